# Optimizing an MI355X kernel written in HIP

```python
import jax, jax.numpy as jnp
from jax import lax
import numpy as np

D_MODEL = 1024
BATCH = 4
SEQ = 4096
DEPTH = 2

N_EVEN = (DEPTH + 1) // 2
N_ODD = DEPTH // 2
EPS = 1e-6

D_FF = 2816

N_MEM = 256
XA_HEADS = 4
XA_HEAD_DIM = D_MODEL // XA_HEADS

A_HEADS = 8
A_HEAD_DIM = 64
A_WIDTH = A_HEADS * A_HEAD_DIM
KV_RANK = 256
IDX_HEADS = 8
IDX_DIM = 64
TOPK_MAX = 256
Q_BLOCK = 128
B_WIDTH = D_MODEL - A_WIDTH
B_BLOCKS = 8
B_BLOCK_DIM = B_WIDTH // B_BLOCKS
CONV_W = 4
LRU_C = 8.0
EVEN_SPLITS = (A_WIDTH, KV_RANK, IDX_HEADS * IDX_DIM, IDX_DIM, IDX_HEADS, B_WIDTH, B_WIDTH)
EVEN_IN = sum(EVEN_SPLITS)

GLA_HEADS = 4
GLA_DK = D_MODEL // 2
GLA_DV = D_MODEL
GLA_DKH = GLA_DK // GLA_HEADS
GLA_DVH = GLA_DV // GLA_HEADS
GLA_GATE_RANK = 16
GLA_TAU = 16.0
GLA_CHUNK = 64
ODD_SPLITS = (GLA_DK, GLA_DK, GLA_DV, GLA_GATE_RANK, GLA_DV)
ODD_IN = sum(ODD_SPLITS)

N_FFN1_PRE, N_FFN1_POST, N_MIX_PRE, N_MIX_POST, N_XA_PRE, N_XA_POST, N_MEM_NORM, N_FFN2_PRE, N_FFN2_POST = range(9)
N_NORMS = 9

kernel_name = "hybrid_dsa_rglru_gla_macaron_block"


def _split(t, sizes):
    return jnp.split(t, np.cumsum(sizes)[:-1].tolist(), axis=-1)


def rmsnorm(x, g):
    xf = x.astype(jnp.float32)
    y = xf * lax.rsqrt(jnp.mean(xf * xf, axis=-1, keepdims=True) + EPS)
    return (y * g.astype(jnp.float32)).astype(x.dtype)


def swiglu(x, w_gu, w_down):
    g, u = jnp.split(x @ w_gu, 2, axis=-1)
    return (jax.nn.silu(g) * u) @ w_down


def causal_dwconv(x, w, b):
    y = lax.conv_general_dilated(x, w[:, None, :].astype(x.dtype), window_strides=(1,),
                                 padding=[(CONV_W - 1, 0)], dimension_numbers=('NWC', 'WIO', 'NWC'),
                                 feature_group_count=x.shape[-1])
    return y + b


def rg_lru(xc, w_ra, b_ra, w_ri, b_ri, lam):
    Bb, S, _ = xc.shape
    xb = xc.reshape(Bb, S, B_BLOCKS, B_BLOCK_DIM)
    r = jax.nn.sigmoid((jnp.einsum('bsgi,gij->bsgj', xb, w_ra) + b_ra).astype(jnp.float32)).reshape(Bb, S, B_WIDTH)
    i = jax.nn.sigmoid((jnp.einsum('bsgi,gij->bsgj', xb, w_ri) + b_ri).astype(jnp.float32)).reshape(Bb, S, B_WIDTH)
    log_a = -LRU_C * r * jax.nn.softplus(-lam.astype(jnp.float32))
    a = jnp.exp(log_a)
    b = jnp.sqrt(-jnp.expm1(2.0 * log_a)) * (i * xc.astype(jnp.float32))

    def combine(left, right):
        a1, b1 = left
        a2, b2 = right
        return a1 * a2, a2 * b1 + b2

    _, h = lax.associative_scan(combine, (a, b), axis=1)
    return h.astype(xc.dtype)


def dsa_attention(q, k, v, q_idx, k_idx, w_idx):
    Bb, S = q.shape[0], q.shape[1]
    n_blk = S // Q_BLOCK
    top_k = min(TOPK_MAX, S // 4)
    key_pos = jnp.arange(S)

    def block(args):
        qb, qib, wb, start = args
        t = start + jnp.arange(Q_BLOCK)
        sc = jnp.einsum('bqhd,bsd->bqhs', qib, k_idx, preferred_element_type=jnp.float32) * (IDX_DIM ** -0.5)
        score = jnp.einsum('bqhs,bqh->bqs', jax.nn.relu(sc), wb.astype(jnp.float32) * (IDX_HEADS ** -0.5))
        causal = key_pos[None, :] <= t[:, None]
        score = jnp.where(causal[None], score, -jnp.inf)
        _, idx = lax.top_k(score, top_k)
        kg = jax.vmap(lambda kk, ii: kk[ii])(k, idx)
        vg = jax.vmap(lambda vv, ii: vv[ii])(v, idx)
        s = jnp.einsum('bqhd,bqkhd->bqhk', qb, kg, preferred_element_type=jnp.float32) * (A_HEAD_DIM ** -0.5)
        valid = (idx <= t[None, :, None])[:, :, None, :]
        p = jax.nn.softmax(jnp.where(valid, s, -jnp.inf), axis=-1)
        return jnp.einsum('bqhk,bqkhd->bqhd', p.astype(vg.dtype), vg)

    def to_blocks(a):
        return a.reshape(Bb, n_blk, Q_BLOCK, *a.shape[2:]).swapaxes(0, 1)

    starts = jnp.arange(n_blk) * Q_BLOCK
    out = lax.map(block, (to_blocks(q), to_blocks(q_idx), to_blocks(w_idx), starts))
    return out.swapaxes(0, 1).reshape(q.shape)


def even_mixer(h, w_in, kv_norm, w_uk, w_uv, conv_w, conv_b, w_ra, b_ra, w_ri, b_ri, lam, w_out):
    Bb, S, _ = h.shape
    q, c_kv, q_i, k_i, w_i, gate_b, x_b = _split(h @ w_in, EVEN_SPLITS)
    c_kv = rmsnorm(c_kv, kv_norm)
    k = (c_kv @ w_uk).reshape(Bb, S, A_HEADS, A_HEAD_DIM)
    v = (c_kv @ w_uv).reshape(Bb, S, A_HEADS, A_HEAD_DIM)
    a_out = dsa_attention(q.reshape(Bb, S, A_HEADS, A_HEAD_DIM), k, v,
                          q_i.reshape(Bb, S, IDX_HEADS, IDX_DIM), k_i, w_i).reshape(Bb, S, A_WIDTH)
    xc = causal_dwconv(x_b, conv_w, conv_b)
    b_out = rg_lru(xc, w_ra, b_ra, w_ri, b_ri, lam) * jax.nn.gelu(gate_b)
    return jnp.concatenate([a_out, b_out], axis=-1) @ w_out


def gla_mixer(h, w_in, w_g2, b_g, head_norm, w_out):
    Bb, S, _ = h.shape
    nc = S // GLA_CHUNK
    q, k, v, g_lr, r = _split(h @ w_in, ODD_SPLITS)
    gk = jax.nn.log_sigmoid((g_lr @ w_g2 + b_g).astype(jnp.float32)) / GLA_TAU

    def chunks(a, dh):
        return a.astype(jnp.float32).reshape(Bb, nc, GLA_CHUNK, GLA_HEADS, dh).transpose(0, 1, 3, 2, 4)

    q = chunks(q, GLA_DKH) * (GLA_DKH ** -0.5)
    k = chunks(k, GLA_DKH)
    v = chunks(v, GLA_DVH)
    G = jnp.cumsum(chunks(gk, GLA_DKH), axis=3)
    G_last = G[:, :, :, -1:, :]
    q_dec = q * jnp.exp(G)
    k_inv = k * jnp.exp(-G)
    k_rem = k * jnp.exp(G_last - G)
    tril = jnp.tril(jnp.ones((GLA_CHUNK, GLA_CHUNK), dtype=bool))
    att = jnp.where(tril, jnp.einsum('bnhid,bnhjd->bnhij', q_dec, k_inv), 0.0)
    o_intra = jnp.einsum('bnhij,bnhjv->bnhiv', att, v)

    def step(state, xs):
        qd, kr, vv, dec = xs
        o = jnp.einsum('bhid,bhdv->bhiv', qd, state)
        state = dec[..., None] * state + jnp.einsum('bhjd,bhjv->bhdv', kr, vv)
        return state, o

    s0 = jnp.zeros((Bb, GLA_HEADS, GLA_DKH, GLA_DVH), jnp.float32)
    xs = (q_dec.swapaxes(0, 1), k_rem.swapaxes(0, 1), v.swapaxes(0, 1), jnp.exp(G_last[:, :, :, 0, :]).swapaxes(0, 1))
    _, o_inter = lax.scan(step, s0, xs)
    o = o_intra + o_inter.swapaxes(0, 1)
    o = o.transpose(0, 1, 3, 2, 4).reshape(Bb, S, GLA_HEADS, GLA_DVH)
    o = rmsnorm(o, head_norm).reshape(Bb, S, GLA_DV).astype(h.dtype) * jax.nn.silu(r)
    return o @ w_out


def mem_cross_attention(h, mem_n, w_q, w_kv, w_o):
    Bb, S, _ = h.shape
    M = mem_n.shape[1]
    q = (h @ w_q).reshape(Bb, S, XA_HEADS, XA_HEAD_DIM)
    k, v = jnp.split(mem_n @ w_kv, 2, axis=-1)
    k = k.reshape(Bb, M, XA_HEADS, XA_HEAD_DIM)
    v = v.reshape(Bb, M, XA_HEADS, XA_HEAD_DIM)
    s = jnp.einsum('bshd,bmhd->bhsm', q, k, preferred_element_type=jnp.float32) * (XA_HEAD_DIM ** -0.5)
    p = jax.nn.softmax(s, axis=-1)
    o = jnp.einsum('bhsm,bmhd->bshd', p.astype(v.dtype), v).reshape(Bb, S, D_MODEL)
    return o @ w_o


def setup_inputs(seed: int = 0) -> dict:
    key = jax.random.key(seed)
    ks = iter(jax.random.split(key, 32))
    f32 = jnp.float32

    def nrm(shape, fan_in):
        return jax.random.normal(next(ks), shape, f32) * (fan_in ** -0.5)

    def small(shape, scale=0.01):
        return jax.random.normal(next(ks), shape, f32) * scale

    def gain(shape):
        return 1.0 + jax.random.normal(next(ks), shape, f32) * 0.02

    u = jax.random.uniform(next(ks), (N_EVEN, B_WIDTH), f32, 0.9, 0.999)
    a_base = u ** (1.0 / LRU_C)
    lam = jnp.log(a_base) - jnp.log1p(-a_base)

    return {
        "x": jax.random.normal(next(ks), (BATCH, SEQ, D_MODEL), f32),
        "mem": jax.random.normal(next(ks), (BATCH, N_MEM, D_MODEL), f32),
        "norms": gain((DEPTH, N_NORMS, D_MODEL)),
        "ffn_w_gu": nrm((DEPTH, 2, D_MODEL, 2 * D_FF), D_MODEL),
        "ffn_w_down": nrm((DEPTH, 2, D_FF, D_MODEL), D_FF),
        "xa_w_q": nrm((DEPTH, D_MODEL, D_MODEL), D_MODEL),
        "xa_w_kv": nrm((DEPTH, D_MODEL, 2 * D_MODEL), D_MODEL),
        "xa_w_o": nrm((DEPTH, D_MODEL, D_MODEL), D_MODEL),
        "ev_w_in": nrm((N_EVEN, D_MODEL, EVEN_IN), D_MODEL),
        "ev_kv_norm": gain((N_EVEN, KV_RANK)),
        "ev_w_uk": nrm((N_EVEN, KV_RANK, A_WIDTH), KV_RANK),
        "ev_w_uv": nrm((N_EVEN, KV_RANK, A_WIDTH), KV_RANK),
        "ev_conv_w": nrm((N_EVEN, CONV_W, B_WIDTH), CONV_W),
        "ev_conv_b": small((N_EVEN, B_WIDTH)),
        "ev_w_ra": nrm((N_EVEN, B_BLOCKS, B_BLOCK_DIM, B_BLOCK_DIM), B_BLOCK_DIM),
        "ev_b_ra": small((N_EVEN, B_BLOCKS, B_BLOCK_DIM)),
        "ev_w_ri": nrm((N_EVEN, B_BLOCKS, B_BLOCK_DIM, B_BLOCK_DIM), B_BLOCK_DIM),
        "ev_b_ri": small((N_EVEN, B_BLOCKS, B_BLOCK_DIM)),
        "ev_lam": lam,
        "ev_w_out": nrm((N_EVEN, D_MODEL, D_MODEL), D_MODEL),
        "od_w_in": nrm((N_ODD, D_MODEL, ODD_IN), D_MODEL),
        "od_w_g2": nrm((N_ODD, GLA_GATE_RANK, GLA_DK), GLA_GATE_RANK),
        "od_b_g": small((N_ODD, GLA_DK), 0.1),
        "od_head_norm": gain((N_ODD, GLA_DVH)),
        "od_w_out": nrm((N_ODD, GLA_DV, D_MODEL), GLA_DV),
    }


def reference(x, mem, norms, ffn_w_gu, ffn_w_down, xa_w_q, xa_w_kv, xa_w_o,
              ev_w_in, ev_kv_norm, ev_w_uk, ev_w_uv, ev_conv_w, ev_conv_b, ev_w_ra, ev_b_ra,
              ev_w_ri, ev_b_ri, ev_lam, ev_w_out,
              od_w_in, od_w_g2, od_b_g, od_head_norm, od_w_out):
    h = x
    for layer in range(DEPTH):
        g = norms[layer]
        f = swiglu(rmsnorm(h, g[N_FFN1_PRE]), ffn_w_gu[layer, 0], ffn_w_down[layer, 0])
        h = h + 0.5 * rmsnorm(f, g[N_FFN1_POST])
        hn = rmsnorm(h, g[N_MIX_PRE])
        if layer % 2 == 0:
            e = layer // 2
            m = even_mixer(hn, ev_w_in[e], ev_kv_norm[e], ev_w_uk[e], ev_w_uv[e], ev_conv_w[e], ev_conv_b[e],
                           ev_w_ra[e], ev_b_ra[e], ev_w_ri[e], ev_b_ri[e], ev_lam[e], ev_w_out[e])
        else:
            o = layer // 2
            m = gla_mixer(hn, od_w_in[o], od_w_g2[o], od_b_g[o], od_head_norm[o], od_w_out[o])
        h = h + rmsnorm(m, g[N_MIX_POST])
        mem_n = rmsnorm(mem, g[N_MEM_NORM])
        c = mem_cross_attention(rmsnorm(h, g[N_XA_PRE]), mem_n, xa_w_q[layer], xa_w_kv[layer], xa_w_o[layer])
        h = h + rmsnorm(c, g[N_XA_POST])
        f = swiglu(rmsnorm(h, g[N_FFN2_PRE]), ffn_w_gu[layer, 1], ffn_w_down[layer, 1])
        h = h + 0.5 * rmsnorm(f, g[N_FFN2_POST])
    return h
```

```cpp
#include <hip/hip_runtime.h>
#include <hip/hip_cooperative_groups.h>
#include <cstdio>
#include <cstdint>
namespace cg = cooperative_groups;

#ifndef MK_PER_PHASE
#define MK_PER_PHASE 0
#endif
#ifndef NAIVE_GEMM
#define NAIVE_GEMM 0
#endif

#define LAS __attribute__((address_space(3)))
#define GAS __attribute__((address_space(1)))
typedef unsigned short bf16_t;
typedef short bf16x8 __attribute__((ext_vector_type(8)));
typedef float f32x4 __attribute__((ext_vector_type(4)));
typedef float f32x2 __attribute__((ext_vector_type(2)));
typedef unsigned u32x4 __attribute__((ext_vector_type(4)));
typedef unsigned u32x2 __attribute__((ext_vector_type(2)));

constexpr int NB = 4, SEQ = 4096, T = NB * SEQ, D = 1024, FF = 2816;
constexpr int NE = 2560, NO = 3328;
constexpr int YQ = 0, YCKV = 512, YQI = 768, YKI = 1280, YWI = 1344, YGATE = 1536, YXB = 2048;
constexpr int ZQ = 0, ZK = 512, ZV = 1024, ZG = 2048, ZR = 2304;
constexpr float EPS = 1e-6f;
constexpr float C2 = 0.125f * 1.4426950408889634f;

constexpr size_t MiB = 1u << 20;
constexpr size_t WS_CTL = 0, CTL_BYTES = 1 * MiB;
constexpr size_t WS_MEMN0 = 1 * MiB, WS_MEMN1 = 3 * MiB, WS_KVM = 5 * MiB, WS_VT = 9 * MiB, WS_LRUA = 11 * MiB, WS_LRUH = 11 * MiB + 512 * 1024, WS_DEC = 12 * MiB;
constexpr size_t WS_W = 17 * MiB;
constexpr size_t W_GU = 0, W_DN = 44 * MiB, W_Q = 66 * MiB, W_KV = 70 * MiB, W_O = 78 * MiB, W_EIN = 82 * MiB, W_UKV = 87 * MiB, W_EOUT = 87 * MiB + 512 * 1024,
                 W_OIN = 89 * MiB + 512 * 1024, W_OOUT = 96 * MiB;
constexpr size_t WS_A = 115 * MiB, WS_F = 147 * MiB;
constexpr size_t WS_BIG = 179 * MiB;
constexpr size_t WS_MIX = 283 * MiB;
constexpr size_t WS_END = 347 * MiB;
constexpr size_t AF_LIST = 0, AF_CNT = 8 * MiB;
constexpr size_t AF_QD = 0, AF_KI = 16 * MiB, AF_KR = 32 * MiB, AF_ATT = 48 * MiB;
constexpr size_t BG_Y = 0, BG_CKVN = 80 * MiB, BG_MASK = 88 * MiB;
constexpr size_t BG_Q = 0, BG_S = 32 * MiB;
constexpr size_t BG_H = 0;
constexpr int CW_BAR = 4096;

__device__ __forceinline__ float bf2f(bf16_t v) { return __uint_as_float((unsigned)v << 16); }
__device__ __forceinline__ unsigned f2bf(float f) { unsigned u = __float_as_uint(f); return (u + 0x7fffu + ((u >> 16) & 1u)) >> 16; }
__device__ __forceinline__ unsigned pk2(float lo, float hi) { return f2bf(lo) | (f2bf(hi) << 16); }
__device__ __forceinline__ float wave_sum(float v) {
#pragma unroll
    for (int o = 1; o < 64; o <<= 1) v += __shfl_xor(v, o);
    return v;
}
__device__ __forceinline__ float wave_max(float v) {
#pragma unroll
    for (int o = 1; o < 64; o <<= 1) v = fmaxf(v, __shfl_xor(v, o));
    return v;
}
__device__ __forceinline__ float sigmoidf_(float x) { return 1.0f / (1.0f + __expf(-x)); }

namespace pg8 {
constexpr int BM = 256, BK = 64, HALF = 128, HTB = HALF * BK * 2, STAGE_BYTES = 8 * HTB, NXCD = 8, WGM = 8;
__host__ __device__ __forceinline__ int lds_byte(int r, int c) { const int st = (r >> 4) * 2 + (c >> 5), rr = r & 15, cc = c & 31, ob = rr * 64 + cc * 2; return st * 1024 + (ob ^ (((ob >> 9) & 1) << 5)); }
__host__ __device__ __forceinline__ void stage_rc(int b, int& R, int& C) { const int st = b / 1024, sb = b % 1024, swz = sb ^ (((sb >> 9) & 1) << 5); R = (st >> 1) * 16 + swz / 64; C = (st & 1) * 32 + (swz % 64) / 2; }
__host__ __device__ __forceinline__ int perm32(int rho) { const int n = rho >> 4, i = rho & 15; return 8 * (i >> 2) + 4 * n + (i & 3); }

struct Unit { int pm, pn; };
struct Gemm {
    const bf16_t* A; const bf16_t* Bt; int lda, ldb, K, nM, nN; int a_pn_off, b_pn_off, b_batch_off, bshift;
    __device__ __forceinline__ const char* a_ptr(const Unit& u) const { return (const char*)(A + (size_t)u.pm * BM * lda + (size_t)u.pn * a_pn_off); }
    __device__ __forceinline__ const char* b_ptr(const Unit& u) const { return (const char*)(Bt + (size_t)u.pn * b_pn_off + (size_t)(u.pm >> bshift) * b_batch_off); }
};
__device__ __forceinline__ Gemm plain_gemm(const bf16_t* A, int lda, const bf16_t* Bt, int ldb, int M, int N, int K) {
    Gemm g; g.A = A; g.Bt = Bt; g.lda = lda; g.ldb = ldb; g.K = K; g.nM = M / BM; g.nN = N / BM; g.a_pn_off = 0; g.b_pn_off = BM * ldb; g.b_batch_off = 0; g.bshift = 30; return g;
}
struct StaticOrder {
    int nM, nN, nwg, G, c;
    __device__ void init(int nM_, int nN_, int G_, int c_) { nM = nM_; nN = nN_; nwg = nM * nN; G = G_; c = c_; }
    __device__ bool next(int i, Unit& u) const {
        const long L = (long)i * G + c; if (L >= nwg) return false;
        int wgid = (int)L; { const int q = nwg / NXCD, r = nwg % NXCD, xcd = wgid % NXCD, off = wgid / NXCD; wgid = (xcd < r ? xcd * (q + 1) : r * (q + 1) + (xcd - r) * q) + off; }
        const int nig = WGM * nN, gid = wgid / nig, fm = gid * WGM, gsz = (nM - fm) < WGM ? (nM - fm) : WGM;
        u.pm = fm + ((wgid % nig) % gsz); u.pn = (wgid % nig) / gsz; return true;
    }
};
__device__ __forceinline__ unsigned cvt_pk_bf16(float lo, float hi) { unsigned r; asm volatile("v_cvt_pk_bf16_f32 %0, %1, %2" : "=v"(r) : "v"(lo), "v"(hi)); return r; }

struct EpiBf16 {
    static constexpr bool PERM = true;
    bf16_t* O; int ldc; float scale;
    __device__ __forceinline__ void operator()(const f32x4 (&acc)[2][2][4][2], const Unit& u, int wr, int wc, int fr, int fq) const {
        const int row0 = u.pm * BM + wr * 64 + fr, col0 = u.pn * BM + wc * 32 + 8 * fq;
#pragma unroll
        for (int ai = 0; ai < 2; ++ai)
#pragma unroll
            for (int m = 0; m < 4; ++m) { bf16_t* rowp = O + (size_t)(row0 + ai * HALF + m * 16) * ldc + col0;
#pragma unroll
                for (int bj = 0; bj < 2; ++bj) { const f32x4 v0 = acc[ai][bj][m][0] * scale, v1 = acc[ai][bj][m][1] * scale;
                    u32x4 w; w.x = cvt_pk_bf16(v0[0], v0[1]); w.y = cvt_pk_bf16(v0[2], v0[3]); w.z = cvt_pk_bf16(v1[0], v1[1]); w.w = cvt_pk_bf16(v1[2], v1[3]);
                    *(u32x4*)(rowp + bj * HALF) = w; } }
    }
    __device__ __forceinline__ void elem(int row, int col, float a0, float) const { O[(size_t)row * ldc + col] = (bf16_t)f2bf(a0 * scale); }
};
struct EpiSwiglu {
    static constexpr bool PERM = true;
    bf16_t* O; int ldc;
    __device__ __forceinline__ void operator()(const f32x4 (&acc)[2][2][4][2], const Unit& u, int wr, int wc, int fr, int fq) const {
        const int row0 = u.pm * BM + wr * 64 + fr, col0 = u.pn * HALF + wc * 32 + 8 * fq;
#pragma unroll
        for (int ai = 0; ai < 2; ++ai)
#pragma unroll
            for (int m = 0; m < 4; ++m) { bf16_t* rowp = O + (size_t)(row0 + ai * HALF + m * 16) * ldc + col0; float o[8];
#pragma unroll
                for (int n = 0; n < 2; ++n)
#pragma unroll
                    for (int i = 0; i < 4; ++i) { const float g = acc[ai][0][m][n][i], uu = acc[ai][1][m][n][i]; o[4 * n + i] = g * __builtin_amdgcn_rcpf(1.0f + __expf(-g)) * uu; }
                u32x4 w; w.x = cvt_pk_bf16(o[0], o[1]); w.y = cvt_pk_bf16(o[2], o[3]); w.z = cvt_pk_bf16(o[4], o[5]); w.w = cvt_pk_bf16(o[6], o[7]);
                *(u32x4*)rowp = w; }
    }
    __device__ __forceinline__ void elem(int row, int j, float g, float uu) const { O[(size_t)row * ldc + j] = (bf16_t)f2bf(g / (1.0f + __expf(-g)) * uu); }
};

struct EpiAny {
    static constexpr bool PERM = true;
    bf16_t* O; int ldc; float scale; int mode;
    __device__ __forceinline__ void operator()(const f32x4 (&acc)[2][2][4][2], const Unit& u, int wr, int wc, int fr, int fq) const {
        if (mode == 0) { EpiBf16 E{O, ldc, scale}; E(acc, u, wr, wc, fr, fq); } else { EpiSwiglu E{O, ldc}; E(acc, u, wr, wc, fr, fq); }
    }
};
template <class Epi, bool ALIGN_EPI>
__device__ __forceinline__ void gemm_phase(LAS unsigned char* lds, const Gemm g, const StaticOrder& S, const Epi& E, const int tid) {
    const int wid = __builtin_amdgcn_readfirstlane(tid >> 6), lane = tid & 63, wr = wid >> 2, wc = wid & 3, fr = lane & 15, fq = lane >> 4;
    const int K = g.K, nt = K / BK;
    unsigned voffA[2], voffB[2];
#pragma unroll
    for (int i = 0; i < 2; ++i) { int R, C; stage_rc(tid * 16 + i * 8192, R, C); const int Rb = Epi::PERM ? ((R & ~31) + perm32(R & 31)) : R;
        voffA[i] = (unsigned)(R * g.lda + C) * 2u; voffB[i] = (unsigned)(Rb * g.ldb + C) * 2u; }
    const size_t kstep = (size_t)(BK * 2);
    const size_t hstepA = (size_t)HALF * g.lda * 2, hstepB = (size_t)HALF * g.ldb * 2;
    const unsigned ldsw = (unsigned)wid * 1024u;
    const int aoff = lds_byte(wr * 64 + fr, fq * 8), boff = lds_byte(wc * 32 + fr, fq * 8);
#define PG8_SA(b, h) (((b) * 2 + (h)) * HTB)
#define PG8_SB(b, h) ((4 + (b) * 2 + (h)) * HTB)
#define PG8_STAGE(bufoff, gbase, voff) do { _Pragma("unroll") for (int _i = 0; _i < 2; ++_i) \
        __builtin_amdgcn_global_load_lds((const unsigned*)((const char*)(gbase) + (voff)[_i]), (LAS unsigned*)(lds + (bufoff) + ldsw + _i * 8192), 16, 0, 0); } while (0)
#define PG8_LDA(dst, b, h) do { _Pragma("unroll") for (int m = 0; m < 4; ++m) _Pragma("unroll") for (int k = 0; k < 2; ++k) dst[m][k] = *(const LAS bf16x8*)(lds + PG8_SA(b, h) + aoff + m * 2048 + k * 1024); } while (0)
#define PG8_LDB(dst, b, h) do { _Pragma("unroll") for (int n = 0; n < 2; ++n) _Pragma("unroll") for (int k = 0; k < 2; ++k) dst[n][k] = *(const LAS bf16x8*)(lds + PG8_SB(b, h) + boff + n * 2048 + k * 1024); } while (0)
#define PG8_MMA(ai, bj, At, Bt) do { __builtin_amdgcn_s_setprio(1); _Pragma("unroll") for (int m = 0; m < 4; ++m) _Pragma("unroll") for (int n = 0; n < 2; ++n) _Pragma("unroll") for (int k = 0; k < 2; ++k) \
        acc[ai][bj][m][n] = __builtin_amdgcn_mfma_f32_16x16x32_bf16(Bt[n][k], At[m][k], acc[ai][bj][m][n], 0, 0, 0); __builtin_amdgcn_s_setprio(0); } while (0)
#define PG8_WAIT_V(n) asm volatile("s_waitcnt vmcnt(" #n ")" ::: "memory")
#define PG8_WAIT_L(n) asm volatile("s_waitcnt lgkmcnt(" #n ")" ::: "memory")
#define PG8_BAR __builtin_amdgcn_s_barrier()
#define PG8_SCHED __builtin_amdgcn_sched_barrier(0)
    Unit cur, nxt; int ui = 0;
    if (!S.next(0, cur)) return;
    f32x4 acc[2][2][4][2];
#pragma unroll
    for (int a = 0; a < 2; ++a)
#pragma unroll
        for (int b = 0; b < 2; ++b)
#pragma unroll
            for (int m = 0; m < 4; ++m)
#pragma unroll
                for (int n = 0; n < 2; ++n) acc[a][b][m][n] = (f32x4){0.f, 0.f, 0.f, 0.f};
    bf16x8 At[4][2], B0[2][2], B1[2][2];
    const char* cA = g.a_ptr(cur); const char* cB = g.b_ptr(cur);
    PG8_STAGE(PG8_SB(0, 0), cB, voffB); PG8_STAGE(PG8_SB(0, 1), cB + hstepB, voffB); PG8_STAGE(PG8_SA(0, 0), cA, voffA); PG8_STAGE(PG8_SA(0, 1), cA + hstepA, voffA);
    if (wr == 1) PG8_BAR;
    PG8_WAIT_V(2); PG8_BAR;
    PG8_STAGE(PG8_SB(1, 0), cB + kstep, voffB); PG8_STAGE(PG8_SA(1, 0), cA + kstep, voffA); PG8_STAGE(PG8_SB(1, 1), cB + hstepB + kstep, voffB);
    PG8_WAIT_V(6); PG8_BAR;
    for (;;) {
        const bool has_next = S.next(ui + 1, nxt);
        const char* nA = has_next ? g.a_ptr(nxt) : cA; const char* nB = has_next ? g.b_ptr(nxt) : cB;
        for (int t = 0; t < nt; t += 2) {
            const bool last = (t == nt - 2);
            const char* a1 = cA + (size_t)(t + 1) * kstep;
            const char* a2 = last ? nA : cA + (size_t)(t + 2) * kstep; const char* b2 = last ? nB : cB + (size_t)(t + 2) * kstep;
            const char* a3 = a2 + kstep; const char* b3 = b2 + kstep;
            PG8_LDB(B0, 0, 0); PG8_LDB(B1, 0, 1); PG8_SCHED; PG8_LDA(At, 0, 0); PG8_STAGE(PG8_SA(1, 1), a1 + hstepA, voffA);
            PG8_WAIT_V(8); PG8_WAIT_L(0); PG8_BAR; PG8_MMA(0, 0, At, B0); PG8_MMA(0, 1, At, B1); PG8_BAR; PG8_SCHED;
            PG8_LDA(At, 0, 1); PG8_STAGE(PG8_SB(0, 0), b2, voffB); PG8_STAGE(PG8_SB(0, 1), b2 + hstepB, voffB); PG8_STAGE(PG8_SA(0, 0), a2, voffA);
            PG8_WAIT_V(8); PG8_WAIT_L(0); PG8_BAR; PG8_MMA(1, 0, At, B0); PG8_MMA(1, 1, At, B1); PG8_BAR; PG8_SCHED;
            PG8_LDB(B0, 1, 0); PG8_LDB(B1, 1, 1); PG8_SCHED; PG8_LDA(At, 1, 0); PG8_STAGE(PG8_SA(0, 1), a2 + hstepA, voffA);
            PG8_WAIT_V(8); PG8_WAIT_L(0); PG8_BAR; PG8_MMA(0, 0, At, B0); PG8_MMA(0, 1, At, B1); PG8_BAR; PG8_SCHED;
            PG8_LDA(At, 1, 1); PG8_STAGE(PG8_SB(1, 0), b3, voffB); PG8_STAGE(PG8_SB(1, 1), b3 + hstepB, voffB); PG8_STAGE(PG8_SA(1, 0), a3, voffA);
            PG8_WAIT_V(8); PG8_WAIT_L(0); PG8_BAR; PG8_MMA(1, 0, At, B0); PG8_MMA(1, 1, At, B1); PG8_BAR; PG8_SCHED;
        }
        if constexpr (ALIGN_EPI) { if (wr == 0) PG8_BAR; }
        { Unit eu = cur; asm volatile("" : "+s"(eu.pm), "+s"(eu.pn));
          E(acc, eu, wr, wc, fr, fq); }
        if (!has_next) break;
#pragma unroll
        for (int a = 0; a < 2; ++a)
#pragma unroll
            for (int b = 0; b < 2; ++b)
#pragma unroll
                for (int m = 0; m < 4; ++m)
#pragma unroll
                    for (int n = 0; n < 2; ++n) acc[a][b][m][n] = (f32x4){0.f, 0.f, 0.f, 0.f};
        cur = nxt; cA = nA; cB = nB; ++ui;
        if constexpr (ALIGN_EPI) { if (wr == 1) PG8_BAR; }
    }
    PG8_WAIT_V(0);
    if constexpr (!ALIGN_EPI) { if (wr == 0) PG8_BAR; }
    PG8_BAR;
#undef PG8_SA
#undef PG8_SB
#undef PG8_STAGE
#undef PG8_LDA
#undef PG8_LDB
#undef PG8_MMA
#undef PG8_WAIT_V
#undef PG8_WAIT_L
#undef PG8_BAR
#undef PG8_SCHED
}

template <int NPAN, class Epi>
__device__ __forceinline__ void gemm_naive(LAS unsigned char* lds8, const Gemm g, const Epi& E, int nblk, int bid, const int tid) {
    LAS float* As = (LAS float*)lds8; LAS float* Bs = As + 64 * 33;
    const int ty = tid >> 4, tx = tid & 15;
    const int ntm = g.nM * 4, ntn = (NPAN == 2) ? g.nN * 2 : g.nN * 4;
    for (int tile = bid; tile < ntm * ntn; tile += nblk) {
        const int tm = tile / ntn, tn = tile % ntn;
        Unit u; u.pm = tm >> 2; u.pn = (NPAN == 2) ? (tn >> 1) : (tn >> 2);
        const bf16_t* Ab = (const bf16_t*)g.a_ptr(u) + (size_t)(tm & 3) * 64 * g.lda;
        const bf16_t* Bb = (const bf16_t*)g.b_ptr(u) + (size_t)((NPAN == 2) ? (tn & 1) * 64 : (tn & 3) * 64) * g.ldb;
        float acc[NPAN][2][4];
#pragma unroll
        for (int p = 0; p < NPAN; ++p)
#pragma unroll
            for (int r = 0; r < 2; ++r)
#pragma unroll
                for (int i = 0; i < 4; ++i) acc[p][r][i] = 0.f;
        const int lr = tid >> 3, lk = (tid & 7) * 4;
        for (int k0 = 0; k0 < g.K; k0 += 32) {
            { const u32x2 v = *(const u32x2*)(Ab + (size_t)lr * g.lda + k0 + lk);
              As[lr * 33 + lk] = __uint_as_float(v.x << 16); As[lr * 33 + lk + 1] = __uint_as_float(v.x & 0xffff0000u); As[lr * 33 + lk + 2] = __uint_as_float(v.y << 16); As[lr * 33 + lk + 3] = __uint_as_float(v.y & 0xffff0000u); }
#pragma unroll
            for (int p = 0; p < NPAN; ++p) { const u32x2 v = *(const u32x2*)(Bb + (size_t)(lr + p * 128) * g.ldb + k0 + lk); LAS float* B_ = Bs + p * 64 * 33;
              B_[lr * 33 + lk] = __uint_as_float(v.x << 16); B_[lr * 33 + lk + 1] = __uint_as_float(v.x & 0xffff0000u); B_[lr * 33 + lk + 2] = __uint_as_float(v.y << 16); B_[lr * 33 + lk + 3] = __uint_as_float(v.y & 0xffff0000u); }
            __syncthreads();
            for (int kk = 0; kk < 32; ++kk) { const float a0 = As[ty * 33 + kk], a1 = As[(ty + 32) * 33 + kk];
#pragma unroll
                for (int p = 0; p < NPAN; ++p)
#pragma unroll
                    for (int i = 0; i < 4; ++i) { const float b = Bs[p * 64 * 33 + (tx + 16 * i) * 33 + kk]; acc[p][0][i] += a0 * b; acc[p][1][i] += a1 * b; } }
            __syncthreads();
        }
#pragma unroll
        for (int r = 0; r < 2; ++r)
#pragma unroll
            for (int i = 0; i < 4; ++i) { const int row = tm * 64 + ty + 32 * r, col = tn * 64 + tx + 16 * i;
                E.elem(row, col, acc[0][r][i], NPAN == 2 ? acc[NPAN - 1][r][i] : 0.f); }
    }
}
}

#define XB_TMO      128
#define XB_XCNT(j)  (256  + 64 * (j))
#define XB_XSUB(j)  (1280 + 64 * (j))
#define XB_XGEN(j)  (2304 + 64 * (j))
#define XB_TOP      3328
#define XB_TOPGEN   3392
#define XCD_BAR_WORDS 3456
#define XB_SPIN_CAP (1u << 18)
__device__ __forceinline__ unsigned xb_ld(unsigned* p)              { return __hip_atomic_load(p, __ATOMIC_RELAXED, __HIP_MEMORY_SCOPE_AGENT); }
__device__ __forceinline__ unsigned xb_add(unsigned* p, unsigned v) { return __hip_atomic_fetch_add(p, v, __ATOMIC_RELAXED, __HIP_MEMORY_SCOPE_AGENT); }
__device__ __forceinline__ unsigned xb_xcc_id() { return (unsigned)__builtin_amdgcn_s_getreg((3 << 11) | 20) & 0xFu; }
#define XB_SPIN(cond, bar) do { unsigned _sp = 0; while (cond) { __builtin_amdgcn_s_sleep(1); \
    if ((++_sp & 255u) == 0u) { if (xb_ld(&(bar)[XB_TMO])) break; if (_sp > XB_SPIN_CAP) { atomicAdd(&(bar)[XB_TMO], 1u); break; } } } } while (0)
struct XcdBarrier { unsigned* bar; unsigned x; volatile LAS unsigned* st; };
__device__ __forceinline__ XcdBarrier xcd_barrier_post(unsigned* bar, volatile LAS unsigned* st) {
    XcdBarrier b; b.bar = bar; b.x = xb_xcc_id(); b.st = st;
    if (threadIdx.x == 0) (void)xb_add(&bar[XB_XCNT(b.x)], 1u);
    return b;
}
__device__ __forceinline__ void xcd_barrier_complete(unsigned* bar, unsigned x, unsigned& nloc, unsigned& nx) {
    const unsigned G = gridDim.x * gridDim.y * gridDim.z;
    unsigned sum, cnt, mine, sp = 0u;
    for (;;) {
        sum = 0u; cnt = 0u; mine = 0u;
#pragma unroll
        for (unsigned j = 0; j < 16; ++j) { const unsigned c = xb_ld(&bar[XB_XCNT(j)]); sum += c; cnt += (c > 0u) ? 1u : 0u; mine = (j == x) ? c : mine; }
        if (sum == G) break;
        __builtin_amdgcn_s_sleep(1);
        if ((++sp & 255u) == 0u) { if (xb_ld(&bar[XB_TMO])) break; if (sp > XB_SPIN_CAP) { atomicAdd(&bar[XB_TMO], 1u); break; } }
    }
    nloc = mine > 0u ? mine : 1u; nx = cnt > 0u ? cnt : 1u;
}
__device__ __forceinline__ void xcd_barrier(const XcdBarrier& b) {
    asm volatile("s_waitcnt vmcnt(0)" ::: "memory");
    __syncthreads();
    if (threadIdx.x == 0) {
        unsigned* bar = b.bar;
        __builtin_amdgcn_s_waitcnt(0);
        unsigned nloc = b.st[0], nx = b.st[1];
        if (nloc == 0u) { xcd_barrier_complete(bar, b.x, nloc, nx); b.st[0] = nloc; b.st[1] = nx; }
        const unsigned old = xb_add(&bar[XB_XSUB(b.x)], 1u);
        const unsigned gen = old / nloc;
        if (old + 1u == (gen + 1u) * nloc) {
            __builtin_amdgcn_fence(__ATOMIC_RELEASE, "agent");
            asm volatile("s_waitcnt vmcnt(0)" ::: "memory");
            const unsigned og = xb_add(&bar[XB_TOP], 1u);
            const unsigned tg = og / nx;
            if (og + 1u == (tg + 1u) * nx) xb_add(&bar[XB_TOPGEN], 1u);
            else XB_SPIN(xb_ld(&bar[XB_TOPGEN]) == tg, bar);
            __builtin_amdgcn_fence(__ATOMIC_ACQUIRE, "agent");
            xb_add(&bar[XB_XGEN(b.x)], 1u);
            asm volatile("s_waitcnt vmcnt(0)" ::: "memory");
        } else {
            XB_SPIN(xb_ld(&bar[XB_XGEN(b.x)]) == gen, bar);
            __builtin_amdgcn_fence(__ATOMIC_ACQUIRE, "agent");
            asm volatile("s_waitcnt vmcnt(0)" ::: "memory");
        }
    }
    __syncthreads();
}

constexpr int NWAVES = 8, NTHREADS = 512;
constexpr int RING_BYTES = 131072, HIST_OFF = RING_BYTES, DESC_OFF = RING_BYTES + 8704, MISC_OFF = DESC_OFF + 6144, LDS_BYTES = 147456;
constexpr int DESC_WORDS = 32;
struct Args { const float* in[25]; float* out; unsigned char* ws; int ph_lo, ph_hi; };
struct Ctx {
    LAS unsigned char* lds; int tid, lane, wave, nblk, bid;
    float* out; unsigned char* ws; const __attribute__((address_space(4))) void* kp;
};
#define inp(i) (((const float* const __attribute__((address_space(4)))*)F.kp)[i])
enum { I_X = 0, I_MEM, I_NORMS, I_WGU, I_WDN, I_XQ, I_XKV, I_XO, I_EIN, I_EKVN, I_EUK, I_EUV, I_ECW, I_ECB, I_ERA, I_EBRA, I_ERI, I_EBRI, I_ELAM, I_EOUT, I_OIN, I_OG2, I_OBG, I_OHN, I_OOUT };
enum { N_FFN1_PRE = 0, N_FFN1_POST, N_MIX_PRE, N_MIX_POST, N_XA_PRE, N_XA_POST, N_MEM_NORM, N_FFN2_PRE, N_FFN2_POST };

struct TJob { const float* W; int K, Nsrc; bf16_t* WT; int c0, nc, r0, mode; float scale; };
__device__ __forceinline__ void transpose_item(const TJob& J, int item, LAS float* scr, int lane) {
    const int nblk = (J.nc + 31) / 32, kb = item / nblk, nb = item % nblk, k0 = 64 * kb, n0 = 32 * nb;
    const int cl = n0 + (lane & 31); const bool okc = cl < J.nc;
#pragma unroll 8
    for (int i = 0; i < 32; ++i) { const int kk = 2 * i + (lane >> 5); scr[kk * 33 + (lane & 31)] = okc ? J.W[(size_t)(k0 + kk) * J.Nsrc + J.c0 + cl] * J.scale : 0.f; }
    asm volatile("s_waitcnt lgkmcnt(0)" ::: "memory");
    const int c = lane & 7;
#pragma unroll
    for (int j = 0; j < 4; ++j) { const int n = (lane >> 3) + 8 * j; const LAS float* s = scr + (8 * c) * 33 + n;
        u32x4 o; o.x = pk2(s[0 * 33], s[1 * 33]); o.y = pk2(s[2 * 33], s[3 * 33]); o.z = pk2(s[4 * 33], s[5 * 33]); o.w = pk2(s[6 * 33], s[7 * 33]);
        const int cc = n0 + n;
        if (cc < J.nc) { int row; if (J.mode == 0) row = J.r0 + cc; else { const int cg = J.c0 + cc, bj = cg / FF, jj = cg % FF; row = 256 * (jj / 128) + 128 * bj + (jj % 128); }
            *(u32x4*)(J.WT + (size_t)row * J.K + k0 + 8 * c) = o; } }
    asm volatile("s_waitcnt lgkmcnt(0)" ::: "memory");
}
constexpr int NJOBS = 4 + 4 + 6 + 7 + 2 + 1 + 5 + 1;
__device__ __forceinline__ TJob get_job(const Ctx& F, int j) {
    TJob J; J.mode = 0; J.scale = 1.f; J.c0 = 0; J.r0 = 0;
    bf16_t* Wb = (bf16_t*)(F.ws + WS_W);
    if (j < 4) { J.W = inp(I_WGU) + (size_t)j * D * 2 * FF; J.K = D; J.Nsrc = 2 * FF; J.nc = 2 * FF; J.WT = (bf16_t*)((unsigned char*)Wb + W_GU) + (size_t)j * 2 * FF * D; J.mode = 1; return J; }
    j -= 4;
    if (j < 4) { J.W = inp(I_WDN) + (size_t)j * FF * D; J.K = FF; J.Nsrc = D; J.nc = D; J.WT = (bf16_t*)((unsigned char*)Wb + W_DN) + (size_t)j * D * FF; return J; }
    j -= 4;
    if (j < 6) { const int l = j & 1, w = j >> 1;
        if (w == 0) { J.W = inp(I_XQ) + (size_t)l * D * D; J.K = D; J.Nsrc = D; J.nc = D; J.WT = (bf16_t*)((unsigned char*)Wb + W_Q) + (size_t)l * D * D; }
        else if (w == 1) { J.W = inp(I_XKV) + (size_t)l * D * 2 * D; J.K = D; J.Nsrc = 2 * D; J.nc = 2 * D; J.WT = (bf16_t*)((unsigned char*)Wb + W_KV) + (size_t)l * 2 * D * D; }
        else { J.W = inp(I_XO) + (size_t)l * D * D; J.K = D; J.Nsrc = D; J.nc = D; J.WT = (bf16_t*)((unsigned char*)Wb + W_O) + (size_t)l * D * D; }
        return J; }
    j -= 6;
    if (j < 7) { J.W = inp(I_EIN); J.K = D; J.Nsrc = 2376; J.WT = (bf16_t*)((unsigned char*)Wb + W_EIN);
        switch (j) { case 0: J.c0 = 0; J.nc = 512; J.r0 = YQ; J.scale = C2; break; case 1: J.c0 = 512; J.nc = 256; J.r0 = YCKV; break; case 2: J.c0 = 768; J.nc = 512; J.r0 = YQI; break;
                     case 3: J.c0 = 1280; J.nc = 64; J.r0 = YKI; break; case 4: J.c0 = 1344; J.nc = 8; J.r0 = YWI; break; case 5: J.c0 = 1352; J.nc = 512; J.r0 = YGATE; break; default: J.c0 = 1864; J.nc = 512; J.r0 = YXB; break; }
        return J; }
    j -= 7;
    if (j < 2) { J.W = (j == 0) ? inp(I_EUK) : inp(I_EUV); J.K = 256; J.Nsrc = 512; J.nc = 512; J.WT = (bf16_t*)((unsigned char*)Wb + W_UKV); J.r0 = 512 * j; return J; }
    j -= 2;
    if (j < 1) { J.W = inp(I_EOUT); J.K = D; J.Nsrc = D; J.nc = D; J.WT = (bf16_t*)((unsigned char*)Wb + W_EOUT); return J; }
    j -= 1;
    if (j < 5) { J.W = inp(I_OIN); J.K = D; J.Nsrc = 3088; J.WT = (bf16_t*)((unsigned char*)Wb + W_OIN);
        switch (j) { case 0: J.c0 = 0; J.nc = 512; J.r0 = ZQ; break; case 1: J.c0 = 512; J.nc = 512; J.r0 = ZK; break; case 2: J.c0 = 1024; J.nc = 1024; J.r0 = ZV; break;
                     case 3: J.c0 = 2048; J.nc = 16; J.r0 = ZG; break; default: J.c0 = 2064; J.nc = 1024; J.r0 = ZR; break; }
        return J; }
    J.W = inp(I_OOUT); J.K = D; J.Nsrc = D; J.nc = D; J.WT = (bf16_t*)((unsigned char*)Wb + W_OOUT); return J;
}
__device__ __forceinline__ void rms_row_to_bf16(const float* xrow, const float* gain, bf16_t* orow, int lane) {
    const f32x4* xr = (const f32x4*)xrow + lane; f32x4 v[4]; float s = 0.f;
#pragma unroll
    for (int j = 0; j < 4; ++j) { v[j] = xr[64 * j]; s += (v[j].x * v[j].x + v[j].y * v[j].y) + (v[j].z * v[j].z + v[j].w * v[j].w); }
    const float rstd = 1.0f / sqrtf(wave_sum(s) * (1.f / D) + EPS);
    u32x2* o8 = (u32x2*)orow + lane;
#pragma unroll
    for (int j = 0; j < 4; ++j) { const f32x4 gg = ((const f32x4*)gain)[lane + 64 * j]; u32x2 w; w.x = pk2(v[j].x * rstd * gg.x, v[j].y * rstd * gg.y); w.y = pk2(v[j].z * rstd * gg.z, v[j].w * rstd * gg.w); o8[64 * j] = w; }
}
__device__ __forceinline__ void phase_prep(const Ctx& F) {
    LAS float* scr = (LAS float*)(F.lds + F.wave * 16384);
    const int gw = F.bid * NWAVES + F.wave, NGW = F.nblk * NWAVES;
    int total = 0;
    for (int j = 0; j < NJOBS; ++j) { const TJob J = get_job(F, j); total += (J.K / 64) * ((J.nc + 31) / 32); }
    for (int it = gw; it < total; it += NGW) {
        int r = it, j = 0; TJob J = get_job(F, 0);
        for (;;) { const int n = (J.K / 64) * ((J.nc + 31) / 32); if (r < n) break; r -= n; ++j; J = get_job(F, j); }
        transpose_item(J, r, scr, F.lane);
    }
    { bf16_t* We = (bf16_t*)(F.ws + WS_W + W_EIN) + (size_t)1352 * D; bf16_t* Wo = (bf16_t*)(F.ws + WS_W + W_OIN) + (size_t)2064 * D;
      const int ne = 184 * D / 8, no = 240 * D / 8; const int gt = F.bid * NTHREADS + F.tid, NGT = F.nblk * NTHREADS;
      for (int i = gt; i < ne + no; i += NGT) { u32x4 z = {0u, 0u, 0u, 0u}; if (i < ne) ((u32x4*)We)[i] = z; else ((u32x4*)Wo)[i - ne] = z; } }
    for (int m = gw; m < 2 * 1024 + T; m += NGW) {
        if (m < 2048) { const int l = m >> 10, r = m & 1023; rms_row_to_bf16(inp(I_MEM) + (size_t)r * D, inp(I_NORMS) + (size_t)(l * 9 + N_MEM_NORM) * D, (bf16_t*)(F.ws + (l ? WS_MEMN1 : WS_MEMN0)) + (size_t)r * D, F.lane); }
        else { const int r = m - 2048; rms_row_to_bf16(inp(I_X) + (size_t)r * D, inp(I_NORMS) + (size_t)N_FFN1_PRE * D, (bf16_t*)(F.ws + WS_A) + (size_t)r * D, F.lane); }
    }
}

__device__ __forceinline__ void phase_norm(const Ctx& F, const bf16_t* Fb, const float* hin, float* hout, float coef, const float* gpost, const float* gpre, bf16_t* Aout) {
    const int gw = F.bid * NWAVES + F.wave, NGW = F.nblk * NWAVES, lane = F.lane;
    for (int m = gw; m < T; m += NGW) {
        const u32x2* fr = (const u32x2*)(Fb + (size_t)m * D) + lane; f32x4 f[4]; float s = 0.f;
#pragma unroll
        for (int j = 0; j < 4; ++j) { const u32x2 w = fr[64 * j]; f[j].x = __uint_as_float(w.x << 16); f[j].y = __uint_as_float(w.x & 0xffff0000u); f[j].z = __uint_as_float(w.y << 16); f[j].w = __uint_as_float(w.y & 0xffff0000u);
            s += (f[j].x * f[j].x + f[j].y * f[j].y) + (f[j].z * f[j].z + f[j].w * f[j].w); }
        const float rstd = coef / sqrtf(wave_sum(s) * (1.f / D) + EPS);
        f32x4 h[4]; float s2 = 0.f;
#pragma unroll
        for (int j = 0; j < 4; ++j) { const f32x4 hv = ((const f32x4*)(hin + (size_t)m * D))[lane + 64 * j]; const f32x4 gg = ((const f32x4*)gpost)[lane + 64 * j];
            h[j] = hv + f[j] * rstd * gg; ((f32x4*)(hout + (size_t)m * D))[lane + 64 * j] = h[j];
            s2 += (h[j].x * h[j].x + h[j].y * h[j].y) + (h[j].z * h[j].z + h[j].w * h[j].w); }
        if (gpre) { const float r2 = 1.0f / sqrtf(wave_sum(s2) * (1.f / D) + EPS); u32x2* o8 = (u32x2*)(Aout + (size_t)m * D) + lane;
#pragma unroll
            for (int j = 0; j < 4; ++j) { const f32x4 gg = ((const f32x4*)gpre)[lane + 64 * j]; u32x2 w; w.x = pk2(h[j].x * r2 * gg.x, h[j].y * r2 * gg.y); w.y = pk2(h[j].z * r2 * gg.z, h[j].w * r2 * gg.w); o8[64 * j] = w; } }
    }
}

__device__ __forceinline__ void phase_ckvn(const Ctx& F) {
    const bf16_t* Y = (const bf16_t*)(F.ws + WS_BIG + BG_Y); bf16_t* O = (bf16_t*)(F.ws + WS_BIG + BG_CKVN); const float* gn = inp(I_EKVN);
    const int gw = F.bid * NWAVES + F.wave, NGW = F.nblk * NWAVES, lane = F.lane;
    for (int m = gw; m < T; m += NGW) {
        const u32x2 w = ((const u32x2*)(Y + (size_t)m * NE + YCKV))[lane];
        const float a = __uint_as_float(w.x << 16), b = __uint_as_float(w.x & 0xffff0000u), c = __uint_as_float(w.y << 16), d = __uint_as_float(w.y & 0xffff0000u);
        const float rstd = 1.0f / sqrtf(wave_sum(a * a + b * b + c * c + d * d) * (1.f / 256.f) + EPS);
        const f32x4 gg = ((const f32x4*)gn)[lane]; u32x2 o; o.x = pk2(a * rstd * gg.x, b * rstd * gg.y); o.y = pk2(c * rstd * gg.z, d * rstd * gg.w);
        ((u32x2*)(O + (size_t)m * 256))[lane] = o;
    }
}

__device__ __forceinline__ unsigned f2ord(float f) { const unsigned u = __float_as_uint(f + 0.0f); return (u & 0x80000000u) ? ~u : (u | 0x80000000u); }
__device__ __forceinline__ void phase_idx(const Ctx& F) {
    const bf16_t* Y = (const bf16_t*)(F.ws + WS_BIG + BG_Y);
    unsigned* MASK = (unsigned*)(F.ws + WS_BIG + BG_MASK);
    unsigned short* LIST = (unsigned short*)(F.ws + WS_A + AF_LIST);
    int* CNT = (int*)(F.ws + WS_A + AF_CNT);
    LAS float* sc = (LAS float*)F.lds;
    LAS unsigned* hist = (LAS unsigned*)(F.lds + HIST_OFF) + F.wave * 264;
    const int tid = F.tid, lane = F.lane, wave = F.wave;
    for (int unit = F.bid; unit < T / 8; unit += F.nblk) {
        const int b = unit / 512, qg = 511 - (unit % 512); const int t0 = qg * 8, nkeys = t0 + 8;
        const size_t rowb = (size_t)b * SEQ;
        for (int s = tid; s < nkeys; s += NTHREADS) {
            float kf[64];
            { const u32x4* kp = (const u32x4*)(Y + (rowb + s) * NE + YKI);
#pragma unroll
              for (int c = 0; c < 8; ++c) { const u32x4 w = kp[c]; kf[8 * c + 0] = __uint_as_float(w.x << 16); kf[8 * c + 1] = __uint_as_float(w.x & 0xffff0000u); kf[8 * c + 2] = __uint_as_float(w.y << 16); kf[8 * c + 3] = __uint_as_float(w.y & 0xffff0000u);
                  kf[8 * c + 4] = __uint_as_float(w.z << 16); kf[8 * c + 5] = __uint_as_float(w.z & 0xffff0000u); kf[8 * c + 6] = __uint_as_float(w.w << 16); kf[8 * c + 7] = __uint_as_float(w.w & 0xffff0000u); } }
            for (int q = 0; q < 8; ++q) {
                const bf16_t* qrow = Y + (rowb + t0 + q) * NE;
                float score = 0.f;
                for (int h = 0; h < 8; ++h) {
                    const u32x4* qp = (const u32x4*)(qrow + YQI + h * 64); float dot = 0.f;
#pragma unroll
                    for (int c = 0; c < 8; ++c) { const u32x4 w = qp[c];
                        dot += kf[8 * c + 0] * __uint_as_float(w.x << 16) + kf[8 * c + 1] * __uint_as_float(w.x & 0xffff0000u) + kf[8 * c + 2] * __uint_as_float(w.y << 16) + kf[8 * c + 3] * __uint_as_float(w.y & 0xffff0000u)
                             + kf[8 * c + 4] * __uint_as_float(w.z << 16) + kf[8 * c + 5] * __uint_as_float(w.z & 0xffff0000u) + kf[8 * c + 6] * __uint_as_float(w.w << 16) + kf[8 * c + 7] * __uint_as_float(w.w & 0xffff0000u); }
                    score += fmaxf(dot, 0.f) * bf2f(qrow[YWI + h]);
                }
                sc[q * 4096 + s] = score;
            }
        }
        __syncthreads();
        {
            const int t = t0 + wave, n = t + 1; const size_t m = rowb + t;
            LAS float* row = sc + wave * 4096;
            unsigned* mrow = MASK + m * 128; unsigned short* lrow = LIST + m * 256;
            if (n <= 256) {
                for (int w = lane; w < 128; w += 64) { const int lo = w * 32; unsigned bits = 0u; if (lo + 31 <= t) bits = 0xffffffffu; else if (lo <= t) bits = (t - lo == 31) ? 0xffffffffu : ((1u << (t - lo + 1)) - 1u); mrow[w] = bits; }
                for (int i = lane; i < 256; i += 64) lrow[i] = (unsigned short)(i < n ? i : 0);
                if (lane == 0) CNT[m] = n;
            } else {
                unsigned prefix = 0u; int kk = 256;
                for (int pass = 0; pass < 4; ++pass) {
                    const int shift = 24 - 8 * pass;
                    for (int i = lane; i < 264; i += 64) hist[i] = 0u;
                    asm volatile("s_waitcnt lgkmcnt(0)" ::: "memory");
                    for (int i = lane; i < n; i += 64) { const unsigned u = f2ord(row[i]); const bool match = (pass == 0) || ((u >> (shift + 8)) == (prefix >> (shift + 8)));
                        if (match) atomicAdd((unsigned*)&hist[(u >> shift) & 255u], 1u); }
                    asm volatile("s_waitcnt lgkmcnt(0)" ::: "memory");
                    const unsigned c0 = hist[4 * lane], c1 = hist[4 * lane + 1], c2 = hist[4 * lane + 2], c3 = hist[4 * lane + 3];
                    const unsigned tot = c0 + c1 + c2 + c3; unsigned suf = tot;
#pragma unroll
                    for (int o = 1; o < 64; o <<= 1) { const unsigned v = __shfl_down(suf, o); if (lane + o < 64) suf += v; }
                    unsigned above = suf - tot;
                    const unsigned cs[4] = {c0, c1, c2, c3};
#pragma unroll
                    for (int bb = 3; bb >= 0; --bb) { if ((int)above < kk && (int)(above + cs[bb]) >= kk) { hist[256] = (unsigned)(4 * lane + bb); hist[257] = (unsigned)(kk - (int)above); } above += cs[bb]; }
                    asm volatile("s_waitcnt lgkmcnt(0)" ::: "memory");
                    const unsigned dsel = hist[256]; kk = (int)hist[257];
                    prefix |= dsel << shift;
                    asm volatile("s_waitcnt lgkmcnt(0)" ::: "memory");
                }
                int cnt = 0, eqseen = 0;
                for (int base = 0; base < 4096; base += 64) {
                    const int i = base + lane; bool gt = false, eq = false;
                    if (i < n) { const unsigned u = f2ord(row[i]); gt = u > prefix; eq = (u == prefix); }
                    const unsigned long long beq = __ballot(eq); const unsigned long long lt = (1ull << lane) - 1ull;
                    const int rk = eqseen + __popcll(beq & lt);
                    const bool sel = gt || (eq && rk < kk);
                    const unsigned long long bs = __ballot(sel);
                    if (sel) lrow[cnt + __popcll(bs & lt)] = (unsigned short)i;
                    if (lane == 0) { mrow[base / 32] = (unsigned)bs; mrow[base / 32 + 1] = (unsigned)(bs >> 32); }
                    cnt += __popcll(bs); eqseen += __popcll(beq);
                }
                if (lane == 0) CNT[m] = cnt;
            }
        }
        __syncthreads();
    }
}

__device__ __forceinline__ void phase_att_naive(const Ctx& F) {
    const bf16_t* Y = (const bf16_t*)(F.ws + WS_BIG + BG_Y); const bf16_t* KV = (const bf16_t*)(F.ws + WS_MIX);
    const unsigned short* LIST = (const unsigned short*)(F.ws + WS_A + AF_LIST); const int* CNT = (const int*)(F.ws + WS_A + AF_CNT);
    bf16_t* C = (bf16_t*)(F.ws + WS_MIX + 32 * MiB);
    LAS float* wq = (LAS float*)F.lds + F.wave * 1024;
    LAS float* wp = wq + 64; LAS int* wi = (LAS int*)(wq + 64 + 256);
    const int gw = F.bid * NWAVES + F.wave, NGW = F.nblk * NWAVES, lane = F.lane;
    for (int unit = gw; unit < T * 8; unit += NGW) {
        const int m = unit >> 3, h = unit & 7, b = m / SEQ; const size_t rowb = (size_t)b * SEQ;
        wq[lane] = bf2f(Y[(size_t)m * NE + YQ + h * 64 + lane]);
        const int cnt = CNT[m];
        asm volatile("s_waitcnt lgkmcnt(0)" ::: "memory");
        float s[4]; int id[4]; float mx = -INFINITY;
#pragma unroll
        for (int j = 0; j < 4; ++j) { const int jj = lane + 64 * j; id[j] = LIST[(size_t)m * 256 + jj]; s[j] = -INFINITY;
            if (jj < cnt) { const u32x4* kp = (const u32x4*)(KV + (rowb + id[j]) * 1024 + h * 64); float dot = 0.f;
#pragma unroll
                for (int c = 0; c < 8; ++c) { const u32x4 w = kp[c]; const f32x4 q0 = *(const LAS f32x4*)(wq + 8 * c), q1 = *(const LAS f32x4*)(wq + 8 * c + 4);
                    dot += q0.x * __uint_as_float(w.x << 16) + q0.y * __uint_as_float(w.x & 0xffff0000u) + q0.z * __uint_as_float(w.y << 16) + q0.w * __uint_as_float(w.y & 0xffff0000u)
                         + q1.x * __uint_as_float(w.z << 16) + q1.y * __uint_as_float(w.z & 0xffff0000u) + q1.z * __uint_as_float(w.w << 16) + q1.w * __uint_as_float(w.w & 0xffff0000u); }
                s[j] = dot; }
            mx = fmaxf(mx, s[j]); }
        mx = wave_max(mx); float l = 0.f;
#pragma unroll
        for (int j = 0; j < 4; ++j) { const float p = (lane + 64 * j < cnt) ? exp2f(s[j] - mx) : 0.f; l += p; wp[lane + 64 * j] = p; wi[lane + 64 * j] = id[j]; }
        l = wave_sum(l);
        asm volatile("s_waitcnt lgkmcnt(0)" ::: "memory");
        float o = 0.f;
        for (int j = 0; j < cnt; ++j) o += wp[j] * bf2f(KV[(rowb + wi[j]) * 1024 + 512 + h * 64 + lane]);
        C[(size_t)m * 1024 + h * 64 + lane] = (bf16_t)f2bf(o / l);
        asm volatile("s_waitcnt lgkmcnt(0)" ::: "memory");
    }
}

template <int MODE> __device__ __forceinline__ void phase_lru(const Ctx& F) {
    const bf16_t* Y = (const bf16_t*)(F.ws + WS_BIG + BG_Y); bf16_t* C = (bf16_t*)(F.ws + WS_MIX + 32 * MiB);
    float* CA = (float*)(F.ws + WS_LRUA); float* CH = (float*)(F.ws + WS_LRUH);
    const int gw = F.bid * NWAVES + F.wave, NGW = F.nblk * NWAVES, lane = F.lane;
    for (int unit = gw; unit < NB * 8 * 64; unit += NGW) {
        const int g = unit & 7, ck = (unit >> 3) & 63, b = unit >> 9; const int ch = g * 64 + lane; const size_t rowb = (size_t)b * SEQ;
        float wra[64], wri[64];
#pragma unroll
        for (int i = 0; i < 64; ++i) { wra[i] = inp(I_ERA)[(size_t)(g * 64 + i) * 64 + lane]; wri[i] = inp(I_ERI)[(size_t)(g * 64 + i) * 64 + lane]; }
        const float bra = inp(I_EBRA)[ch], bri = inp(I_EBRI)[ch], lam = inp(I_ELAM)[ch], cb = inp(I_ECB)[ch];
        const float cw0 = inp(I_ECW)[ch], cw1 = inp(I_ECW)[512 + ch], cw2 = inp(I_ECW)[1024 + ch], cw3 = inp(I_ECW)[1536 + ch];
        const float spl = log1pf(__expf(-lam));
        const int t0 = ck * 64;
        float x3 = (t0 >= 3) ? bf2f(Y[(rowb + t0 - 3) * NE + YXB + ch]) : 0.f, x2 = (t0 >= 2) ? bf2f(Y[(rowb + t0 - 2) * NE + YXB + ch]) : 0.f, x1 = (t0 >= 1) ? bf2f(Y[(rowb + t0 - 1) * NE + YXB + ch]) : 0.f;
        float hst = 0.f, aprod = 1.f;
        if (MODE == 1) { for (int c = 0; c < ck; ++c) { const float a = CA[((size_t)b * 64 + c) * 512 + ch], hh = CH[((size_t)b * 64 + c) * 512 + ch]; hst = a * hst + hh; } }
        for (int tt = 0; tt < 64; ++tt) {
            const size_t m = rowb + t0 + tt;
            const float x0 = bf2f(Y[m * NE + YXB + ch]);
            const float xc = cw0 * x3 + cw1 * x2 + cw2 * x1 + cw3 * x0 + cb;
            x3 = x2; x2 = x1; x1 = x0;
            float ra = bra, ri = bri;
#pragma unroll
            for (int i = 0; i < 64; ++i) { const float xi = __uint_as_float(__builtin_amdgcn_readlane(__float_as_uint(xc), i)); ra += xi * wra[i]; ri += xi * wri[i]; }
            const float r = sigmoidf_(ra), ig = sigmoidf_(ri);
            const float log_a = -8.0f * r * spl; const float a = __expf(log_a); const float bb = sqrtf(-expm1f(2.0f * log_a)) * (ig * xc);
            hst = a * hst + bb; aprod *= a;
            if (MODE == 1) { const float gt = bf2f(Y[m * NE + YGATE + ch]); const float u = 0.7978845608028654f * (gt + 0.044715f * gt * gt * gt); const float ge = 0.5f * gt * (1.0f + tanhf(u));
                C[m * 1024 + 512 + ch] = (bf16_t)f2bf(hst * ge); }
        }
        if (MODE == 0) { CA[((size_t)b * 64 + ck) * 512 + ch] = aprod; CH[((size_t)b * 64 + ck) * 512 + ch] = hst; }
    }
}

__device__ __forceinline__ void phase_gla_a(const Ctx& F) {
    const bf16_t* Z = (const bf16_t*)(F.ws + WS_BIG + BG_Y);
    bf16_t* QD = (bf16_t*)(F.ws + WS_A + AF_QD); bf16_t* KI = (bf16_t*)(F.ws + WS_A + AF_KI); bf16_t* KR = (bf16_t*)(F.ws + WS_A + AF_KR); bf16_t* ATT = (bf16_t*)(F.ws + WS_A + AF_ATT);
    float* DEC = (float*)(F.ws + WS_DEC);
    LAS float* G = (LAS float*)F.lds;
    LAS float* qd = G + 64 * 128;
    LAS float* ki = qd + 64 * 129;
    LAS float* gl = ki + 64 * 129;
    const int tid = F.tid;
    for (int unit = F.bid; unit < NB * 64 * 4; unit += F.nblk) {
        const int h = unit & 3, n = (unit >> 2) & 63, b = unit >> 8; const size_t row0 = (size_t)b * SEQ + n * 64;
        for (int i = tid; i < 64 * 16; i += NTHREADS) gl[i] = bf2f(Z[(row0 + (i >> 4)) * NO + ZG + (i & 15)]);
        __syncthreads();
        for (int i = tid; i < 64 * 128; i += NTHREADS) { const int j = i >> 7, d = i & 127; float z = inp(I_OBG)[h * 128 + d];
#pragma unroll
            for (int r = 0; r < 16; ++r) z += gl[j * 16 + r] * inp(I_OG2)[r * 512 + h * 128 + d];
            const float ls = fminf(z, 0.f) - log1pf(__expf(-fabsf(z)));
            G[i] = ls * (1.0f / 16.0f); }
        __syncthreads();
        if (tid < 128) { float run = 0.f; for (int j = 0; j < 64; ++j) { run += G[j * 128 + tid]; G[j * 128 + tid] = run; } DEC[((size_t)b * 64 + n) * 512 + h * 128 + tid] = __expf(run); }
        __syncthreads();
        for (int i = tid; i < 64 * 128; i += NTHREADS) { const int j = i >> 7, d = i & 127; const size_t m = row0 + j;
            const float q = bf2f(Z[m * NO + ZQ + h * 128 + d]) * 0.08838834764831845f, k = bf2f(Z[m * NO + ZK + h * 128 + d]);
            const float gg = G[i], glast = G[63 * 128 + d];
            const float qdv = q * __expf(gg), kiv = k * __expf(-gg), krv = k * __expf(glast - gg);
            const bf16_t qb = (bf16_t)f2bf(qdv), kb = (bf16_t)f2bf(kiv);
            QD[m * 512 + h * 128 + d] = qb; KI[m * 512 + h * 128 + d] = kb; KR[m * 512 + h * 128 + d] = (bf16_t)f2bf(krv);
            qd[j * 129 + d] = bf2f(qb); ki[j * 129 + d] = bf2f(kb); }
        __syncthreads();
        for (int i = tid; i < 64 * 64; i += NTHREADS) { const int ii = i >> 6, jj = i & 63; float a = 0.f;
            if (jj <= ii) { for (int d = 0; d < 128; ++d) a += qd[ii * 129 + d] * ki[jj * 129 + d]; }
            ATT[(size_t)unit * 4096 + i] = (bf16_t)f2bf(a); }
        __syncthreads();
    }
}
__device__ __forceinline__ void phase_gla_b(const Ctx& F) {
    const bf16_t* Z = (const bf16_t*)(F.ws + WS_BIG + BG_Y);
    const bf16_t* QD = (const bf16_t*)(F.ws + WS_A + AF_QD); const bf16_t* KR = (const bf16_t*)(F.ws + WS_A + AF_KR); const bf16_t* ATT = (const bf16_t*)(F.ws + WS_A + AF_ATT);
    const float* DEC = (const float*)(F.ws + WS_DEC); bf16_t* ORAW = (bf16_t*)(F.ws + WS_MIX);
    LAS float* qd = (LAS float*)F.lds;
    LAS float* kr = qd + 64 * 129;
    LAS float* at = kr + 64 * 129;
    LAS float* vv = at + 64 * 65;
    LAS float* st = vv + 64 * 17;
    LAS float* dc = st + 128 * 17;
    const int tid = F.tid;
    for (int unit = F.bid; unit < NB * 4 * 16; unit += F.nblk) {
        const int vs = unit & 15, h = (unit >> 4) & 3, b = unit >> 6;
        for (int i = tid; i < 128 * 17; i += NTHREADS) st[i] = 0.f;
        __syncthreads();
        for (int n = 0; n < 64; ++n) {
            const size_t row0 = (size_t)b * SEQ + n * 64; const int au = ((b * 64 + n) << 2) + h;
            for (int i = tid; i < 64 * 128; i += NTHREADS) { const int j = i >> 7, d = i & 127; qd[j * 129 + d] = bf2f(QD[(row0 + j) * 512 + h * 128 + d]); kr[j * 129 + d] = bf2f(KR[(row0 + j) * 512 + h * 128 + d]); }
            for (int i = tid; i < 64 * 64; i += NTHREADS) at[(i >> 6) * 65 + (i & 63)] = bf2f(ATT[(size_t)au * 4096 + i]);
            for (int i = tid; i < 64 * 16; i += NTHREADS) vv[(i >> 4) * 17 + (i & 15)] = bf2f(Z[(row0 + (i >> 4)) * NO + ZV + h * 256 + vs * 16 + (i & 15)]);
            if (tid < 128) dc[tid] = DEC[((size_t)b * 64 + n) * 512 + h * 128 + tid];
            __syncthreads();
#pragma unroll
            for (int r = 0; r < 2; ++r) { const int idx = tid + r * NTHREADS, i = idx >> 4, v = idx & 15; float o = 0.f;
                for (int j = 0; j <= i; ++j) o += at[i * 65 + j] * vv[j * 17 + v];
                for (int d = 0; d < 128; ++d) o += qd[i * 129 + d] * st[d * 17 + v];
                ORAW[(row0 + i) * 1024 + h * 256 + vs * 16 + v] = (bf16_t)f2bf(o); }
            __syncthreads();
            float ns[4];
#pragma unroll
            for (int r = 0; r < 4; ++r) { const int idx = tid + r * NTHREADS, d = idx >> 4, v = idx & 15; float a = dc[d] * st[d * 17 + v];
                for (int j = 0; j < 64; ++j) a += kr[j * 129 + d] * vv[j * 17 + v];
                ns[r] = a; }
            __syncthreads();
#pragma unroll
            for (int r = 0; r < 4; ++r) { const int idx = tid + r * NTHREADS; st[(idx >> 4) * 17 + (idx & 15)] = ns[r]; }
            __syncthreads();
        }
    }
}
__device__ __forceinline__ void phase_gla_c(const Ctx& F) {
    const bf16_t* Z = (const bf16_t*)(F.ws + WS_BIG + BG_Y); const bf16_t* ORAW = (const bf16_t*)(F.ws + WS_MIX); bf16_t* C = (bf16_t*)(F.ws + WS_MIX + 32 * MiB);
    const float* hn = inp(I_OHN);
    const int gw = F.bid * NWAVES + F.wave, NGW = F.nblk * NWAVES, lane = F.lane;
    for (int m = gw; m < T; m += NGW) {
#pragma unroll
        for (int j = 0; j < 4; ++j) { const u32x2 w = ((const u32x2*)(ORAW + (size_t)m * 1024))[lane + 64 * j]; const u32x2 rw = ((const u32x2*)(Z + (size_t)m * NO + ZR))[lane + 64 * j];
            const float a = __uint_as_float(w.x << 16), bq = __uint_as_float(w.x & 0xffff0000u), c = __uint_as_float(w.y << 16), d = __uint_as_float(w.y & 0xffff0000u);
            const float rstd = 1.0f / sqrtf(wave_sum(a * a + bq * bq + c * c + d * d) * (1.f / 256.f) + EPS);
            const f32x4 gg = ((const f32x4*)hn)[lane];
            const float r0 = __uint_as_float(rw.x << 16), r1 = __uint_as_float(rw.x & 0xffff0000u), r2 = __uint_as_float(rw.y << 16), r3 = __uint_as_float(rw.y & 0xffff0000u);
            u32x2 o; o.x = pk2(a * rstd * gg.x * r0 * sigmoidf_(r0), bq * rstd * gg.y * r1 * sigmoidf_(r1)); o.y = pk2(c * rstd * gg.z * r2 * sigmoidf_(r2), d * rstd * gg.w * r3 * sigmoidf_(r3));
            ((u32x2*)(C + (size_t)m * 1024))[lane + 64 * j] = o; }
    }
}

__device__ __forceinline__ void phase_vt(const Ctx& F) {
    const bf16_t* KVm = (const bf16_t*)(F.ws + WS_KVM); bf16_t* Vt = (bf16_t*)(F.ws + WS_VT);
    const int gt = F.bid * NTHREADS + F.tid, NGT = F.nblk * NTHREADS;
    for (int i = gt; i < 1024 * 1024; i += NGT) { const int mm = i & 255, d = (i >> 8) & 255, h = (i >> 16) & 3, b = i >> 18;
        Vt[i] = KVm[(size_t)(b * 256 + mm) * 2048 + 1024 + h * 256 + d]; }
}
__device__ __forceinline__ void phase_xsoftmax(const Ctx& F) {
    const bf16_t* S = (const bf16_t*)(F.ws + WS_BIG + BG_S); bf16_t* P = (bf16_t*)(F.ws + WS_MIX);
    const int gw = F.bid * NWAVES + F.wave, NGW = F.nblk * NWAVES, lane = F.lane;
    for (int m = gw; m < T; m += NGW) {
#pragma unroll
        for (int j = 0; j < 4; ++j) { const u32x2 w = ((const u32x2*)(S + (size_t)m * 1024))[lane + 64 * j];
            const float a = __uint_as_float(w.x << 16), b = __uint_as_float(w.x & 0xffff0000u), c = __uint_as_float(w.y << 16), d = __uint_as_float(w.y & 0xffff0000u);
            const float mx = wave_max(fmaxf(fmaxf(a, b), fmaxf(c, d)));
            const float ea = __expf(a - mx), eb = __expf(b - mx), ec = __expf(c - mx), ed = __expf(d - mx);
            const float inv = 1.0f / wave_sum((ea + eb) + (ec + ed));
            u32x2 o; o.x = pk2(ea * inv, eb * inv); o.y = pk2(ec * inv, ed * inv);
            ((u32x2*)(P + (size_t)m * 1024))[lane + 64 * j] = o; }
    }
}

enum Kind { K_PREP = 0, K_SWIGLU, K_GEMM, K_NORM, K_CKVN, K_IDX, K_ATT, K_LRU_A, K_LRU_B, K_GLA_A, K_GLA_B, K_GLA_C, K_VT, K_XSOFTMAX };
enum Op { OP_UP1 = 0, OP_DN1, OP_N1, OP_IN, OP_M0, OP_M1, OP_M2, OP_M3, OP_M4, OP_M5, OP_OUT, OP_N2, OP_XQ, OP_XKV, OP_XVT, OP_XS, OP_XSM, OP_XO, OP_XOUT, OP_N3, OP_UP2, OP_DN2, OP_N4, OP_COUNT };
constexpr int NPHASES = 1 + 2 * OP_COUNT;

struct Desc { int kind; pg8::Gemm g; bf16_t* O; int ldc; float scale; const bf16_t* Fb; const float* hin; float coef; const float* gpost; const float* gpre; };
__device__ __forceinline__ void st_ptr(LAS unsigned* p, const void* q) { const unsigned long long v = (unsigned long long)(uintptr_t)q; p[0] = (unsigned)v; p[1] = (unsigned)(v >> 32); }
__device__ __forceinline__ unsigned ld_u(const LAS unsigned* p) { return (unsigned)__builtin_amdgcn_readfirstlane((int)p[0]); }
__device__ __forceinline__ const void* ld_ptr(const LAS unsigned* p) { const unsigned long long v = (unsigned long long)ld_u(p) | ((unsigned long long)ld_u(p + 1) << 32); return (const void*)(uintptr_t)v; }
__device__ __forceinline__ void desc_store(LAS unsigned* t, const Desc& d) {
    t[0] = (unsigned)d.kind; st_ptr(t + 1, d.g.A); st_ptr(t + 3, d.g.Bt); t[5] = d.g.lda; t[6] = d.g.ldb; t[7] = d.g.K; t[8] = d.g.nM; t[9] = d.g.nN; t[10] = d.g.a_pn_off; t[11] = d.g.b_pn_off; t[12] = d.g.b_batch_off; t[13] = d.g.bshift;
    st_ptr(t + 14, d.O); t[16] = d.ldc; t[17] = __float_as_uint(d.scale); st_ptr(t + 18, d.Fb); st_ptr(t + 20, d.hin); t[22] = __float_as_uint(d.coef); st_ptr(t + 23, d.gpost); st_ptr(t + 25, d.gpre);
}
__device__ __forceinline__ Desc desc_load(const LAS unsigned* t) {
    Desc d; d.kind = (int)ld_u(t); d.g.A = (const bf16_t*)ld_ptr(t + 1); d.g.Bt = (const bf16_t*)ld_ptr(t + 3); d.g.lda = ld_u(t + 5); d.g.ldb = ld_u(t + 6); d.g.K = ld_u(t + 7); d.g.nM = ld_u(t + 8); d.g.nN = ld_u(t + 9);
    d.g.a_pn_off = ld_u(t + 10); d.g.b_pn_off = ld_u(t + 11); d.g.b_batch_off = ld_u(t + 12); d.g.bshift = ld_u(t + 13);
    d.O = (bf16_t*)ld_ptr(t + 14); d.ldc = ld_u(t + 16); d.scale = __uint_as_float(ld_u(t + 17)); d.Fb = (const bf16_t*)ld_ptr(t + 18); d.hin = (const float*)ld_ptr(t + 20); d.coef = __uint_as_float(ld_u(t + 22));
    d.gpost = (const float*)ld_ptr(t + 23); d.gpre = (const float*)ld_ptr(t + 25); return d;
}

__device__ __forceinline__ Desc make_desc(const Ctx& F, int ph) {
    Desc d; d.kind = -1; d.O = nullptr; d.ldc = 0; d.scale = 1.f; d.Fb = nullptr; d.hin = nullptr; d.coef = 0.f; d.gpost = nullptr; d.gpre = nullptr;
    d.g = pg8::plain_gemm(nullptr, 0, nullptr, 0, 256, 256, 256);
    if (ph == 0) { d.kind = K_PREP; return d; }
    const int l = (ph - 1) / OP_COUNT, op = (ph - 1) % OP_COUNT;
    unsigned char* ws = F.ws; const float* nrm = inp(I_NORMS) + (size_t)l * 9 * D;
    bf16_t* A = (bf16_t*)(ws + WS_A); bf16_t* Fb = (bf16_t*)(ws + WS_F); bf16_t* BIG = (bf16_t*)(ws + WS_BIG); bf16_t* MIX = (bf16_t*)(ws + WS_MIX); bf16_t* Cc = (bf16_t*)(ws + WS_MIX + 32 * MiB);
    const unsigned char* W = ws + WS_W;
    switch (op) {
    case OP_UP1: case OP_UP2: { const int i = (op == OP_UP2); d.kind = K_SWIGLU; d.g = pg8::plain_gemm(A, D, (const bf16_t*)(W + W_GU) + (size_t)(l * 2 + i) * 2 * FF * D, D, T, 2 * FF, D); d.O = BIG; d.ldc = FF; break; }
    case OP_DN1: case OP_DN2: { const int i = (op == OP_DN2); d.kind = K_GEMM; d.g = pg8::plain_gemm(BIG, FF, (const bf16_t*)(W + W_DN) + (size_t)(l * 2 + i) * D * FF, FF, T, D, FF); d.O = Fb; d.ldc = D; break; }
    case OP_N1: d.kind = K_NORM; d.Fb = Fb; d.hin = (l == 0) ? inp(I_X) : F.out; d.coef = 0.5f; d.gpost = nrm + N_FFN1_POST * D; d.gpre = nrm + N_MIX_PRE * D; break;
    case OP_IN: d.kind = K_GEMM; if (l == 0) d.g = pg8::plain_gemm(A, D, (const bf16_t*)(W + W_EIN), D, T, NE, D); else d.g = pg8::plain_gemm(A, D, (const bf16_t*)(W + W_OIN), D, T, NO, D);
                d.O = BIG; d.ldc = (l == 0) ? NE : NO; break;
    case OP_M0: d.kind = (l == 0) ? K_CKVN : K_GLA_A; break;
    case OP_M1: if (l == 0) { d.kind = K_GEMM; d.g = pg8::plain_gemm((const bf16_t*)(ws + WS_BIG + BG_CKVN), 256, (const bf16_t*)(W + W_UKV), 256, T, 1024, 256); d.O = MIX; d.ldc = 1024; } else d.kind = K_GLA_B; break;
    case OP_M2: d.kind = (l == 0) ? K_IDX : K_GLA_C; break;
    case OP_M3: d.kind = (l == 0) ? K_ATT : -1; break;
    case OP_M4: d.kind = (l == 0) ? K_LRU_A : -1; break;
    case OP_M5: d.kind = (l == 0) ? K_LRU_B : -1; break;
    case OP_OUT: d.kind = K_GEMM; d.g = pg8::plain_gemm(Cc, D, (const bf16_t*)(W + (l == 0 ? W_EOUT : W_OOUT)), D, T, D, D); d.O = Fb; d.ldc = D; break;
    case OP_N2: d.kind = K_NORM; d.Fb = Fb; d.hin = F.out; d.coef = 1.0f; d.gpost = nrm + N_MIX_POST * D; d.gpre = nrm + N_XA_PRE * D; break;
    case OP_XQ: d.kind = K_GEMM; d.g = pg8::plain_gemm(A, D, (const bf16_t*)(W + W_Q) + (size_t)l * D * D, D, T, D, D); d.O = BIG; d.ldc = D; break;
    case OP_XKV: d.kind = K_GEMM; d.g = pg8::plain_gemm((const bf16_t*)(ws + (l ? WS_MEMN1 : WS_MEMN0)), D, (const bf16_t*)(W + W_KV) + (size_t)l * 2 * D * D, D, 1024, 2 * D, D); d.O = (bf16_t*)(ws + WS_KVM); d.ldc = 2 * D; break;
    case OP_XVT: d.kind = K_VT; break;
    case OP_XS: { d.kind = K_GEMM; pg8::Gemm g; g.A = BIG; g.Bt = (const bf16_t*)(ws + WS_KVM); g.lda = D; g.ldb = 2 * D; g.K = 256; g.nM = T / 256; g.nN = 4; g.a_pn_off = 256; g.b_pn_off = 256; g.b_batch_off = 256 * 2 * D; g.bshift = 4;
                  d.g = g; d.O = (bf16_t*)(ws + WS_BIG + BG_S); d.ldc = D; d.scale = 0.0625f; break; }
    case OP_XSM: d.kind = K_XSOFTMAX; break;
    case OP_XO: { d.kind = K_GEMM; pg8::Gemm g; g.A = MIX; g.Bt = (const bf16_t*)(ws + WS_VT); g.lda = D; g.ldb = 256; g.K = 256; g.nM = T / 256; g.nN = 4; g.a_pn_off = 256; g.b_pn_off = 256 * 256; g.b_batch_off = 4 * 256 * 256; g.bshift = 4;
                  d.g = g; d.O = BIG; d.ldc = D; break; }
    case OP_XOUT: d.kind = K_GEMM; d.g = pg8::plain_gemm(BIG, D, (const bf16_t*)(W + W_O) + (size_t)l * D * D, D, T, D, D); d.O = Fb; d.ldc = D; break;
    case OP_N3: d.kind = K_NORM; d.Fb = Fb; d.hin = F.out; d.coef = 1.0f; d.gpost = nrm + N_XA_POST * D; d.gpre = nrm + N_FFN2_PRE * D; break;
    case OP_N4: d.kind = K_NORM; d.Fb = Fb; d.hin = F.out; d.coef = 0.5f; d.gpost = nrm + N_FFN2_POST * D; d.gpre = (l == 0) ? (inp(I_NORMS) + (size_t)(9 + N_FFN1_PRE) * D) : nullptr; break;
    default: break;
    }
    return d;
}

__global__ void __launch_bounds__(NTHREADS, 2) mk_fwd(Args args) {
    extern __shared__ __attribute__((aligned(16))) unsigned char lds_raw[];
    Ctx F; F.lds = (LAS unsigned char*)lds_raw; F.tid = threadIdx.x; F.lane = F.tid & 63; F.wave = __builtin_amdgcn_readfirstlane(F.tid >> 6);
    F.nblk = gridDim.x; F.bid = blockIdx.x; F.out = args.out; F.ws = args.ws;
    volatile LAS unsigned* MISC = (volatile LAS unsigned*)(F.lds + MISC_OFF);
    for (int u = F.tid; u < (LDS_BYTES - MISC_OFF) / 4; u += NTHREADS) MISC[u] = 0u;
    __syncthreads();
    XcdBarrier bar; bar.bar = (unsigned*)(args.ws + WS_CTL) + CW_BAR; bar.x = 0; bar.st = nullptr;
#if !MK_PER_PHASE
    bar = xcd_barrier_post((unsigned*)(args.ws + WS_CTL) + CW_BAR, MISC + 8);
#endif
    F.kp = (const __attribute__((address_space(4))) void*)__builtin_amdgcn_kernarg_segment_ptr();
    if (F.tid < NPHASES) { const Desc dd = make_desc(F, F.tid); desc_store((LAS unsigned*)(F.lds + DESC_OFF) + F.tid * DESC_WORDS, dd); }
    __syncthreads();
    const Ctx F0 = F;
    for (int ph = args.ph_lo; ph < args.ph_hi; ++ph) {
        Ctx F = F0;
        asm volatile("" : "+s"(F.ws), "+s"(F.out), "+s"(F.kp), "+s"(F.wave), "+s"(F.nblk), "+s"(F.bid), "+v"(F.tid), "+v"(F.lane));
        const Desc d = desc_load((const LAS unsigned*)(F.lds + DESC_OFF) + ph * DESC_WORDS);
        if (d.kind < 0) continue;
#ifndef PH_ENABLE
#define PH_ENABLE 0xffffffffu
#endif
#define EN(k) (((PH_ENABLE) >> (k)) & 1u)
        switch (d.kind) {
        case K_PREP: if constexpr (EN(K_PREP)) { phase_prep(F); } break;
#if NAIVE_GEMM
        case K_SWIGLU: { pg8::EpiSwiglu E{d.O, d.ldc}; pg8::gemm_naive<2>(F.lds, d.g, E, F.nblk, F.bid, F.tid); break; }
        case K_GEMM: { pg8::EpiBf16 E{d.O, d.ldc, d.scale}; pg8::gemm_naive<1>(F.lds, d.g, E, F.nblk, F.bid, F.tid); break; }
#else
        case K_SWIGLU: case K_GEMM: if constexpr (EN(K_GEMM)) {
            pg8::StaticOrder S; S.init(d.g.nM, d.g.nN, F.nblk, F.bid); pg8::EpiAny E{d.O, d.ldc, d.scale, d.kind == K_SWIGLU ? 1 : 0}; pg8::gemm_phase<pg8::EpiAny, true>(F.lds, d.g, S, E, F.tid);
            break; }
#endif
        case K_NORM: if constexpr (EN(K_NORM)) { phase_norm(F, d.Fb, d.hin, F.out, d.coef, d.gpost, d.gpre, (bf16_t*)(F.ws + WS_A)); } break;
        case K_CKVN: if constexpr (EN(K_CKVN)) { phase_ckvn(F); } break;
        case K_IDX: if constexpr (EN(K_IDX)) { phase_idx(F); } break;
        case K_ATT: if constexpr (EN(K_ATT)) { phase_att_naive(F); } break;
        case K_LRU_A: if constexpr (EN(K_LRU_A)) { phase_lru<0>(F); } break;
        case K_LRU_B: if constexpr (EN(K_LRU_B)) { phase_lru<1>(F); } break;
        case K_GLA_A: if constexpr (EN(K_GLA_A)) { phase_gla_a(F); } break;
        case K_GLA_B: if constexpr (EN(K_GLA_B)) { phase_gla_b(F); } break;
        case K_GLA_C: if constexpr (EN(K_GLA_C)) { phase_gla_c(F); } break;
        case K_VT: if constexpr (EN(K_VT)) { phase_vt(F); } break;
        case K_XSOFTMAX: if constexpr (EN(K_XSOFTMAX)) { phase_xsoftmax(F); } break;
        default: break;
        }
#if !MK_PER_PHASE
        if (ph + 1 < args.ph_hi) {
            if (ph == 0) { cg::this_grid().sync(); }
            xcd_barrier(bar);
        }
#endif
    }
}

extern "C" void kernel_launch(void* const* d_in, const int* in_sizes, int n_in, void* d_out, int out_size, void* d_ws, size_t ws_size, hipStream_t stream) {
    static int grid = 0;
    if (grid == 0) {
        if (n_in != 25 || in_sizes[0] != T * D || out_size != T * D || ws_size < WS_END) { fprintf(stderr, "kernel_launch: unexpected shapes (n_in %d, in0 %d, out %d, ws %zu); nothing launched\n", n_in, n_in > 0 ? in_sizes[0] : -1, out_size, ws_size); grid = -1; return; }
        int dev = 0, cus = 0, per_cu = 0;
        if (hipGetDevice(&dev) != hipSuccess || hipDeviceGetAttribute(&cus, hipDeviceAttributeMultiprocessorCount, dev) != hipSuccess) { grid = -1; return; }
        if (hipFuncSetAttribute((const void*)mk_fwd, hipFuncAttributeMaxDynamicSharedMemorySize, LDS_BYTES) != hipSuccess) { fprintf(stderr, "kernel_launch: hipFuncSetAttribute failed\n"); grid = -1; return; }
        if (hipOccupancyMaxActiveBlocksPerMultiprocessor(&per_cu, (const void*)mk_fwd, NTHREADS, LDS_BYTES) != hipSuccess || per_cu < 1) { fprintf(stderr, "kernel_launch: occupancy query says %d\n", per_cu); (void)hipGetLastError(); grid = -1; return; }
        grid = cus;
    }
    if (grid < 0) return;
    (void)hipMemsetAsync((char*)d_ws + WS_CTL, 0, CTL_BYTES, stream);
    Args a{};
    for (int i = 0; i < 25; ++i) a.in[i] = (const float*)d_in[i];
    a.out = (float*)d_out; a.ws = (unsigned char*)d_ws;
#if MK_PER_PHASE
    for (int ph = 0; ph < NPHASES; ++ph) { a.ph_lo = ph; a.ph_hi = ph + 1; hipLaunchKernelGGL(mk_fwd, dim3(grid), dim3(NTHREADS), LDS_BYTES, stream, a); }
#else
    a.ph_lo = 0; a.ph_hi = NPHASES;
    void* kargs[] = {&a};
    hipError_t e = hipLaunchCooperativeKernel((const void*)mk_fwd, dim3(grid), dim3(NTHREADS), kargs, LDS_BYTES, stream);
    if (e != hipSuccess) fprintf(stderr, "cooperative launch failed: %s (grid %d)\n", hipGetErrorString(e), grid);
#endif
}
```

```cpp
#include <hip/hip_runtime.h>
#include <hip/hip_cooperative_groups.h>
#include <hip/hip_bf16.h>
#include <cmath>
#include <cstdio>
#include <cstdint>
namespace cg = cooperative_groups;

#ifndef MK_PER_PHASE
#define MK_PER_PHASE 0
#endif
#ifndef NAIVE_GEMM
#define NAIVE_GEMM 0
#endif

#define LAS __attribute__((address_space(3)))
#define GAS __attribute__((address_space(1)))
typedef unsigned short bf16_t;
typedef short bf16x8 __attribute__((ext_vector_type(8)));
typedef float f32x4 __attribute__((ext_vector_type(4)));
typedef float f32x2 __attribute__((ext_vector_type(2)));
typedef unsigned u32x4 __attribute__((ext_vector_type(4)));
typedef unsigned u32x2 __attribute__((ext_vector_type(2)));

constexpr int NB = 4, SEQ = 4096, T = NB * SEQ, D = 1024, FF = 2816;
constexpr int NE = 2560, NO = 3328;
constexpr int YQ = 0, YCKV = 512, YQI = 768, YKI = 1280, YWI = 1344, YGATE = 1536, YXB = 2048;
constexpr int ZQ = 0, ZK = 512, ZV = 1024, ZG = 2048, ZR = 2304;
constexpr float EPS = 1e-6f;
constexpr float C2 = 0.125f * 1.4426950408889634f;

constexpr size_t MiB = 1u << 20;
constexpr size_t WS_CTL = 0, CTL_BYTES = 1 * MiB;
constexpr size_t WS_MEMN0 = 1 * MiB, WS_MEMN1 = 3 * MiB, WS_KVM = 5 * MiB, WS_VT = 9 * MiB, WS_LRUA = 11 * MiB, WS_LRUH = 11 * MiB + 512 * 1024, WS_DEC = 12 * MiB;
constexpr size_t WS_W = 17 * MiB;
constexpr size_t W_GU = 0, W_DN = 44 * MiB, W_Q = 66 * MiB, W_KV = 70 * MiB, W_O = 78 * MiB, W_EIN = 82 * MiB, W_UKV = 87 * MiB, W_EOUT = 87 * MiB + 512 * 1024,
                 W_OIN = 89 * MiB + 512 * 1024, W_OOUT = 96 * MiB;
constexpr size_t WS_A = 115 * MiB, WS_F = 147 * MiB;
constexpr size_t WS_BIG = 179 * MiB;
constexpr size_t WS_MIX = 283 * MiB;
constexpr size_t WS_END = 347 * MiB;
constexpr size_t AF_LIST = 0, AF_CNT = 8 * MiB;
constexpr size_t AF_QD = 0, AF_KI = 16 * MiB, AF_KR = 32 * MiB, AF_ATT = 48 * MiB;
constexpr size_t BG_Y = 0, BG_CKVN = 80 * MiB, BG_MASK = 88 * MiB;
constexpr size_t BG_Q = 0, BG_S = 32 * MiB;
constexpr size_t BG_H = 0;
constexpr int CW_BAR = 4096;

__device__ __forceinline__ float bf2f(bf16_t v) { return __uint_as_float((unsigned)v << 16); }
__device__ __forceinline__ unsigned f2bf(float f) { unsigned u = __float_as_uint(f); return (u + 0x7fffu + ((u >> 16) & 1u)) >> 16; }
__device__ __forceinline__ unsigned pk2(float lo, float hi) { return f2bf(lo) | (f2bf(hi) << 16); }
__device__ __forceinline__ float wave_sum(float v) {
#pragma unroll
    for (int o = 1; o < 64; o <<= 1) v += __shfl_xor(v, o);
    return v;
}
__device__ __forceinline__ float wave_max(float v) {
#pragma unroll
    for (int o = 1; o < 64; o <<= 1) v = fmaxf(v, __shfl_xor(v, o));
    return v;
}
__device__ __forceinline__ float sigmoidf_(float x) { return 1.0f / (1.0f + __expf(-x)); }

namespace pg8 {
constexpr int BM = 256, BK = 64, HALF = 128, HTB = HALF * BK * 2, STAGE_BYTES = 8 * HTB, NXCD = 8, WGM = 8;
__host__ __device__ __forceinline__ int lds_byte(int r, int c) { const int st = (r >> 4) * 2 + (c >> 5), rr = r & 15, cc = c & 31, ob = rr * 64 + cc * 2; return st * 1024 + (ob ^ (((ob >> 9) & 1) << 5)); }
__host__ __device__ __forceinline__ void stage_rc(int b, int& R, int& C) { const int st = b / 1024, sb = b % 1024, swz = sb ^ (((sb >> 9) & 1) << 5); R = (st >> 1) * 16 + swz / 64; C = (st & 1) * 32 + (swz % 64) / 2; }
__host__ __device__ __forceinline__ int perm32(int rho) { const int n = rho >> 4, i = rho & 15; return 8 * (i >> 2) + 4 * n + (i & 3); }

struct Unit { int pm, pn; };
struct Gemm {
    const bf16_t* A; const bf16_t* Bt; int lda, ldb, K, nM, nN; int a_pn_off, b_pn_off, b_batch_off, bshift;
    __device__ __forceinline__ const char* a_ptr(const Unit& u) const { return (const char*)(A + (size_t)u.pm * BM * lda + (size_t)u.pn * a_pn_off); }
    __device__ __forceinline__ const char* b_ptr(const Unit& u) const { return (const char*)(Bt + (size_t)u.pn * b_pn_off + (size_t)(u.pm >> bshift) * b_batch_off); }
};
__device__ __forceinline__ Gemm plain_gemm(const bf16_t* A, int lda, const bf16_t* Bt, int ldb, int M, int N, int K) {
    Gemm g; g.A = A; g.Bt = Bt; g.lda = lda; g.ldb = ldb; g.K = K; g.nM = M / BM; g.nN = N / BM; g.a_pn_off = 0; g.b_pn_off = BM * ldb; g.b_batch_off = 0; g.bshift = 30; return g;
}
struct StaticOrder {
    int nM, nN, nwg, G, c;
    __device__ void init(int nM_, int nN_, int G_, int c_) { nM = nM_; nN = nN_; nwg = nM * nN; G = G_; c = c_; }
    __device__ bool next(int i, Unit& u) const {
        const long L = (long)i * G + c; if (L >= nwg) return false;
        int wgid = (int)L; { const int q = nwg / NXCD, r = nwg % NXCD, xcd = wgid % NXCD, off = wgid / NXCD; wgid = (xcd < r ? xcd * (q + 1) : r * (q + 1) + (xcd - r) * q) + off; }
        const int nig = WGM * nN, gid = wgid / nig, fm = gid * WGM, gsz = (nM - fm) < WGM ? (nM - fm) : WGM;
        u.pm = fm + ((wgid % nig) % gsz); u.pn = (wgid % nig) / gsz; return true;
    }
};
__device__ __forceinline__ unsigned cvt_pk_bf16(float lo, float hi) { unsigned r; asm volatile("v_cvt_pk_bf16_f32 %0, %1, %2" : "=v"(r) : "v"(lo), "v"(hi)); return r; }

struct EpiBf16 {
    static constexpr bool PERM = true;
    bf16_t* O; int ldc; float scale;
    __device__ __forceinline__ void operator()(const f32x4 (&acc)[2][2][4][2], const Unit& u, int wr, int wc, int fr, int fq) const {
        const int row0 = u.pm * BM + wr * 64 + fr, col0 = u.pn * BM + wc * 32 + 8 * fq;
#pragma unroll
        for (int ai = 0; ai < 2; ++ai)
#pragma unroll
            for (int m = 0; m < 4; ++m) { bf16_t* rowp = O + (size_t)(row0 + ai * HALF + m * 16) * ldc + col0;
#pragma unroll
                for (int bj = 0; bj < 2; ++bj) { const f32x4 v0 = acc[ai][bj][m][0] * scale, v1 = acc[ai][bj][m][1] * scale;
                    u32x4 w; w.x = cvt_pk_bf16(v0[0], v0[1]); w.y = cvt_pk_bf16(v0[2], v0[3]); w.z = cvt_pk_bf16(v1[0], v1[1]); w.w = cvt_pk_bf16(v1[2], v1[3]);
                    *(u32x4*)(rowp + bj * HALF) = w; } }
    }
    __device__ __forceinline__ void elem(int row, int col, float a0, float) const { O[(size_t)row * ldc + col] = (bf16_t)f2bf(a0 * scale); }
};
struct EpiSwiglu {
    static constexpr bool PERM = true;
    bf16_t* O; int ldc;
    __device__ __forceinline__ void operator()(const f32x4 (&acc)[2][2][4][2], const Unit& u, int wr, int wc, int fr, int fq) const {
        const int row0 = u.pm * BM + wr * 64 + fr, col0 = u.pn * HALF + wc * 32 + 8 * fq;
#pragma unroll
        for (int ai = 0; ai < 2; ++ai)
#pragma unroll
            for (int m = 0; m < 4; ++m) { bf16_t* rowp = O + (size_t)(row0 + ai * HALF + m * 16) * ldc + col0; float o[8];
#pragma unroll
                for (int n = 0; n < 2; ++n)
#pragma unroll
                    for (int i = 0; i < 4; ++i) { const float g = acc[ai][0][m][n][i], uu = acc[ai][1][m][n][i]; o[4 * n + i] = g * __builtin_amdgcn_rcpf(1.0f + __expf(-g)) * uu; }
                u32x4 w; w.x = cvt_pk_bf16(o[0], o[1]); w.y = cvt_pk_bf16(o[2], o[3]); w.z = cvt_pk_bf16(o[4], o[5]); w.w = cvt_pk_bf16(o[6], o[7]);
                *(u32x4*)rowp = w; }
    }
    __device__ __forceinline__ void elem(int row, int j, float g, float uu) const { O[(size_t)row * ldc + j] = (bf16_t)f2bf(g / (1.0f + __expf(-g)) * uu); }
};

struct EpiAny {
    static constexpr bool PERM = true;
    bf16_t* O; int ldc; float scale; int mode;
    __device__ __forceinline__ void operator()(const f32x4 (&acc)[2][2][4][2], const Unit& u, int wr, int wc, int fr, int fq) const {
        if (mode == 0) { EpiBf16 E{O, ldc, scale}; E(acc, u, wr, wc, fr, fq); } else { EpiSwiglu E{O, ldc}; E(acc, u, wr, wc, fr, fq); }
    }
};
template <class Epi, bool ALIGN_EPI>
__device__ __forceinline__ void gemm_phase(LAS unsigned char* lds, const Gemm g, const StaticOrder& S, const Epi& E, const int tid) {
    const int wid = __builtin_amdgcn_readfirstlane(tid >> 6), lane = tid & 63, wr = wid >> 2, wc = wid & 3, fr = lane & 15, fq = lane >> 4;
    const int K = g.K, nt = K / BK;
    unsigned voffA[2], voffB[2];
#pragma unroll
    for (int i = 0; i < 2; ++i) { int R, C; stage_rc(tid * 16 + i * 8192, R, C); const int Rb = Epi::PERM ? ((R & ~31) + perm32(R & 31)) : R;
        voffA[i] = (unsigned)(R * g.lda + C) * 2u; voffB[i] = (unsigned)(Rb * g.ldb + C) * 2u; }
    const size_t kstep = (size_t)(BK * 2);
    const size_t hstepA = (size_t)HALF * g.lda * 2, hstepB = (size_t)HALF * g.ldb * 2;
    const unsigned ldsw = (unsigned)wid * 1024u;
    const int aoff = lds_byte(wr * 64 + fr, fq * 8), boff = lds_byte(wc * 32 + fr, fq * 8);
#define PG8_SA(b, h) (((b) * 2 + (h)) * HTB)
#define PG8_SB(b, h) ((4 + (b) * 2 + (h)) * HTB)
#define PG8_STAGE(bufoff, gbase, voff) do { _Pragma("unroll") for (int _i = 0; _i < 2; ++_i) \
        __builtin_amdgcn_global_load_lds((const unsigned*)((const char*)(gbase) + (voff)[_i]), (LAS unsigned*)(lds + (bufoff) + ldsw + _i * 8192), 16, 0, 0); } while (0)
#define PG8_LDA(dst, b, h) do { _Pragma("unroll") for (int m = 0; m < 4; ++m) _Pragma("unroll") for (int k = 0; k < 2; ++k) dst[m][k] = *(const LAS bf16x8*)(lds + PG8_SA(b, h) + aoff + m * 2048 + k * 1024); } while (0)
#define PG8_LDB(dst, b, h) do { _Pragma("unroll") for (int n = 0; n < 2; ++n) _Pragma("unroll") for (int k = 0; k < 2; ++k) dst[n][k] = *(const LAS bf16x8*)(lds + PG8_SB(b, h) + boff + n * 2048 + k * 1024); } while (0)
#define PG8_MMA(ai, bj, At, Bt) do { __builtin_amdgcn_s_setprio(1); _Pragma("unroll") for (int m = 0; m < 4; ++m) _Pragma("unroll") for (int n = 0; n < 2; ++n) _Pragma("unroll") for (int k = 0; k < 2; ++k) \
        acc[ai][bj][m][n] = __builtin_amdgcn_mfma_f32_16x16x32_bf16(Bt[n][k], At[m][k], acc[ai][bj][m][n], 0, 0, 0); __builtin_amdgcn_s_setprio(0); } while (0)
#define PG8_WAIT_V(n) asm volatile("s_waitcnt vmcnt(" #n ")" ::: "memory")
#define PG8_WAIT_L(n) asm volatile("s_waitcnt lgkmcnt(" #n ")" ::: "memory")
#define PG8_BAR __builtin_amdgcn_s_barrier()
#define PG8_SCHED __builtin_amdgcn_sched_barrier(0)
    Unit cur, nxt; int ui = 0;
    if (!S.next(0, cur)) return;
    f32x4 acc[2][2][4][2];
#pragma unroll
    for (int a = 0; a < 2; ++a)
#pragma unroll
        for (int b = 0; b < 2; ++b)
#pragma unroll
            for (int m = 0; m < 4; ++m)
#pragma unroll
                for (int n = 0; n < 2; ++n) acc[a][b][m][n] = (f32x4){0.f, 0.f, 0.f, 0.f};
    bf16x8 At[4][2], B0[2][2], B1[2][2];
    const char* cA = g.a_ptr(cur); const char* cB = g.b_ptr(cur);
    PG8_STAGE(PG8_SB(0, 0), cB, voffB); PG8_STAGE(PG8_SB(0, 1), cB + hstepB, voffB); PG8_STAGE(PG8_SA(0, 0), cA, voffA); PG8_STAGE(PG8_SA(0, 1), cA + hstepA, voffA);
    if (wr == 1) PG8_BAR;
    PG8_WAIT_V(2); PG8_BAR;
    PG8_STAGE(PG8_SB(1, 0), cB + kstep, voffB); PG8_STAGE(PG8_SA(1, 0), cA + kstep, voffA); PG8_STAGE(PG8_SB(1, 1), cB + hstepB + kstep, voffB);
    PG8_WAIT_V(6); PG8_BAR;
    for (;;) {
        const bool has_next = S.next(ui + 1, nxt);
        const char* nA = has_next ? g.a_ptr(nxt) : cA; const char* nB = has_next ? g.b_ptr(nxt) : cB;
        for (int t = 0; t < nt; t += 2) {
            const bool last = (t == nt - 2);
            const char* a1 = cA + (size_t)(t + 1) * kstep;
            const char* a2 = last ? nA : cA + (size_t)(t + 2) * kstep; const char* b2 = last ? nB : cB + (size_t)(t + 2) * kstep;
            const char* a3 = a2 + kstep; const char* b3 = b2 + kstep;
            PG8_LDB(B0, 0, 0); PG8_LDB(B1, 0, 1); PG8_SCHED; PG8_LDA(At, 0, 0); PG8_STAGE(PG8_SA(1, 1), a1 + hstepA, voffA);
            PG8_WAIT_V(8); PG8_WAIT_L(0); PG8_BAR; PG8_MMA(0, 0, At, B0); PG8_MMA(0, 1, At, B1); PG8_BAR; PG8_SCHED;
            PG8_LDA(At, 0, 1); PG8_STAGE(PG8_SB(0, 0), b2, voffB); PG8_STAGE(PG8_SB(0, 1), b2 + hstepB, voffB); PG8_STAGE(PG8_SA(0, 0), a2, voffA);
            PG8_WAIT_V(8); PG8_WAIT_L(0); PG8_BAR; PG8_MMA(1, 0, At, B0); PG8_MMA(1, 1, At, B1); PG8_BAR; PG8_SCHED;
            PG8_LDB(B0, 1, 0); PG8_LDB(B1, 1, 1); PG8_SCHED; PG8_LDA(At, 1, 0); PG8_STAGE(PG8_SA(0, 1), a2 + hstepA, voffA);
            PG8_WAIT_V(8); PG8_WAIT_L(0); PG8_BAR; PG8_MMA(0, 0, At, B0); PG8_MMA(0, 1, At, B1); PG8_BAR; PG8_SCHED;
            PG8_LDA(At, 1, 1); PG8_STAGE(PG8_SB(1, 0), b3, voffB); PG8_STAGE(PG8_SB(1, 1), b3 + hstepB, voffB); PG8_STAGE(PG8_SA(1, 0), a3, voffA);
            PG8_WAIT_V(8); PG8_WAIT_L(0); PG8_BAR; PG8_MMA(1, 0, At, B0); PG8_MMA(1, 1, At, B1); PG8_BAR; PG8_SCHED;
        }
        if constexpr (ALIGN_EPI) { if (wr == 0) PG8_BAR; }
        { Unit eu = cur; asm volatile("" : "+s"(eu.pm), "+s"(eu.pn));
          E(acc, eu, wr, wc, fr, fq); }
        if (!has_next) break;
#pragma unroll
        for (int a = 0; a < 2; ++a)
#pragma unroll
            for (int b = 0; b < 2; ++b)
#pragma unroll
                for (int m = 0; m < 4; ++m)
#pragma unroll
                    for (int n = 0; n < 2; ++n) acc[a][b][m][n] = (f32x4){0.f, 0.f, 0.f, 0.f};
        cur = nxt; cA = nA; cB = nB; ++ui;
        if constexpr (ALIGN_EPI) { if (wr == 1) PG8_BAR; }
    }
    PG8_WAIT_V(0);
    if constexpr (!ALIGN_EPI) { if (wr == 0) PG8_BAR; }
    PG8_BAR;
#undef PG8_SA
#undef PG8_SB
#undef PG8_STAGE
#undef PG8_LDA
#undef PG8_LDB
#undef PG8_MMA
#undef PG8_WAIT_V
#undef PG8_WAIT_L
#undef PG8_BAR
#undef PG8_SCHED
}

template <int NPAN, class Epi>
__device__ __forceinline__ void gemm_naive(LAS unsigned char* lds8, const Gemm g, const Epi& E, int nblk, int bid, const int tid) {
    LAS float* As = (LAS float*)lds8; LAS float* Bs = As + 64 * 33;
    const int ty = tid >> 4, tx = tid & 15;
    const int ntm = g.nM * 4, ntn = (NPAN == 2) ? g.nN * 2 : g.nN * 4;
    for (int tile = bid; tile < ntm * ntn; tile += nblk) {
        const int tm = tile / ntn, tn = tile % ntn;
        Unit u; u.pm = tm >> 2; u.pn = (NPAN == 2) ? (tn >> 1) : (tn >> 2);
        const bf16_t* Ab = (const bf16_t*)g.a_ptr(u) + (size_t)(tm & 3) * 64 * g.lda;
        const bf16_t* Bb = (const bf16_t*)g.b_ptr(u) + (size_t)((NPAN == 2) ? (tn & 1) * 64 : (tn & 3) * 64) * g.ldb;
        float acc[NPAN][2][4];
#pragma unroll
        for (int p = 0; p < NPAN; ++p)
#pragma unroll
            for (int r = 0; r < 2; ++r)
#pragma unroll
                for (int i = 0; i < 4; ++i) acc[p][r][i] = 0.f;
        const int lr = tid >> 3, lk = (tid & 7) * 4;
        for (int k0 = 0; k0 < g.K; k0 += 32) {
            { const u32x2 v = *(const u32x2*)(Ab + (size_t)lr * g.lda + k0 + lk);
              As[lr * 33 + lk] = __uint_as_float(v.x << 16); As[lr * 33 + lk + 1] = __uint_as_float(v.x & 0xffff0000u); As[lr * 33 + lk + 2] = __uint_as_float(v.y << 16); As[lr * 33 + lk + 3] = __uint_as_float(v.y & 0xffff0000u); }
#pragma unroll
            for (int p = 0; p < NPAN; ++p) { const u32x2 v = *(const u32x2*)(Bb + (size_t)(lr + p * 128) * g.ldb + k0 + lk); LAS float* B_ = Bs + p * 64 * 33;
              B_[lr * 33 + lk] = __uint_as_float(v.x << 16); B_[lr * 33 + lk + 1] = __uint_as_float(v.x & 0xffff0000u); B_[lr * 33 + lk + 2] = __uint_as_float(v.y << 16); B_[lr * 33 + lk + 3] = __uint_as_float(v.y & 0xffff0000u); }
            __syncthreads();
            for (int kk = 0; kk < 32; ++kk) { const float a0 = As[ty * 33 + kk], a1 = As[(ty + 32) * 33 + kk];
#pragma unroll
                for (int p = 0; p < NPAN; ++p)
#pragma unroll
                    for (int i = 0; i < 4; ++i) { const float b = Bs[p * 64 * 33 + (tx + 16 * i) * 33 + kk]; acc[p][0][i] += a0 * b; acc[p][1][i] += a1 * b; } }
            __syncthreads();
        }
#pragma unroll
        for (int r = 0; r < 2; ++r)
#pragma unroll
            for (int i = 0; i < 4; ++i) { const int row = tm * 64 + ty + 32 * r, col = tn * 64 + tx + 16 * i;
                E.elem(row, col, acc[0][r][i], NPAN == 2 ? acc[NPAN - 1][r][i] : 0.f); }
    }
}
}

#define XB_TMO      128
#define XB_XCNT(j)  (256  + 64 * (j))
#define XB_XSUB(j)  (1280 + 64 * (j))
#define XB_XGEN(j)  (2304 + 64 * (j))
#define XB_TOP      3328
#define XB_TOPGEN   3392
#define XCD_BAR_WORDS 3456
#define XB_SPIN_CAP (1u << 18)
__device__ __forceinline__ unsigned xb_ld(unsigned* p)              { return __hip_atomic_load(p, __ATOMIC_RELAXED, __HIP_MEMORY_SCOPE_AGENT); }
__device__ __forceinline__ unsigned xb_add(unsigned* p, unsigned v) { return __hip_atomic_fetch_add(p, v, __ATOMIC_RELAXED, __HIP_MEMORY_SCOPE_AGENT); }
__device__ __forceinline__ unsigned xb_xcc_id() { return (unsigned)__builtin_amdgcn_s_getreg((3 << 11) | 20) & 0xFu; }
#define XB_SPIN(cond, bar) do { unsigned _sp = 0; while (cond) { __builtin_amdgcn_s_sleep(1); \
    if ((++_sp & 255u) == 0u) { if (xb_ld(&(bar)[XB_TMO])) break; if (_sp > XB_SPIN_CAP) { atomicAdd(&(bar)[XB_TMO], 1u); break; } } } } while (0)
struct XcdBarrier { unsigned* bar; unsigned x; volatile LAS unsigned* st; };
__device__ __forceinline__ XcdBarrier xcd_barrier_post(unsigned* bar, volatile LAS unsigned* st) {
    XcdBarrier b; b.bar = bar; b.x = xb_xcc_id(); b.st = st;
    if (threadIdx.x == 0) (void)xb_add(&bar[XB_XCNT(b.x)], 1u);
    return b;
}
__device__ __forceinline__ void xcd_barrier_complete(unsigned* bar, unsigned x, unsigned& nloc, unsigned& nx) {
    const unsigned G = gridDim.x * gridDim.y * gridDim.z;
    unsigned sum, cnt, mine, sp = 0u;
    for (;;) {
        sum = 0u; cnt = 0u; mine = 0u;
#pragma unroll
        for (unsigned j = 0; j < 16; ++j) { const unsigned c = xb_ld(&bar[XB_XCNT(j)]); sum += c; cnt += (c > 0u) ? 1u : 0u; mine = (j == x) ? c : mine; }
        if (sum == G) break;
        __builtin_amdgcn_s_sleep(1);
        if ((++sp & 255u) == 0u) { if (xb_ld(&bar[XB_TMO])) break; if (sp > XB_SPIN_CAP) { atomicAdd(&bar[XB_TMO], 1u); break; } }
    }
    nloc = mine > 0u ? mine : 1u; nx = cnt > 0u ? cnt : 1u;
}
__device__ __forceinline__ void xcd_barrier(const XcdBarrier& b) {
    asm volatile("s_waitcnt vmcnt(0)" ::: "memory");
    __syncthreads();
    if (threadIdx.x == 0) {
        unsigned* bar = b.bar;
        __builtin_amdgcn_s_waitcnt(0);
        unsigned nloc = b.st[0], nx = b.st[1];
        if (nloc == 0u) { xcd_barrier_complete(bar, b.x, nloc, nx); b.st[0] = nloc; b.st[1] = nx; }
        const unsigned old = xb_add(&bar[XB_XSUB(b.x)], 1u);
        const unsigned gen = old / nloc;
        if (old + 1u == (gen + 1u) * nloc) {
            __builtin_amdgcn_fence(__ATOMIC_RELEASE, "agent");
            asm volatile("s_waitcnt vmcnt(0)" ::: "memory");
            const unsigned og = xb_add(&bar[XB_TOP], 1u);
            const unsigned tg = og / nx;
            if (og + 1u == (tg + 1u) * nx) xb_add(&bar[XB_TOPGEN], 1u);
            else XB_SPIN(xb_ld(&bar[XB_TOPGEN]) == tg, bar);
            __builtin_amdgcn_fence(__ATOMIC_ACQUIRE, "agent");
            xb_add(&bar[XB_XGEN(b.x)], 1u);
            asm volatile("s_waitcnt vmcnt(0)" ::: "memory");
        } else {
            XB_SPIN(xb_ld(&bar[XB_XGEN(b.x)]) == gen, bar);
            __builtin_amdgcn_fence(__ATOMIC_ACQUIRE, "agent");
            asm volatile("s_waitcnt vmcnt(0)" ::: "memory");
        }
    }
    __syncthreads();
}

namespace dsa {
using bf16=__hip_bfloat16;
using bf16x8=__attribute__((ext_vector_type(8)))short;
using s16x4=__attribute__((ext_vector_type(4)))short;
using f32x16=__attribute__((ext_vector_type(16)))float;
using u32x4=__attribute__((ext_vector_type(4)))unsigned;
using u32x2=__attribute__((ext_vector_type(2)))unsigned;
constexpr int BATCH=4,NHEAD=8,SEQ=4096,D=64,QP=2560,KP=1024,OP=1024;
constexpr int NW=8,QBLK=32,QB=QBLK*NW,KVBLK=64,NQB=SEQ/QB;
__device__ __forceinline__ int crow(int r,int hi){return (r&3)+8*(r>>2)+4*hi;}
#define SBAR() __builtin_amdgcn_sched_barrier(0)
__device__ __forceinline__ void bmask(f32x16&p0,f32x16&p1,unsigned w0,unsigned w1,int hi){
  const int s0=(int)(w0>>(4*hi)), s1=(int)(w1>>(4*hi));
  #pragma unroll
  for(int r=0;r<16;++r){const unsigned pos=(r&3)+8*(r>>2);
    const unsigned m0=(unsigned)__builtin_amdgcn_sbfe(s0,pos,1u), m1=(unsigned)__builtin_amdgcn_sbfe(s1,pos,1u);
    p0[r]=__uint_as_float((__float_as_uint(p0[r])&m0)|(~m0&0xff800000u)); p1[r]=__uint_as_float((__float_as_uint(p1[r])&m1)|(~m1&0xff800000u));}
}

constexpr int NSLOT=3, SLOTB=8192;
constexpr int LDS_K=0, LDS_V=NSLOT*SLOTB, LDS_WS=2*NSLOT*SLOTB, LDS_OST=LDS_WS+NW*64*4, LDS_BYTES=LDS_OST+NW*4096;
constexpr float C2=0.125f*1.4426950408889634f;
__device__ __forceinline__ void glds16(const void*gsrc,unsigned lds_dst){unsigned keep;
  asm volatile("s_mov_b32 %0, m0\n\ts_mov_b32 m0, %2\n\ts_nop 0\n\tglobal_load_lds_dwordx4 %1, off\n\ts_mov_b32 m0, %0":"=&s"(keep):"v"(gsrc),"s"(lds_dst):"memory");}
__device__ __forceinline__ float max3f(float a,float b,float c){float r;asm("v_max3_f32 %0, %1, %2, %3":"=v"(r):"v"(a),"v"(b),"v"(c));return r;}
__device__ __forceinline__ float max2f(float a,float b){float r;asm("v_max_f32_e32 %0, %1, %2":"=v"(r):"v"(a),"v"(b));return r;}
__device__ __forceinline__ float fadd_s(float a,float b){float r;asm("v_add_f32_e32 %0, %1, %2":"=v"(r):"v"(a),"v"(b));return r;}
__device__ __forceinline__ float fsub_s(float a,float b){float r;asm("v_sub_f32_e32 %0, %1, %2":"=v"(r):"v"(a),"v"(b));return r;}
typedef float f32x2_t __attribute__((ext_vector_type(2))); typedef __bf16 bf16x2_t __attribute__((ext_vector_type(2)));
__device__ __forceinline__ unsigned cvtpk_s(float lo,float hi){f32x2_t v={lo,hi};bf16x2_t b=__builtin_convertvector(v,bf16x2_t);return __builtin_bit_cast(unsigned,b);}
#define WAIT_BAR(N) asm volatile("s_waitcnt vmcnt(" #N ") lgkmcnt(0)\n\ts_barrier":::"memory")
#define WAIT_BAR_M(N,M) asm volatile("s_waitcnt vmcnt(" #N ") lgkmcnt(0)\n\ts_barrier":"+v"(M)::"memory")

__device__ __forceinline__ void qkt(f32x16&p0,f32x16&p1,const char*Kslot,const bf16x8*qr,int r32,int hi){
  const char*kb=Kslot+hi*1024+r32*16;
  #pragma unroll
  for(int d0=0;d0<4;++d0){
    const bf16x8 b0=*reinterpret_cast<const bf16x8*>(kb+d0*2048);
    const bf16x8 b1=*reinterpret_cast<const bf16x8*>(kb+d0*2048+512);
    if(d0==0){p0=__builtin_amdgcn_mfma_f32_32x32x16_bf16(b0,qr[0],f32x16{},0,0,0);p1=__builtin_amdgcn_mfma_f32_32x32x16_bf16(b1,qr[0],f32x16{},0,0,0);}
    else{p0=__builtin_amdgcn_mfma_f32_32x32x16_bf16(b0,qr[d0],p0,0,0,0);p1=__builtin_amdgcn_mfma_f32_32x32x16_bf16(b1,qr[d0],p1,0,0,0);}}
}
typedef __attribute__((address_space(3))) const char* lds_cptr;
typedef short v4i16_t __attribute__((ext_vector_type(4)));
__device__ __forceinline__ void kload8(bf16x8*kf,lds_cptr kp){
  kf[0]=*(const __attribute__((address_space(3))) bf16x8*)(kp);      kf[1]=*(const __attribute__((address_space(3))) bf16x8*)(kp+512);
  kf[2]=*(const __attribute__((address_space(3))) bf16x8*)(kp+2048); kf[3]=*(const __attribute__((address_space(3))) bf16x8*)(kp+2560);
  kf[4]=*(const __attribute__((address_space(3))) bf16x8*)(kp+4096); kf[5]=*(const __attribute__((address_space(3))) bf16x8*)(kp+4608);
  kf[6]=*(const __attribute__((address_space(3))) bf16x8*)(kp+6144); kf[7]=*(const __attribute__((address_space(3))) bf16x8*)(kp+6656);
}
__device__ __forceinline__ void kload2(bf16x8*kf,lds_cptr kp,int j){ kf[2*j]=*(const __attribute__((address_space(3))) bf16x8*)(kp+j*2048); kf[2*j+1]=*(const __attribute__((address_space(3))) bf16x8*)(kp+j*2048+512); }
__device__ __forceinline__ s16x4 vtr(lds_cptr p){ return __builtin_bit_cast(s16x4,__builtin_amdgcn_ds_read_tr16_b64_v4i16((__attribute__((address_space(3))) v4i16_t*)p)); }
__device__ __forceinline__ float rowmax(const f32x16&p0,const f32x16&p1){
  float a=max3f(p0[0],p0[1],p1[0]),b=max3f(p0[2],p0[3],p1[1]);a=max3f(a,p1[2],p1[3]);
  #pragma unroll
  for(int r=4;r<16;r+=4){a=max3f(a,p0[r],p0[r+1]);b=max3f(b,p0[r+2],p0[r+3]);a=max3f(a,p1[r],p1[r+1]);b=max3f(b,p1[r+2],p1[r+3]);}
  const float m=max2f(a,b);
  auto rr=__builtin_amdgcn_permlane32_swap(__float_as_uint(m),__float_as_uint(m),false,false);
  return max2f(__uint_as_float(rr[0]),__uint_as_float(rr[1]));
}
__device__ __forceinline__ void pv(f32x16*o,int vb,bf16x8 pa0,bf16x8 pa1,bf16x8 pa2,bf16x8 pa3){
  #pragma unroll
  for(int d0=0;d0<2;++d0){s16x4 lo[4],hi[4];
    #pragma unroll
    for(int ks=0;ks<4;++ks){
      asm volatile("ds_read_b64_tr_b16 %0,%1 offset:%c2":"=&v"(lo[ks]):"v"(vb),"i"(d0*4096+ks*1024):"memory");
      asm volatile("ds_read_b64_tr_b16 %0,%1 offset:%c2":"=&v"(hi[ks]):"v"(vb),"i"(d0*4096+ks*1024+512):"memory");}
    asm volatile("s_waitcnt lgkmcnt(0)":::"memory");SBAR();
    #define PK(k) (bf16x8){lo[k][0],lo[k][1],lo[k][2],lo[k][3],hi[k][0],hi[k][1],hi[k][2],hi[k][3]}
    o[d0]=__builtin_amdgcn_mfma_f32_32x32x16_bf16(pa0,PK(0),o[d0],0,0,0);
    o[d0]=__builtin_amdgcn_mfma_f32_32x32x16_bf16(pa1,PK(1),o[d0],0,0,0);
    o[d0]=__builtin_amdgcn_mfma_f32_32x32x16_bf16(pa2,PK(2),o[d0],0,0,0);
    o[d0]=__builtin_amdgcn_mfma_f32_32x32x16_bf16(pa3,PK(3),o[d0],0,0,0);
    #undef PK
  }
}

#ifndef ATTN_STORE16
#define ATTN_STORE16(p,v) (*(u32x4*)(p)=(v))
#endif
template<int THRL> __device__ __forceinline__ void attn_unit(const int tid,int b,int h,int qb,const bf16*Q,const bf16*__restrict__ K,const bf16*__restrict__ V,bf16*O,const u32x2*__restrict__ MT,char*shm){
  const int lane=tid&63,r32=lane&31,hi=lane>>5; const int wid=__builtin_amdgcn_readfirstlane(tid>>6);
  const long rowbase=(long)b*SEQ; const int q0=qb*QB;
  const bf16*Qw=Q+(rowbase+q0+wid*QBLK)*QP+h*D;
  const bf16*Kh=K+rowbase*KP+h*D,*Vh=V+rowbase*KP+h*D;
  const unsigned lds0=(unsigned)(uintptr_t)shm;
  float*wsf=(float*)(shm+LDS_WS)+wid*64;
  const bf16*ksrc=Kh+(long)lane*KP+wid*8;
  const bf16*vsrc=Vh+(long)(16*(wid&3)+(lane>>2))*KP+(wid>>2)*32+(lane&3)*8;
  const unsigned kdst=lds0+LDS_K+wid*1024, vdst=lds0+LDS_V+wid*1024;
  #define DMA_K(t,slot) glds16(ksrc+(long)(t)*KVBLK*KP,(unsigned)__builtin_amdgcn_readfirstlane(kdst+(slot)))
  #define DMA_V(t,slot) glds16(vsrc+(long)(t)*KVBLK*KP,(unsigned)__builtin_amdgcn_readfirstlane(vdst+(slot)))
  const int vb0=(int)(lds0+LDS_V)+((lane>>4)&1)*32+(lane&3)*8+(4*hi+((lane&15)>>2))*64;
  const char*Kbase=shm+LDS_K; bf16x8 kf[8];
  const lds_cptr shm3=(lds_cptr)shm; const lds_cptr kp0=shm3+LDS_K+hi*1024+r32*16; const lds_cptr vp0=shm3+LDS_V+((lane>>4)&1)*32+(lane&3)*8+(4*hi+((lane&15)>>2))*64;
  const int NT=(q0+QB)/KVBLK;
  const u32x2*mq=MT+(long)b*64*SEQ+q0+wid*QBLK+r32;
  u32x2 mA=mq[0],mB=mq[SEQ]; asm volatile("s_waitcnt vmcnt(0)":"+v"(mA),"+v"(mB)::"memory");
  #define MLD(M,t) asm volatile("global_load_dwordx2 %0, %1, off":"=v"(M):"v"(mq+(long)(t)*SEQ):"memory")
  DMA_K(0,0);DMA_V(0,0);DMA_K(1,SLOTB);
  bf16x8 qr[4];
  #pragma unroll
  for(int d0=0;d0<4;++d0)qr[d0]=*reinterpret_cast<const bf16x8*>(&Qw[(long)r32*QP+d0*16+hi*8]);
  float mhat=0.f,l_reg=0.f;f32x16 o[2];o[0]=f32x16{};o[1]=f32x16{};
  const int qrel=wid*QBLK+r32;
  #define CMASK(P0,P1,M) bmask(P0,P1,M.x,M.y,hi)
  bool resc=false;
  #define START(P0,P1) do{ const float rm=rowmax(P0,P1); resc=false; \
    { const float dl=__builtin_fmaxf(rm,-64.f); mhat=fadd_s(mhat,dl); \
      _Pragma("unroll") for(int r=0;r<16;++r){P0[r]=fsub_s(P0[r],dl);P1[r]=fsub_s(P1[r],dl);} } \
    _Pragma("unroll") for(int r=0;r<16;++r)P0[r]=__builtin_amdgcn_exp2f(P0[r]); }while(0)
  #define RESC() do{ if(resc){ asm volatile("s_waitcnt lgkmcnt(0)":::"memory"); \
      _Pragma("unroll") for(int d_=0;d_<2;++d_) _Pragma("unroll") for(int r=0;r<16;++r)o[d_][r]*=wsf[crow(r,hi)]; } }while(0)
  f32x16 pA0,pA1,pB0,pB1;
  int sl_prev=0,sl_cur=0,sl_next=SLOTB;
  #define ROT() do{sl_prev=sl_cur;sl_cur=sl_next;sl_next=(sl_next==(NSLOT-1)*SLOTB)?0:sl_next+SLOTB;}while(0)
  DMA_K(2,2*SLOTB);
  WAIT_BAR(3);
  qkt(pA0,pA1,Kbase,qr,r32,hi);asm volatile("s_nop 15\n\ts_nop 7":"+v"(pA0),"+v"(pA1));CMASK(pA0,pA1,mA);
  START(pA0,pA1);
  _Pragma("unroll") for(int r=0;r<16;++r)pA1[r]=__builtin_amdgcn_exp2f(pA1[r]);
  WAIT_BAR(0);
  DMA_K(3,0);DMA_V(1,SLOTB);
  ROT();
  kload8(kf,kp0+sl_cur);
  WAIT_BAR(2);
  s16x4 vl0,vh0,vl1,vh1,vl2,vh2; u32x4 pw0,pw1,pw2,pw3;
  #define PKW(P,B) cvtpk_s(P[B],P[B+1])
  #define PAF(k) __builtin_bit_cast(bf16x8,pw##k)
  #define VFRB(b) (bf16x8){vl##b[0],vl##b[1],vl##b[2],vl##b[3],vh##b[0],vh##b[1],vh##b[2],vh##b[3]}
  #define PIN(x) asm volatile("":"+v"(x))
  #define MX3(a,b,c) __builtin_fmaxf(__builtin_fmaxf((a),(b)),(c))
  #define GAPA(MF,A0,A1,A2,A3,W0,W1,PW) do{ MF; sacc+=A0; sacc+=A1; sacc+=A2; sacc+=A3; PIN(sacc); W0; W1; PIN(PW); SBAR(); }while(0)
  #define EX(v) __builtin_amdgcn_exp2f(v)
  #define GAPB(MF,X,B) do{ MF; X[B]=EX(X[B]); X[B+1]=EX(X[B+1]); X[B+2]=EX(X[B+2]); X[B+3]=EX(X[B+3]); PIN(X); SBAR(); }while(0)
  #define VRDB(b,i) do{ vl##b=vtr(vp_+(((i)>>2)*4096+((i)&3)*1024)); vh##b=vtr(vp_+(((i)>>2)*4096+((i)&3)*1024+512)); SBAR(); }while(0)
  #define KRD(G,j) do{ if(G){ kload2(kf,kp0+sl_next,j); SBAR(); } }while(0)
  #define STEP(C0,C1,P0,P1,t,GK,GV,GL,MC,MN) do{ SBAR(); if(GV){MLD(MN,(t)+1);} SBAR(); \
    const lds_cptr vp_=vp0+sl_prev; \
    float sacc=(P0[0]+P0[1]); \
    GAPA(C0=__builtin_amdgcn_mfma_f32_32x32x16_bf16(kf[0],qr[0],f32x16{},0,0,0), P0[2],P0[3],P0[4],P0[5],     pw0[0]=PKW(P0,0), pw0[1]=PKW(P0,2), pw0); \
    GAPA(C1=__builtin_amdgcn_mfma_f32_32x32x16_bf16(kf[1],qr[0],f32x16{},0,0,0), P0[6],P0[7],P0[8],P0[9],     pw0[2]=PKW(P0,4), pw0[3]=PKW(P0,6), pw0); \
    GAPA(C0=__builtin_amdgcn_mfma_f32_32x32x16_bf16(kf[2],qr[1],C0,0,0,0),   P0[10],P0[11],P0[12],P0[13], pw1[0]=PKW(P0,8), pw1[1]=PKW(P0,10), pw1); \
    GAPA(C1=__builtin_amdgcn_mfma_f32_32x32x16_bf16(kf[3],qr[1],C1,0,0,0),   P0[14],P0[15],P1[0],P1[1],   pw1[2]=PKW(P0,12),pw1[3]=PKW(P0,14), pw1); \
    KRD(GL,0); \
    GAPA(C0=__builtin_amdgcn_mfma_f32_32x32x16_bf16(kf[4],qr[2],C0,0,0,0),   P1[2],P1[3],P1[4],P1[5],     pw2[0]=PKW(P1,0), pw2[1]=PKW(P1,2), pw2); \
    GAPA(C1=__builtin_amdgcn_mfma_f32_32x32x16_bf16(kf[5],qr[2],C1,0,0,0),   P1[6],P1[7],P1[8],P1[9],     pw2[2]=PKW(P1,4), pw2[3]=PKW(P1,6), pw2); \
    KRD(GL,1); \
    GAPA(C0=__builtin_amdgcn_mfma_f32_32x32x16_bf16(kf[6],qr[3],C0,0,0,0),   P1[10],P1[11],P1[12],P1[13], pw3[0]=PKW(P1,8), pw3[1]=PKW(P1,10), pw3); \
    GAPA(C1=__builtin_amdgcn_mfma_f32_32x32x16_bf16(kf[7],qr[3],C1,0,0,0),   P1[14],P1[15],0.f,0.f,       pw3[2]=PKW(P1,12),pw3[3]=PKW(P1,14), pw3); \
    KRD(GL,2); KRD(GL,3); \
    l_reg+=sacc; \
    if(GK){DMA_K((t)+3,sl_cur);} if(GV){DMA_V((t)+1,sl_next);} \
    VRDB(0,0); VRDB(1,4); \
    CMASK(C0,C1,MC); \
    { float a=MX3(C0[0],C0[1],C1[0]),b=MX3(C0[2],C0[3],C1[1]); a=MX3(a,C1[2],C1[3]); \
      _Pragma("unroll") for(int r=4;r<16;r+=4){a=MX3(a,C0[r],C0[r+1]);b=MX3(b,C0[r+2],C0[r+3]);a=MX3(a,C1[r],C1[r+1]);b=MX3(b,C1[r+2],C1[r+3]);} \
      float rm=__builtin_fmaxf(a,b); { auto rr=__builtin_amdgcn_permlane32_swap(__float_as_uint(rm),__float_as_uint(rm),false,false); rm=__builtin_fmaxf(__uint_as_float(rr[0]),__uint_as_float(rr[1])); } \
      rm-=mhat; resc=false;     \
      if(__builtin_expect(__any(rm>(float)THRL),0)){ const float dl=__builtin_fmaxf(rm,0.f); mhat+=dl; \
        const float f=__builtin_amdgcn_exp2f(-dl); l_reg*=f; if(hi==0)wsf[r32]=f; resc=true; } \
      _Pragma("unroll") for(int r=0;r<16;++r){C0[r]-=mhat;C1[r]-=mhat;} } \
    SBAR(); \
    VRDB(2,1); GAPB(o[0]=__builtin_amdgcn_mfma_f32_32x32x16_bf16(PAF(0),VFRB(0),o[0],0,0,0), C0,0); \
    VRDB(0,5); GAPB(o[1]=__builtin_amdgcn_mfma_f32_32x32x16_bf16(PAF(0),VFRB(1),o[1],0,0,0), C0,4); \
    VRDB(1,2); GAPB(o[0]=__builtin_amdgcn_mfma_f32_32x32x16_bf16(PAF(1),VFRB(2),o[0],0,0,0), C0,8); \
    VRDB(2,6); GAPB(o[1]=__builtin_amdgcn_mfma_f32_32x32x16_bf16(PAF(1),VFRB(0),o[1],0,0,0), C0,12); \
    VRDB(0,3); GAPB(o[0]=__builtin_amdgcn_mfma_f32_32x32x16_bf16(PAF(2),VFRB(1),o[0],0,0,0), C1,0); \
    VRDB(1,7); GAPB(o[1]=__builtin_amdgcn_mfma_f32_32x32x16_bf16(PAF(2),VFRB(2),o[1],0,0,0), C1,4); \
    GAPB(o[0]=__builtin_amdgcn_mfma_f32_32x32x16_bf16(PAF(3),VFRB(0),o[0],0,0,0), C1,8); \
    GAPB(o[1]=__builtin_amdgcn_mfma_f32_32x32x16_bf16(PAF(3),VFRB(1),o[1],0,0,0), C1,12); \
    }while(0)
  int t=1;
  for(;t+5<NT;t+=2){
    STEP(pB0,pB1,pA0,pA1,t,true,true,true,mB,mA);     WAIT_BAR_M(2,mA); RESC(); ROT();
    STEP(pA0,pA1,pB0,pB1,t+1,true,true,true,mA,mB);   WAIT_BAR_M(2,mB); RESC(); ROT();
  }
  #define ENDW(tt,M) do{ if((tt)+3<NT){WAIT_BAR_M(2,M);} else if((tt)+2<NT){WAIT_BAR_M(1,M);} else {WAIT_BAR_M(0,M);} }while(0)
  for(;t+1<NT;t+=2){
    STEP(pB0,pB1,pA0,pA1,t,(t+3<NT),(t+1<NT),(t+1<NT),mB,mA);       ENDW(t,mA);   RESC(); ROT();
    STEP(pA0,pA1,pB0,pB1,t+1,(t+4<NT),(t+2<NT),(t+2<NT),mA,mB);     ENDW(t+1,mB); RESC(); ROT();
  }
  STEP(pB0,pB1,pA0,pA1,NT-1,false,false,false,mB,mA); RESC();
  { float sacc=pB0[0]+pB0[1]; _Pragma("unroll") for(int r=2;r<16;++r)sacc+=pB0[r]; _Pragma("unroll") for(int r=0;r<16;++r)sacc+=pB1[r]; l_reg+=sacc;
    pw0=(u32x4){PKW(pB0,0),PKW(pB0,2),PKW(pB0,4),PKW(pB0,6)};pw1=(u32x4){PKW(pB0,8),PKW(pB0,10),PKW(pB0,12),PKW(pB0,14)};pw2=(u32x4){PKW(pB1,0),PKW(pB1,2),PKW(pB1,4),PKW(pB1,6)};pw3=(u32x4){PKW(pB1,8),PKW(pB1,10),PKW(pB1,12),PKW(pB1,14)};
    SBAR(); pv(o,vb0+sl_cur,PAF(0),PAF(1),PAF(2),PAF(3)); }
  #undef PKW
  #undef PAF
  #undef VFRB
  #undef PIN
  #undef MX3
  #undef GAPA
  #undef GAPB
  #undef EX
  #undef VRDB
  #undef KRD
  #undef STEP
  #undef ENDW
  {auto rr=__builtin_amdgcn_permlane32_swap(__float_as_uint(l_reg),__float_as_uint(l_reg),false,false);l_reg=__uint_as_float(rr[0])+__uint_as_float(rr[1]);}
  if(hi==0)wsf[32+r32]=l_reg;asm volatile("s_waitcnt lgkmcnt(0)":::"memory");
  float rli[16];
  #pragma unroll
  for(int r=0;r<16;++r)rli[r]=__builtin_amdgcn_rcpf(wsf[32+crow(r,hi)]);
  bf16*Ow=O+(rowbase+q0+wid*QBLK)*OP+h*D;
  { bf16*stg=(bf16*)(shm+LDS_OST)+wid*2048;
    #pragma unroll
    for(int r=0;r<16;++r){const int orow=crow(r,hi);
      #pragma unroll
      for(int d0=0;d0<2;++d0)stg[orow*64+d0*32+r32]=__float2bfloat16(o[d0][r]*rli[r]);}
    asm volatile("s_waitcnt lgkmcnt(0)":::"memory");
    #pragma unroll
    for(int i=0;i<4;++i){const int row=i*8+(lane>>3),ch=lane&7; const u32x4 v=*(const u32x4*)(stg+row*64+ch*8); ATTN_STORE16(Ow+(long)row*OP+ch*8,v);} }
  asm volatile("s_waitcnt lgkmcnt(0)\n\ts_barrier":::"memory");
  #undef DMA_K
  #undef DMA_V
  #undef CMASK
  #undef MLD
  #undef START
  #undef RESC
  #undef ROT
}
constexpr int ATTN_LDS_BYTES=LDS_BYTES;
template<int THRL=8> __device__ __forceinline__ void attn_phase(const int tid,int grid,int block,const bf16*Q,const bf16*K,const bf16*V,bf16*O,const u32x2*MT,char*lds){
  for(int i=0;;++i){ const int u=i*grid+block; if(u>=BATCH*NHEAD*NQB)break; int bh,qb;
    if(grid==256){ const int vcu=(block%8)*(grid/8)+block/8, s=vcu&7; bh=vcu>>3; qb=i?15-s:s; } else { bh=u/NQB; qb=NQB-1-(u%NQB); }
    bh=__builtin_amdgcn_readfirstlane(bh); qb=__builtin_amdgcn_readfirstlane(qb);
    attn_unit<THRL>(tid,bh/NHEAD,bh%NHEAD,qb,Q,K,V,O,MT,lds); }
}
#undef SBAR
#undef WAIT_BAR
#undef WAIT_BAR_M
}
constexpr int NWAVES = 8, NTHREADS = 512;
constexpr int RING_BYTES = 131072, HIST_OFF = RING_BYTES, DESC_OFF = RING_BYTES + 8704, MISC_OFF = DESC_OFF + 6144, LDS_BYTES = 147456;
constexpr int DESC_WORDS = 32;
struct Args { const float* in[25]; float* out; unsigned char* ws; int ph_lo, ph_hi; };
struct Ctx {
    LAS unsigned char* lds; char* ldsg; int tid, lane, wave, nblk, bid;
    float* out; unsigned char* ws; const __attribute__((address_space(4))) void* kp;
};
#define inp(i) (((const float* const __attribute__((address_space(4)))*)F.kp)[i])
enum { I_X = 0, I_MEM, I_NORMS, I_WGU, I_WDN, I_XQ, I_XKV, I_XO, I_EIN, I_EKVN, I_EUK, I_EUV, I_ECW, I_ECB, I_ERA, I_EBRA, I_ERI, I_EBRI, I_ELAM, I_EOUT, I_OIN, I_OG2, I_OBG, I_OHN, I_OOUT };
enum { N_FFN1_PRE = 0, N_FFN1_POST, N_MIX_PRE, N_MIX_POST, N_XA_PRE, N_XA_POST, N_MEM_NORM, N_FFN2_PRE, N_FFN2_POST };

struct TJob { const float* W; int K, Nsrc; bf16_t* WT; int c0, nc, r0, mode; float scale; };
__device__ __forceinline__ void transpose_item(const TJob& J, int item, LAS float* scr, int lane) {
    const int nblk = (J.nc + 31) / 32, kb = item / nblk, nb = item % nblk, k0 = 64 * kb, n0 = 32 * nb;
    const int cl = n0 + (lane & 31); const bool okc = cl < J.nc;
#pragma unroll 8
    for (int i = 0; i < 32; ++i) { const int kk = 2 * i + (lane >> 5); scr[kk * 33 + (lane & 31)] = okc ? J.W[(size_t)(k0 + kk) * J.Nsrc + J.c0 + cl] * J.scale : 0.f; }
    asm volatile("s_waitcnt lgkmcnt(0)" ::: "memory");
    const int c = lane & 7;
#pragma unroll
    for (int j = 0; j < 4; ++j) { const int n = (lane >> 3) + 8 * j; const LAS float* s = scr + (8 * c) * 33 + n;
        u32x4 o; o.x = pk2(s[0 * 33], s[1 * 33]); o.y = pk2(s[2 * 33], s[3 * 33]); o.z = pk2(s[4 * 33], s[5 * 33]); o.w = pk2(s[6 * 33], s[7 * 33]);
        const int cc = n0 + n;
        if (cc < J.nc) { int row; if (J.mode == 0) row = J.r0 + cc; else { const int cg = J.c0 + cc, bj = cg / FF, jj = cg % FF; row = 256 * (jj / 128) + 128 * bj + (jj % 128); }
            *(u32x4*)(J.WT + (size_t)row * J.K + k0 + 8 * c) = o; } }
    asm volatile("s_waitcnt lgkmcnt(0)" ::: "memory");
}
constexpr int NJOBS = 4 + 4 + 6 + 7 + 2 + 1 + 5 + 1;
__device__ __forceinline__ TJob get_job(const Ctx& F, int j) {
    TJob J; J.mode = 0; J.scale = 1.f; J.c0 = 0; J.r0 = 0;
    bf16_t* Wb = (bf16_t*)(F.ws + WS_W);
    if (j < 4) { J.W = inp(I_WGU) + (size_t)j * D * 2 * FF; J.K = D; J.Nsrc = 2 * FF; J.nc = 2 * FF; J.WT = (bf16_t*)((unsigned char*)Wb + W_GU) + (size_t)j * 2 * FF * D; J.mode = 1; return J; }
    j -= 4;
    if (j < 4) { J.W = inp(I_WDN) + (size_t)j * FF * D; J.K = FF; J.Nsrc = D; J.nc = D; J.WT = (bf16_t*)((unsigned char*)Wb + W_DN) + (size_t)j * D * FF; return J; }
    j -= 4;
    if (j < 6) { const int l = j & 1, w = j >> 1;
        if (w == 0) { J.W = inp(I_XQ) + (size_t)l * D * D; J.K = D; J.Nsrc = D; J.nc = D; J.WT = (bf16_t*)((unsigned char*)Wb + W_Q) + (size_t)l * D * D; }
        else if (w == 1) { J.W = inp(I_XKV) + (size_t)l * D * 2 * D; J.K = D; J.Nsrc = 2 * D; J.nc = 2 * D; J.WT = (bf16_t*)((unsigned char*)Wb + W_KV) + (size_t)l * 2 * D * D; }
        else { J.W = inp(I_XO) + (size_t)l * D * D; J.K = D; J.Nsrc = D; J.nc = D; J.WT = (bf16_t*)((unsigned char*)Wb + W_O) + (size_t)l * D * D; }
        return J; }
    j -= 6;
    if (j < 7) { J.W = inp(I_EIN); J.K = D; J.Nsrc = 2376; J.WT = (bf16_t*)((unsigned char*)Wb + W_EIN);
        switch (j) { case 0: J.c0 = 0; J.nc = 512; J.r0 = YQ; J.scale = C2; break; case 1: J.c0 = 512; J.nc = 256; J.r0 = YCKV; break; case 2: J.c0 = 768; J.nc = 512; J.r0 = YQI; break;
                     case 3: J.c0 = 1280; J.nc = 64; J.r0 = YKI; break; case 4: J.c0 = 1344; J.nc = 8; J.r0 = YWI; break; case 5: J.c0 = 1352; J.nc = 512; J.r0 = YGATE; break; default: J.c0 = 1864; J.nc = 512; J.r0 = YXB; break; }
        return J; }
    j -= 7;
    if (j < 2) { J.W = (j == 0) ? inp(I_EUK) : inp(I_EUV); J.K = 256; J.Nsrc = 512; J.nc = 512; J.WT = (bf16_t*)((unsigned char*)Wb + W_UKV); J.r0 = 512 * j; return J; }
    j -= 2;
    if (j < 1) { J.W = inp(I_EOUT); J.K = D; J.Nsrc = D; J.nc = D; J.WT = (bf16_t*)((unsigned char*)Wb + W_EOUT); return J; }
    j -= 1;
    if (j < 5) { J.W = inp(I_OIN); J.K = D; J.Nsrc = 3088; J.WT = (bf16_t*)((unsigned char*)Wb + W_OIN);
        switch (j) { case 0: J.c0 = 0; J.nc = 512; J.r0 = ZQ; break; case 1: J.c0 = 512; J.nc = 512; J.r0 = ZK; break; case 2: J.c0 = 1024; J.nc = 1024; J.r0 = ZV; break;
                     case 3: J.c0 = 2048; J.nc = 16; J.r0 = ZG; break; default: J.c0 = 2064; J.nc = 1024; J.r0 = ZR; break; }
        return J; }
    J.W = inp(I_OOUT); J.K = D; J.Nsrc = D; J.nc = D; J.WT = (bf16_t*)((unsigned char*)Wb + W_OOUT); return J;
}
__device__ __forceinline__ void rms_row_to_bf16(const float* xrow, const float* gain, bf16_t* orow, int lane) {
    const f32x4* xr = (const f32x4*)xrow + lane; f32x4 v[4]; float s = 0.f;
#pragma unroll
    for (int j = 0; j < 4; ++j) { v[j] = xr[64 * j]; s += (v[j].x * v[j].x + v[j].y * v[j].y) + (v[j].z * v[j].z + v[j].w * v[j].w); }
    const float rstd = 1.0f / sqrtf(wave_sum(s) * (1.f / D) + EPS);
    u32x2* o8 = (u32x2*)orow + lane;
#pragma unroll
    for (int j = 0; j < 4; ++j) { const f32x4 gg = ((const f32x4*)gain)[lane + 64 * j]; u32x2 w; w.x = pk2(v[j].x * rstd * gg.x, v[j].y * rstd * gg.y); w.y = pk2(v[j].z * rstd * gg.z, v[j].w * rstd * gg.w); o8[64 * j] = w; }
}
__device__ __forceinline__ void phase_prep(const Ctx& F) {
    LAS float* scr = (LAS float*)(F.lds + F.wave * 16384);
    const int gw = F.bid * NWAVES + F.wave, NGW = F.nblk * NWAVES;
    int total = 0;
    for (int j = 0; j < NJOBS; ++j) { const TJob J = get_job(F, j); total += (J.K / 64) * ((J.nc + 31) / 32); }
    for (int it = gw; it < total; it += NGW) {
        int r = it, j = 0; TJob J = get_job(F, 0);
        for (;;) { const int n = (J.K / 64) * ((J.nc + 31) / 32); if (r < n) break; r -= n; ++j; J = get_job(F, j); }
        transpose_item(J, r, scr, F.lane);
    }
    { bf16_t* We = (bf16_t*)(F.ws + WS_W + W_EIN) + (size_t)1352 * D; bf16_t* Wo = (bf16_t*)(F.ws + WS_W + W_OIN) + (size_t)2064 * D;
      const int ne = 184 * D / 8, no = 240 * D / 8; const int gt = F.bid * NTHREADS + F.tid, NGT = F.nblk * NTHREADS;
      for (int i = gt; i < ne + no; i += NGT) { u32x4 z = {0u, 0u, 0u, 0u}; if (i < ne) ((u32x4*)We)[i] = z; else ((u32x4*)Wo)[i - ne] = z; } }
    for (int m = gw; m < 2 * 1024 + T; m += NGW) {
        if (m < 2048) { const int l = m >> 10, r = m & 1023; rms_row_to_bf16(inp(I_MEM) + (size_t)r * D, inp(I_NORMS) + (size_t)(l * 9 + N_MEM_NORM) * D, (bf16_t*)(F.ws + (l ? WS_MEMN1 : WS_MEMN0)) + (size_t)r * D, F.lane); }
        else { const int r = m - 2048; rms_row_to_bf16(inp(I_X) + (size_t)r * D, inp(I_NORMS) + (size_t)N_FFN1_PRE * D, (bf16_t*)(F.ws + WS_A) + (size_t)r * D, F.lane); }
    }
}

__device__ __forceinline__ void phase_norm(const Ctx& F, const bf16_t* Fb, const float* hin, float* hout, float coef, const float* gpost, const float* gpre, bf16_t* Aout) {
    const int gw = F.bid * NWAVES + F.wave, NGW = F.nblk * NWAVES, lane = F.lane;
    for (int m = gw; m < T; m += NGW) {
        const u32x2* fr = (const u32x2*)(Fb + (size_t)m * D) + lane; f32x4 f[4]; float s = 0.f;
#pragma unroll
        for (int j = 0; j < 4; ++j) { const u32x2 w = fr[64 * j]; f[j].x = __uint_as_float(w.x << 16); f[j].y = __uint_as_float(w.x & 0xffff0000u); f[j].z = __uint_as_float(w.y << 16); f[j].w = __uint_as_float(w.y & 0xffff0000u);
            s += (f[j].x * f[j].x + f[j].y * f[j].y) + (f[j].z * f[j].z + f[j].w * f[j].w); }
        const float rstd = coef / sqrtf(wave_sum(s) * (1.f / D) + EPS);
        f32x4 h[4]; float s2 = 0.f;
#pragma unroll
        for (int j = 0; j < 4; ++j) { const f32x4 hv = ((const f32x4*)(hin + (size_t)m * D))[lane + 64 * j]; const f32x4 gg = ((const f32x4*)gpost)[lane + 64 * j];
            h[j] = hv + f[j] * rstd * gg; ((f32x4*)(hout + (size_t)m * D))[lane + 64 * j] = h[j];
            s2 += (h[j].x * h[j].x + h[j].y * h[j].y) + (h[j].z * h[j].z + h[j].w * h[j].w); }
        if (gpre) { const float r2 = 1.0f / sqrtf(wave_sum(s2) * (1.f / D) + EPS); u32x2* o8 = (u32x2*)(Aout + (size_t)m * D) + lane;
#pragma unroll
            for (int j = 0; j < 4; ++j) { const f32x4 gg = ((const f32x4*)gpre)[lane + 64 * j]; u32x2 w; w.x = pk2(h[j].x * r2 * gg.x, h[j].y * r2 * gg.y); w.y = pk2(h[j].z * r2 * gg.z, h[j].w * r2 * gg.w); o8[64 * j] = w; } }
    }
}

__device__ __forceinline__ void phase_ckvn(const Ctx& F) {
    const bf16_t* Y = (const bf16_t*)(F.ws + WS_BIG + BG_Y); bf16_t* O = (bf16_t*)(F.ws + WS_BIG + BG_CKVN); const float* gn = inp(I_EKVN);
    const int gw = F.bid * NWAVES + F.wave, NGW = F.nblk * NWAVES, lane = F.lane;
    for (int m = gw; m < T; m += NGW) {
        const u32x2 w = ((const u32x2*)(Y + (size_t)m * NE + YCKV))[lane];
        const float a = __uint_as_float(w.x << 16), b = __uint_as_float(w.x & 0xffff0000u), c = __uint_as_float(w.y << 16), d = __uint_as_float(w.y & 0xffff0000u);
        const float rstd = 1.0f / sqrtf(wave_sum(a * a + b * b + c * c + d * d) * (1.f / 256.f) + EPS);
        const f32x4 gg = ((const f32x4*)gn)[lane]; u32x2 o; o.x = pk2(a * rstd * gg.x, b * rstd * gg.y); o.y = pk2(c * rstd * gg.z, d * rstd * gg.w);
        ((u32x2*)(O + (size_t)m * 256))[lane] = o;
    }
}

__device__ __forceinline__ unsigned f2ord(float f) { const unsigned u = __float_as_uint(f + 0.0f); return (u & 0x80000000u) ? ~u : (u | 0x80000000u); }
__device__ __forceinline__ void phase_idx(const Ctx& F) {
    const bf16_t* Y = (const bf16_t*)(F.ws + WS_BIG + BG_Y);
    u32x2* MT = (u32x2*)(F.ws + WS_BIG + BG_MASK);
    unsigned short* LIST = (unsigned short*)(F.ws + WS_A + AF_LIST);
    int* CNT = (int*)(F.ws + WS_A + AF_CNT);
    LAS float* sc = (LAS float*)F.lds;
    LAS unsigned* hist = (LAS unsigned*)(F.lds + HIST_OFF) + F.wave * 264;
    const int tid = F.tid, lane = F.lane, wave = F.wave;
    for (int unit = F.bid; unit < T / 8; unit += F.nblk) {
        const int b = unit / 512, qg = 511 - (unit % 512); const int t0 = qg * 8, nkeys = t0 + 8;
        const size_t rowb = (size_t)b * SEQ;
        for (int s = tid; s < nkeys; s += NTHREADS) {
            float kf[64];
            { const u32x4* kp = (const u32x4*)(Y + (rowb + s) * NE + YKI);
#pragma unroll
              for (int c = 0; c < 8; ++c) { const u32x4 w = kp[c]; kf[8 * c + 0] = __uint_as_float(w.x << 16); kf[8 * c + 1] = __uint_as_float(w.x & 0xffff0000u); kf[8 * c + 2] = __uint_as_float(w.y << 16); kf[8 * c + 3] = __uint_as_float(w.y & 0xffff0000u);
                  kf[8 * c + 4] = __uint_as_float(w.z << 16); kf[8 * c + 5] = __uint_as_float(w.z & 0xffff0000u); kf[8 * c + 6] = __uint_as_float(w.w << 16); kf[8 * c + 7] = __uint_as_float(w.w & 0xffff0000u); } }
            for (int q = 0; q < 8; ++q) {
                const bf16_t* qrow = Y + (rowb + t0 + q) * NE;
                float score = 0.f;
                for (int h = 0; h < 8; ++h) {
                    const u32x4* qp = (const u32x4*)(qrow + YQI + h * 64); float dot = 0.f;
#pragma unroll
                    for (int c = 0; c < 8; ++c) { const u32x4 w = qp[c];
                        dot += kf[8 * c + 0] * __uint_as_float(w.x << 16) + kf[8 * c + 1] * __uint_as_float(w.x & 0xffff0000u) + kf[8 * c + 2] * __uint_as_float(w.y << 16) + kf[8 * c + 3] * __uint_as_float(w.y & 0xffff0000u)
                             + kf[8 * c + 4] * __uint_as_float(w.z << 16) + kf[8 * c + 5] * __uint_as_float(w.z & 0xffff0000u) + kf[8 * c + 6] * __uint_as_float(w.w << 16) + kf[8 * c + 7] * __uint_as_float(w.w & 0xffff0000u); }
                    score += fmaxf(dot, 0.f) * bf2f(qrow[YWI + h]);
                }
                sc[q * 4096 + s] = score;
            }
        }
        __syncthreads();
        {
            const int t = t0 + wave, n = t + 1; const size_t m = rowb + t;
            LAS float* row = sc + wave * 4096;
            u32x2* mrow = MT + (size_t)b * 64 * SEQ + t; unsigned short* lrow = LIST + m * 256;
            if (n <= 256) {
                { const int lo = lane * 64; unsigned long long bits = 0ull; if (lo + 63 <= t) bits = ~0ull; else if (lo <= t) bits = (2ull << (t - lo)) - 1ull; u32x2 w; w.x = (unsigned)bits; w.y = (unsigned)(bits >> 32); mrow[(size_t)lane * SEQ] = w; }
                for (int i = lane; i < 256; i += 64) lrow[i] = (unsigned short)(i < n ? i : 0);
                if (lane == 0) CNT[m] = n;
            } else {
                unsigned prefix = 0u; int kk = 256;
                for (int pass = 0; pass < 4; ++pass) {
                    const int shift = 24 - 8 * pass;
                    for (int i = lane; i < 264; i += 64) hist[i] = 0u;
                    asm volatile("s_waitcnt lgkmcnt(0)" ::: "memory");
                    for (int i = lane; i < n; i += 64) { const unsigned u = f2ord(row[i]); const bool match = (pass == 0) || ((u >> (shift + 8)) == (prefix >> (shift + 8)));
                        if (match) atomicAdd((unsigned*)&hist[(u >> shift) & 255u], 1u); }
                    asm volatile("s_waitcnt lgkmcnt(0)" ::: "memory");
                    const unsigned c0 = hist[4 * lane], c1 = hist[4 * lane + 1], c2 = hist[4 * lane + 2], c3 = hist[4 * lane + 3];
                    const unsigned tot = c0 + c1 + c2 + c3; unsigned suf = tot;
#pragma unroll
                    for (int o = 1; o < 64; o <<= 1) { const unsigned v = __shfl_down(suf, o); if (lane + o < 64) suf += v; }
                    unsigned above = suf - tot;
                    const unsigned cs[4] = {c0, c1, c2, c3};
#pragma unroll
                    for (int bb = 3; bb >= 0; --bb) { if ((int)above < kk && (int)(above + cs[bb]) >= kk) { hist[256] = (unsigned)(4 * lane + bb); hist[257] = (unsigned)(kk - (int)above); } above += cs[bb]; }
                    asm volatile("s_waitcnt lgkmcnt(0)" ::: "memory");
                    const unsigned dsel = hist[256]; kk = (int)hist[257];
                    prefix |= dsel << shift;
                    asm volatile("s_waitcnt lgkmcnt(0)" ::: "memory");
                }
                int cnt = 0, eqseen = 0;
                for (int base = 0; base < 4096; base += 64) {
                    const int i = base + lane; bool gt = false, eq = false;
                    if (i < n) { const unsigned u = f2ord(row[i]); gt = u > prefix; eq = (u == prefix); }
                    const unsigned long long beq = __ballot(eq); const unsigned long long lt = (1ull << lane) - 1ull;
                    const int rk = eqseen + __popcll(beq & lt);
                    const bool sel = gt || (eq && rk < kk);
                    const unsigned long long bs = __ballot(sel);
                    if (sel) lrow[cnt + __popcll(bs & lt)] = (unsigned short)i;
                    if (lane == 0) { u32x2 w; w.x = (unsigned)bs; w.y = (unsigned)(bs >> 32); mrow[(size_t)(base >> 6) * SEQ] = w; }
                    cnt += __popcll(bs); eqseen += __popcll(beq);
                }
                if (lane == 0) CNT[m] = cnt;
            }
        }
        __syncthreads();
    }
}

__device__ __forceinline__ void phase_att_naive(const Ctx& F) {
    const bf16_t* Y = (const bf16_t*)(F.ws + WS_BIG + BG_Y); const bf16_t* KV = (const bf16_t*)(F.ws + WS_MIX);
    const unsigned short* LIST = (const unsigned short*)(F.ws + WS_A + AF_LIST); const int* CNT = (const int*)(F.ws + WS_A + AF_CNT);
    bf16_t* C = (bf16_t*)(F.ws + WS_MIX + 32 * MiB);
    LAS float* wq = (LAS float*)F.lds + F.wave * 1024;
    LAS float* wp = wq + 64; LAS int* wi = (LAS int*)(wq + 64 + 256);
    const int gw = F.bid * NWAVES + F.wave, NGW = F.nblk * NWAVES, lane = F.lane;
    for (int unit = gw; unit < T * 8; unit += NGW) {
        const int m = unit >> 3, h = unit & 7, b = m / SEQ; const size_t rowb = (size_t)b * SEQ;
        wq[lane] = bf2f(Y[(size_t)m * NE + YQ + h * 64 + lane]);
        const int cnt = CNT[m];
        asm volatile("s_waitcnt lgkmcnt(0)" ::: "memory");
        float s[4]; int id[4]; float mx = -INFINITY;
#pragma unroll
        for (int j = 0; j < 4; ++j) { const int jj = lane + 64 * j; id[j] = LIST[(size_t)m * 256 + jj]; s[j] = -INFINITY;
            if (jj < cnt) { const u32x4* kp = (const u32x4*)(KV + (rowb + id[j]) * 1024 + h * 64); float dot = 0.f;
#pragma unroll
                for (int c = 0; c < 8; ++c) { const u32x4 w = kp[c]; const f32x4 q0 = *(const LAS f32x4*)(wq + 8 * c), q1 = *(const LAS f32x4*)(wq + 8 * c + 4);
                    dot += q0.x * __uint_as_float(w.x << 16) + q0.y * __uint_as_float(w.x & 0xffff0000u) + q0.z * __uint_as_float(w.y << 16) + q0.w * __uint_as_float(w.y & 0xffff0000u)
                         + q1.x * __uint_as_float(w.z << 16) + q1.y * __uint_as_float(w.z & 0xffff0000u) + q1.z * __uint_as_float(w.w << 16) + q1.w * __uint_as_float(w.w & 0xffff0000u); }
                s[j] = dot; }
            mx = fmaxf(mx, s[j]); }
        mx = wave_max(mx); float l = 0.f;
#pragma unroll
        for (int j = 0; j < 4; ++j) { const float p = (lane + 64 * j < cnt) ? exp2f(s[j] - mx) : 0.f; l += p; wp[lane + 64 * j] = p; wi[lane + 64 * j] = id[j]; }
        l = wave_sum(l);
        asm volatile("s_waitcnt lgkmcnt(0)" ::: "memory");
        float o = 0.f;
        for (int j = 0; j < cnt; ++j) o += wp[j] * bf2f(KV[(rowb + wi[j]) * 1024 + 512 + h * 64 + lane]);
        C[(size_t)m * 1024 + h * 64 + lane] = (bf16_t)f2bf(o / l);
        asm volatile("s_waitcnt lgkmcnt(0)" ::: "memory");
    }
}

template <int MODE> __device__ __forceinline__ void phase_lru(const Ctx& F) {
    const bf16_t* Y = (const bf16_t*)(F.ws + WS_BIG + BG_Y); bf16_t* C = (bf16_t*)(F.ws + WS_MIX + 32 * MiB);
    float* CA = (float*)(F.ws + WS_LRUA); float* CH = (float*)(F.ws + WS_LRUH);
    const int gw = F.bid * NWAVES + F.wave, NGW = F.nblk * NWAVES, lane = F.lane;
    for (int unit = gw; unit < NB * 8 * 64; unit += NGW) {
        const int g = unit & 7, ck = (unit >> 3) & 63, b = unit >> 9; const int ch = g * 64 + lane; const size_t rowb = (size_t)b * SEQ;
        float wra[64], wri[64];
#pragma unroll
        for (int i = 0; i < 64; ++i) { wra[i] = inp(I_ERA)[(size_t)(g * 64 + i) * 64 + lane]; wri[i] = inp(I_ERI)[(size_t)(g * 64 + i) * 64 + lane]; }
        const float bra = inp(I_EBRA)[ch], bri = inp(I_EBRI)[ch], lam = inp(I_ELAM)[ch], cb = inp(I_ECB)[ch];
        const float cw0 = inp(I_ECW)[ch], cw1 = inp(I_ECW)[512 + ch], cw2 = inp(I_ECW)[1024 + ch], cw3 = inp(I_ECW)[1536 + ch];
        const float spl = log1pf(__expf(-lam));
        const int t0 = ck * 64;
        float x3 = (t0 >= 3) ? bf2f(Y[(rowb + t0 - 3) * NE + YXB + ch]) : 0.f, x2 = (t0 >= 2) ? bf2f(Y[(rowb + t0 - 2) * NE + YXB + ch]) : 0.f, x1 = (t0 >= 1) ? bf2f(Y[(rowb + t0 - 1) * NE + YXB + ch]) : 0.f;
        float hst = 0.f, aprod = 1.f;
        if (MODE == 1) { for (int c = 0; c < ck; ++c) { const float a = CA[((size_t)b * 64 + c) * 512 + ch], hh = CH[((size_t)b * 64 + c) * 512 + ch]; hst = a * hst + hh; } }
        for (int tt = 0; tt < 64; ++tt) {
            const size_t m = rowb + t0 + tt;
            const float x0 = bf2f(Y[m * NE + YXB + ch]);
            const float xc = cw0 * x3 + cw1 * x2 + cw2 * x1 + cw3 * x0 + cb;
            x3 = x2; x2 = x1; x1 = x0;
            float ra = bra, ri = bri;
#pragma unroll
            for (int i = 0; i < 64; ++i) { const float xi = __uint_as_float(__builtin_amdgcn_readlane(__float_as_uint(xc), i)); ra += xi * wra[i]; ri += xi * wri[i]; }
            const float r = sigmoidf_(ra), ig = sigmoidf_(ri);
            const float log_a = -8.0f * r * spl; const float a = __expf(log_a); const float bb = sqrtf(-expm1f(2.0f * log_a)) * (ig * xc);
            hst = a * hst + bb; aprod *= a;
            if (MODE == 1) { const float gt = bf2f(Y[m * NE + YGATE + ch]); const float u = 0.7978845608028654f * (gt + 0.044715f * gt * gt * gt); const float ge = 0.5f * gt * (1.0f + tanhf(u));
                C[m * 1024 + 512 + ch] = (bf16_t)f2bf(hst * ge); }
        }
        if (MODE == 0) { CA[((size_t)b * 64 + ck) * 512 + ch] = aprod; CH[((size_t)b * 64 + ck) * 512 + ch] = hst; }
    }
}

__device__ __forceinline__ void phase_gla_a(const Ctx& F) {
    const bf16_t* Z = (const bf16_t*)(F.ws + WS_BIG + BG_Y);
    bf16_t* QD = (bf16_t*)(F.ws + WS_A + AF_QD); bf16_t* KI = (bf16_t*)(F.ws + WS_A + AF_KI); bf16_t* KR = (bf16_t*)(F.ws + WS_A + AF_KR); bf16_t* ATT = (bf16_t*)(F.ws + WS_A + AF_ATT);
    float* DEC = (float*)(F.ws + WS_DEC);
    LAS float* G = (LAS float*)F.lds;
    LAS float* qd = G + 64 * 128;
    LAS float* ki = qd + 64 * 129;
    LAS float* gl = ki + 64 * 129;
    const int tid = F.tid;
    for (int unit = F.bid; unit < NB * 64 * 4; unit += F.nblk) {
        const int h = unit & 3, n = (unit >> 2) & 63, b = unit >> 8; const size_t row0 = (size_t)b * SEQ + n * 64;
        for (int i = tid; i < 64 * 16; i += NTHREADS) gl[i] = bf2f(Z[(row0 + (i >> 4)) * NO + ZG + (i & 15)]);
        __syncthreads();
        for (int i = tid; i < 64 * 128; i += NTHREADS) { const int j = i >> 7, d = i & 127; float z = inp(I_OBG)[h * 128 + d];
#pragma unroll
            for (int r = 0; r < 16; ++r) z += gl[j * 16 + r] * inp(I_OG2)[r * 512 + h * 128 + d];
            const float ls = fminf(z, 0.f) - log1pf(__expf(-fabsf(z)));
            G[i] = ls * (1.0f / 16.0f); }
        __syncthreads();
        if (tid < 128) { float run = 0.f; for (int j = 0; j < 64; ++j) { run += G[j * 128 + tid]; G[j * 128 + tid] = run; } DEC[((size_t)b * 64 + n) * 512 + h * 128 + tid] = __expf(run); }
        __syncthreads();
        for (int i = tid; i < 64 * 128; i += NTHREADS) { const int j = i >> 7, d = i & 127; const size_t m = row0 + j;
            const float q = bf2f(Z[m * NO + ZQ + h * 128 + d]) * 0.08838834764831845f, k = bf2f(Z[m * NO + ZK + h * 128 + d]);
            const float gg = G[i], glast = G[63 * 128 + d];
            const float qdv = q * __expf(gg), kiv = k * __expf(-gg), krv = k * __expf(glast - gg);
            const bf16_t qb = (bf16_t)f2bf(qdv), kb = (bf16_t)f2bf(kiv);
            QD[m * 512 + h * 128 + d] = qb; KI[m * 512 + h * 128 + d] = kb; KR[m * 512 + h * 128 + d] = (bf16_t)f2bf(krv);
            qd[j * 129 + d] = bf2f(qb); ki[j * 129 + d] = bf2f(kb); }
        __syncthreads();
        for (int i = tid; i < 64 * 64; i += NTHREADS) { const int ii = i >> 6, jj = i & 63; float a = 0.f;
            if (jj <= ii) { for (int d = 0; d < 128; ++d) a += qd[ii * 129 + d] * ki[jj * 129 + d]; }
            ATT[(size_t)unit * 4096 + i] = (bf16_t)f2bf(a); }
        __syncthreads();
    }
}
__device__ __forceinline__ void phase_gla_b(const Ctx& F) {
    const bf16_t* Z = (const bf16_t*)(F.ws + WS_BIG + BG_Y);
    const bf16_t* QD = (const bf16_t*)(F.ws + WS_A + AF_QD); const bf16_t* KR = (const bf16_t*)(F.ws + WS_A + AF_KR); const bf16_t* ATT = (const bf16_t*)(F.ws + WS_A + AF_ATT);
    const float* DEC = (const float*)(F.ws + WS_DEC); bf16_t* ORAW = (bf16_t*)(F.ws + WS_MIX);
    LAS float* qd = (LAS float*)F.lds;
    LAS float* kr = qd + 64 * 129;
    LAS float* at = kr + 64 * 129;
    LAS float* vv = at + 64 * 65;
    LAS float* st = vv + 64 * 17;
    LAS float* dc = st + 128 * 17;
    const int tid = F.tid;
    for (int unit = F.bid; unit < NB * 4 * 16; unit += F.nblk) {
        const int vs = unit & 15, h = (unit >> 4) & 3, b = unit >> 6;
        for (int i = tid; i < 128 * 17; i += NTHREADS) st[i] = 0.f;
        __syncthreads();
        for (int n = 0; n < 64; ++n) {
            const size_t row0 = (size_t)b * SEQ + n * 64; const int au = ((b * 64 + n) << 2) + h;
            for (int i = tid; i < 64 * 128; i += NTHREADS) { const int j = i >> 7, d = i & 127; qd[j * 129 + d] = bf2f(QD[(row0 + j) * 512 + h * 128 + d]); kr[j * 129 + d] = bf2f(KR[(row0 + j) * 512 + h * 128 + d]); }
            for (int i = tid; i < 64 * 64; i += NTHREADS) at[(i >> 6) * 65 + (i & 63)] = bf2f(ATT[(size_t)au * 4096 + i]);
            for (int i = tid; i < 64 * 16; i += NTHREADS) vv[(i >> 4) * 17 + (i & 15)] = bf2f(Z[(row0 + (i >> 4)) * NO + ZV + h * 256 + vs * 16 + (i & 15)]);
            if (tid < 128) dc[tid] = DEC[((size_t)b * 64 + n) * 512 + h * 128 + tid];
            __syncthreads();
#pragma unroll
            for (int r = 0; r < 2; ++r) { const int idx = tid + r * NTHREADS, i = idx >> 4, v = idx & 15; float o = 0.f;
                for (int j = 0; j <= i; ++j) o += at[i * 65 + j] * vv[j * 17 + v];
                for (int d = 0; d < 128; ++d) o += qd[i * 129 + d] * st[d * 17 + v];
                ORAW[(row0 + i) * 1024 + h * 256 + vs * 16 + v] = (bf16_t)f2bf(o); }
            __syncthreads();
            float ns[4];
#pragma unroll
            for (int r = 0; r < 4; ++r) { const int idx = tid + r * NTHREADS, d = idx >> 4, v = idx & 15; float a = dc[d] * st[d * 17 + v];
                for (int j = 0; j < 64; ++j) a += kr[j * 129 + d] * vv[j * 17 + v];
                ns[r] = a; }
            __syncthreads();
#pragma unroll
            for (int r = 0; r < 4; ++r) { const int idx = tid + r * NTHREADS; st[(idx >> 4) * 17 + (idx & 15)] = ns[r]; }
            __syncthreads();
        }
    }
}
__device__ __forceinline__ void phase_gla_c(const Ctx& F) {
    const bf16_t* Z = (const bf16_t*)(F.ws + WS_BIG + BG_Y); const bf16_t* ORAW = (const bf16_t*)(F.ws + WS_MIX); bf16_t* C = (bf16_t*)(F.ws + WS_MIX + 32 * MiB);
    const float* hn = inp(I_OHN);
    const int gw = F.bid * NWAVES + F.wave, NGW = F.nblk * NWAVES, lane = F.lane;
    for (int m = gw; m < T; m += NGW) {
#pragma unroll
        for (int j = 0; j < 4; ++j) { const u32x2 w = ((const u32x2*)(ORAW + (size_t)m * 1024))[lane + 64 * j]; const u32x2 rw = ((const u32x2*)(Z + (size_t)m * NO + ZR))[lane + 64 * j];
            const float a = __uint_as_float(w.x << 16), bq = __uint_as_float(w.x & 0xffff0000u), c = __uint_as_float(w.y << 16), d = __uint_as_float(w.y & 0xffff0000u);
            const float rstd = 1.0f / sqrtf(wave_sum(a * a + bq * bq + c * c + d * d) * (1.f / 256.f) + EPS);
            const f32x4 gg = ((const f32x4*)hn)[lane];
            const float r0 = __uint_as_float(rw.x << 16), r1 = __uint_as_float(rw.x & 0xffff0000u), r2 = __uint_as_float(rw.y << 16), r3 = __uint_as_float(rw.y & 0xffff0000u);
            u32x2 o; o.x = pk2(a * rstd * gg.x * r0 * sigmoidf_(r0), bq * rstd * gg.y * r1 * sigmoidf_(r1)); o.y = pk2(c * rstd * gg.z * r2 * sigmoidf_(r2), d * rstd * gg.w * r3 * sigmoidf_(r3));
            ((u32x2*)(C + (size_t)m * 1024))[lane + 64 * j] = o; }
    }
}

__device__ __forceinline__ void phase_vt(const Ctx& F) {
    const bf16_t* KVm = (const bf16_t*)(F.ws + WS_KVM); bf16_t* Vt = (bf16_t*)(F.ws + WS_VT);
    const int gt = F.bid * NTHREADS + F.tid, NGT = F.nblk * NTHREADS;
    for (int i = gt; i < 1024 * 1024; i += NGT) { const int mm = i & 255, d = (i >> 8) & 255, h = (i >> 16) & 3, b = i >> 18;
        Vt[i] = KVm[(size_t)(b * 256 + mm) * 2048 + 1024 + h * 256 + d]; }
}
__device__ __forceinline__ void phase_xsoftmax(const Ctx& F) {
    const bf16_t* S = (const bf16_t*)(F.ws + WS_BIG + BG_S); bf16_t* P = (bf16_t*)(F.ws + WS_MIX);
    const int gw = F.bid * NWAVES + F.wave, NGW = F.nblk * NWAVES, lane = F.lane;
    for (int m = gw; m < T; m += NGW) {
#pragma unroll
        for (int j = 0; j < 4; ++j) { const u32x2 w = ((const u32x2*)(S + (size_t)m * 1024))[lane + 64 * j];
            const float a = __uint_as_float(w.x << 16), b = __uint_as_float(w.x & 0xffff0000u), c = __uint_as_float(w.y << 16), d = __uint_as_float(w.y & 0xffff0000u);
            const float mx = wave_max(fmaxf(fmaxf(a, b), fmaxf(c, d)));
            const float ea = __expf(a - mx), eb = __expf(b - mx), ec = __expf(c - mx), ed = __expf(d - mx);
            const float inv = 1.0f / wave_sum((ea + eb) + (ec + ed));
            u32x2 o; o.x = pk2(ea * inv, eb * inv); o.y = pk2(ec * inv, ed * inv);
            ((u32x2*)(P + (size_t)m * 1024))[lane + 64 * j] = o; }
    }
}

enum Kind { K_PREP = 0, K_SWIGLU, K_GEMM, K_NORM, K_CKVN, K_IDX, K_ATT, K_LRU_A, K_LRU_B, K_GLA_A, K_GLA_B, K_GLA_C, K_VT, K_XSOFTMAX };
enum Op { OP_UP1 = 0, OP_DN1, OP_N1, OP_IN, OP_M0, OP_M1, OP_M2, OP_M3, OP_M4, OP_M5, OP_OUT, OP_N2, OP_XQ, OP_XKV, OP_XVT, OP_XS, OP_XSM, OP_XO, OP_XOUT, OP_N3, OP_UP2, OP_DN2, OP_N4, OP_COUNT };
constexpr int NPHASES = 1 + 2 * OP_COUNT;

struct Desc { int kind; pg8::Gemm g; bf16_t* O; int ldc; float scale; const bf16_t* Fb; const float* hin; float coef; const float* gpost; const float* gpre; };
__device__ __forceinline__ void st_ptr(LAS unsigned* p, const void* q) { const unsigned long long v = (unsigned long long)(uintptr_t)q; p[0] = (unsigned)v; p[1] = (unsigned)(v >> 32); }
__device__ __forceinline__ unsigned ld_u(const LAS unsigned* p) { return (unsigned)__builtin_amdgcn_readfirstlane((int)p[0]); }
__device__ __forceinline__ const void* ld_ptr(const LAS unsigned* p) { const unsigned long long v = (unsigned long long)ld_u(p) | ((unsigned long long)ld_u(p + 1) << 32); return (const void*)(uintptr_t)v; }
__device__ __forceinline__ void desc_store(LAS unsigned* t, const Desc& d) {
    t[0] = (unsigned)d.kind; st_ptr(t + 1, d.g.A); st_ptr(t + 3, d.g.Bt); t[5] = d.g.lda; t[6] = d.g.ldb; t[7] = d.g.K; t[8] = d.g.nM; t[9] = d.g.nN; t[10] = d.g.a_pn_off; t[11] = d.g.b_pn_off; t[12] = d.g.b_batch_off; t[13] = d.g.bshift;
    st_ptr(t + 14, d.O); t[16] = d.ldc; t[17] = __float_as_uint(d.scale); st_ptr(t + 18, d.Fb); st_ptr(t + 20, d.hin); t[22] = __float_as_uint(d.coef); st_ptr(t + 23, d.gpost); st_ptr(t + 25, d.gpre);
}
__device__ __forceinline__ Desc desc_load(const LAS unsigned* t) {
    Desc d; d.kind = (int)ld_u(t); d.g.A = (const bf16_t*)ld_ptr(t + 1); d.g.Bt = (const bf16_t*)ld_ptr(t + 3); d.g.lda = ld_u(t + 5); d.g.ldb = ld_u(t + 6); d.g.K = ld_u(t + 7); d.g.nM = ld_u(t + 8); d.g.nN = ld_u(t + 9);
    d.g.a_pn_off = ld_u(t + 10); d.g.b_pn_off = ld_u(t + 11); d.g.b_batch_off = ld_u(t + 12); d.g.bshift = ld_u(t + 13);
    d.O = (bf16_t*)ld_ptr(t + 14); d.ldc = ld_u(t + 16); d.scale = __uint_as_float(ld_u(t + 17)); d.Fb = (const bf16_t*)ld_ptr(t + 18); d.hin = (const float*)ld_ptr(t + 20); d.coef = __uint_as_float(ld_u(t + 22));
    d.gpost = (const float*)ld_ptr(t + 23); d.gpre = (const float*)ld_ptr(t + 25); return d;
}

__device__ __forceinline__ Desc make_desc(const Ctx& F, int ph) {
    Desc d; d.kind = -1; d.O = nullptr; d.ldc = 0; d.scale = 1.f; d.Fb = nullptr; d.hin = nullptr; d.coef = 0.f; d.gpost = nullptr; d.gpre = nullptr;
    d.g = pg8::plain_gemm(nullptr, 0, nullptr, 0, 256, 256, 256);
    if (ph == 0) { d.kind = K_PREP; return d; }
    const int l = (ph - 1) / OP_COUNT, op = (ph - 1) % OP_COUNT;
    unsigned char* ws = F.ws; const float* nrm = inp(I_NORMS) + (size_t)l * 9 * D;
    bf16_t* A = (bf16_t*)(ws + WS_A); bf16_t* Fb = (bf16_t*)(ws + WS_F); bf16_t* BIG = (bf16_t*)(ws + WS_BIG); bf16_t* MIX = (bf16_t*)(ws + WS_MIX); bf16_t* Cc = (bf16_t*)(ws + WS_MIX + 32 * MiB);
    const unsigned char* W = ws + WS_W;
    switch (op) {
    case OP_UP1: case OP_UP2: { const int i = (op == OP_UP2); d.kind = K_SWIGLU; d.g = pg8::plain_gemm(A, D, (const bf16_t*)(W + W_GU) + (size_t)(l * 2 + i) * 2 * FF * D, D, T, 2 * FF, D); d.O = BIG; d.ldc = FF; break; }
    case OP_DN1: case OP_DN2: { const int i = (op == OP_DN2); d.kind = K_GEMM; d.g = pg8::plain_gemm(BIG, FF, (const bf16_t*)(W + W_DN) + (size_t)(l * 2 + i) * D * FF, FF, T, D, FF); d.O = Fb; d.ldc = D; break; }
    case OP_N1: d.kind = K_NORM; d.Fb = Fb; d.hin = (l == 0) ? inp(I_X) : F.out; d.coef = 0.5f; d.gpost = nrm + N_FFN1_POST * D; d.gpre = nrm + N_MIX_PRE * D; break;
    case OP_IN: d.kind = K_GEMM; if (l == 0) d.g = pg8::plain_gemm(A, D, (const bf16_t*)(W + W_EIN), D, T, NE, D); else d.g = pg8::plain_gemm(A, D, (const bf16_t*)(W + W_OIN), D, T, NO, D);
                d.O = BIG; d.ldc = (l == 0) ? NE : NO; break;
    case OP_M0: d.kind = (l == 0) ? K_CKVN : K_GLA_A; break;
    case OP_M1: if (l == 0) { d.kind = K_GEMM; d.g = pg8::plain_gemm((const bf16_t*)(ws + WS_BIG + BG_CKVN), 256, (const bf16_t*)(W + W_UKV), 256, T, 1024, 256); d.O = MIX; d.ldc = 1024; } else d.kind = K_GLA_B; break;
    case OP_M2: d.kind = (l == 0) ? K_IDX : K_GLA_C; break;
    case OP_M3: d.kind = (l == 0) ? K_ATT : -1; break;
    case OP_M4: d.kind = (l == 0) ? K_LRU_A : -1; break;
    case OP_M5: d.kind = (l == 0) ? K_LRU_B : -1; break;
    case OP_OUT: d.kind = K_GEMM; d.g = pg8::plain_gemm(Cc, D, (const bf16_t*)(W + (l == 0 ? W_EOUT : W_OOUT)), D, T, D, D); d.O = Fb; d.ldc = D; break;
    case OP_N2: d.kind = K_NORM; d.Fb = Fb; d.hin = F.out; d.coef = 1.0f; d.gpost = nrm + N_MIX_POST * D; d.gpre = nrm + N_XA_PRE * D; break;
    case OP_XQ: d.kind = K_GEMM; d.g = pg8::plain_gemm(A, D, (const bf16_t*)(W + W_Q) + (size_t)l * D * D, D, T, D, D); d.O = BIG; d.ldc = D; break;
    case OP_XKV: d.kind = K_GEMM; d.g = pg8::plain_gemm((const bf16_t*)(ws + (l ? WS_MEMN1 : WS_MEMN0)), D, (const bf16_t*)(W + W_KV) + (size_t)l * 2 * D * D, D, 1024, 2 * D, D); d.O = (bf16_t*)(ws + WS_KVM); d.ldc = 2 * D; break;
    case OP_XVT: d.kind = K_VT; break;
    case OP_XS: { d.kind = K_GEMM; pg8::Gemm g; g.A = BIG; g.Bt = (const bf16_t*)(ws + WS_KVM); g.lda = D; g.ldb = 2 * D; g.K = 256; g.nM = T / 256; g.nN = 4; g.a_pn_off = 256; g.b_pn_off = 256; g.b_batch_off = 256 * 2 * D; g.bshift = 4;
                  d.g = g; d.O = (bf16_t*)(ws + WS_BIG + BG_S); d.ldc = D; d.scale = 0.0625f; break; }
    case OP_XSM: d.kind = K_XSOFTMAX; break;
    case OP_XO: { d.kind = K_GEMM; pg8::Gemm g; g.A = MIX; g.Bt = (const bf16_t*)(ws + WS_VT); g.lda = D; g.ldb = 256; g.K = 256; g.nM = T / 256; g.nN = 4; g.a_pn_off = 256; g.b_pn_off = 256 * 256; g.b_batch_off = 4 * 256 * 256; g.bshift = 4;
                  d.g = g; d.O = BIG; d.ldc = D; break; }
    case OP_XOUT: d.kind = K_GEMM; d.g = pg8::plain_gemm(BIG, D, (const bf16_t*)(W + W_O) + (size_t)l * D * D, D, T, D, D); d.O = Fb; d.ldc = D; break;
    case OP_N3: d.kind = K_NORM; d.Fb = Fb; d.hin = F.out; d.coef = 1.0f; d.gpost = nrm + N_XA_POST * D; d.gpre = nrm + N_FFN2_PRE * D; break;
    case OP_N4: d.kind = K_NORM; d.Fb = Fb; d.hin = F.out; d.coef = 0.5f; d.gpost = nrm + N_FFN2_POST * D; d.gpre = (l == 0) ? (inp(I_NORMS) + (size_t)(9 + N_FFN1_PRE) * D) : nullptr; break;
    default: break;
    }
    return d;
}

__global__ void __launch_bounds__(NTHREADS, 2) mk_fwd(Args args) {
    extern __shared__ __attribute__((aligned(16))) unsigned char lds_raw[];
    Ctx F; F.lds = (LAS unsigned char*)lds_raw; F.ldsg = (char*)lds_raw; F.tid = threadIdx.x; F.lane = F.tid & 63; F.wave = __builtin_amdgcn_readfirstlane(F.tid >> 6);
    F.nblk = gridDim.x; F.bid = blockIdx.x; F.out = args.out; F.ws = args.ws;
    volatile LAS unsigned* MISC = (volatile LAS unsigned*)(F.lds + MISC_OFF);
    for (int u = F.tid; u < (LDS_BYTES - MISC_OFF) / 4; u += NTHREADS) MISC[u] = 0u;
    __syncthreads();
    XcdBarrier bar; bar.bar = (unsigned*)(args.ws + WS_CTL) + CW_BAR; bar.x = 0; bar.st = nullptr;
#if !MK_PER_PHASE
    bar = xcd_barrier_post((unsigned*)(args.ws + WS_CTL) + CW_BAR, MISC + 8);
#endif
    F.kp = (const __attribute__((address_space(4))) void*)__builtin_amdgcn_kernarg_segment_ptr();
    if (F.tid < NPHASES) { const Desc dd = make_desc(F, F.tid); desc_store((LAS unsigned*)(F.lds + DESC_OFF) + F.tid * DESC_WORDS, dd); }
    __syncthreads();
    const Ctx F0 = F;
    for (int ph = args.ph_lo; ph < args.ph_hi; ++ph) {
        Ctx F = F0;
        F.tid = F0.tid;
        const Desc d = desc_load((const LAS unsigned*)(F.lds + DESC_OFF) + ph * DESC_WORDS);
        if (d.kind < 0) continue;
#ifndef PH_ENABLE
#define PH_ENABLE 0xffffffffu
#endif
#define EN(k) (((PH_ENABLE) >> (k)) & 1u)
#ifndef REPEAT_MASK
#define REPEAT_MASK 0u
#endif
        for (int rep = 0; rep < 1 + (int)((REPEAT_MASK >> d.kind) & 1u); ++rep) {
        if (rep) __syncthreads();
        F = F0;
        { unsigned long long p0 = (unsigned long long)(uintptr_t)F.ws, p1 = (unsigned long long)(uintptr_t)F.out, p2 = (unsigned long long)(uintptr_t)F.kp;
          unsigned a0 = (unsigned)p0, a1 = (unsigned)(p0 >> 32), b0 = (unsigned)p1, b1 = (unsigned)(p1 >> 32), c0 = (unsigned)p2, c1 = (unsigned)(p2 >> 32); int w_ = F.wave, n_ = F.nblk, i_ = F.bid;
          int ln_; asm volatile("v_mbcnt_lo_u32_b32 %0, -1, 0\n\tv_mbcnt_hi_u32_b32 %0, -1, %0" : "=v"(ln_));
          asm volatile("" : "+v"(a0), "+v"(a1), "+v"(b0), "+v"(b1), "+v"(c0), "+v"(c1), "+v"(w_), "+v"(n_), "+v"(i_));
#define RFL(x) ((unsigned)__builtin_amdgcn_readfirstlane((int)(x)))
          F.ws = (unsigned char*)(uintptr_t)((unsigned long long)RFL(a0) | ((unsigned long long)RFL(a1) << 32)); F.out = (float*)(uintptr_t)((unsigned long long)RFL(b0) | ((unsigned long long)RFL(b1) << 32));
          F.kp = (const __attribute__((address_space(4))) void*)(uintptr_t)((unsigned long long)RFL(c0) | ((unsigned long long)RFL(c1) << 32)); F.wave = (int)RFL(w_); F.nblk = (int)RFL(n_); F.bid = (int)RFL(i_); F.lane = ln_; F.tid = F.wave * 64 + ln_; }
        switch (d.kind) {
        case K_PREP: if constexpr (EN(K_PREP)) { phase_prep(F); } break;
#if NAIVE_GEMM
        case K_SWIGLU: { pg8::EpiSwiglu E{d.O, d.ldc}; pg8::gemm_naive<2>(F.lds, d.g, E, F.nblk, F.bid, F.tid); break; }
        case K_GEMM: { pg8::EpiBf16 E{d.O, d.ldc, d.scale}; pg8::gemm_naive<1>(F.lds, d.g, E, F.nblk, F.bid, F.tid); break; }
#else
        case K_SWIGLU: case K_GEMM: if constexpr (EN(K_GEMM)) {
            pg8::StaticOrder S; S.init(d.g.nM, d.g.nN, F.nblk, F.bid); pg8::EpiAny E{d.O, d.ldc, d.scale, d.kind == K_SWIGLU ? 1 : 0}; pg8::gemm_phase<pg8::EpiAny, true>(F.lds, d.g, S, E, F.tid);
            break; }
#endif
        case K_NORM: if constexpr (EN(K_NORM)) { phase_norm(F, d.Fb, d.hin, F.out, d.coef, d.gpost, d.gpre, (bf16_t*)(F.ws + WS_A)); } break;
        case K_CKVN: if constexpr (EN(K_CKVN)) { phase_ckvn(F); } break;
        case K_IDX: if constexpr (EN(K_IDX)) { phase_idx(F); } break;
        #ifdef ATT_NAIVE
        case K_ATT: if constexpr (EN(K_ATT)) { phase_att_naive(F); } break;
#else
        case K_ATT: if constexpr (EN(K_ATT)) { dsa::attn_phase<8>(F.tid, F.nblk, F.bid, (const dsa::bf16*)(F.ws + WS_BIG + BG_Y) + YQ, (const dsa::bf16*)(F.ws + WS_MIX), (const dsa::bf16*)(F.ws + WS_MIX) + 512,
                                                                  (dsa::bf16*)(F.ws + WS_MIX + 32 * MiB), (const dsa::u32x2*)(F.ws + WS_BIG + BG_MASK), F.ldsg); } break;
#endif
        case K_LRU_A: if constexpr (EN(K_LRU_A)) { phase_lru<0>(F); } break;
        case K_LRU_B: if constexpr (EN(K_LRU_B)) { phase_lru<1>(F); } break;
        case K_GLA_A: if constexpr (EN(K_GLA_A)) { phase_gla_a(F); } break;
        case K_GLA_B: if constexpr (EN(K_GLA_B)) { phase_gla_b(F); } break;
        case K_GLA_C: if constexpr (EN(K_GLA_C)) { phase_gla_c(F); } break;
        case K_VT: if constexpr (EN(K_VT)) { phase_vt(F); } break;
        case K_XSOFTMAX: if constexpr (EN(K_XSOFTMAX)) { phase_xsoftmax(F); } break;
        default: break;
        }
        }
#if !MK_PER_PHASE
        if (ph + 1 < args.ph_hi) {
            if (ph == 0) { cg::this_grid().sync(); }
            xcd_barrier(bar);
        }
#endif
    }
}

extern "C" void kernel_launch(void* const* d_in, const int* in_sizes, int n_in, void* d_out, int out_size, void* d_ws, size_t ws_size, hipStream_t stream) {
    static int grid = 0;
    if (grid == 0) {
        if (n_in != 25 || in_sizes[0] != T * D || out_size != T * D || ws_size < WS_END) { fprintf(stderr, "kernel_launch: unexpected shapes (n_in %d, in0 %d, out %d, ws %zu); nothing launched\n", n_in, n_in > 0 ? in_sizes[0] : -1, out_size, ws_size); grid = -1; return; }
        int dev = 0, cus = 0, per_cu = 0;
        if (hipGetDevice(&dev) != hipSuccess || hipDeviceGetAttribute(&cus, hipDeviceAttributeMultiprocessorCount, dev) != hipSuccess) { grid = -1; return; }
        if (hipFuncSetAttribute((const void*)mk_fwd, hipFuncAttributeMaxDynamicSharedMemorySize, LDS_BYTES) != hipSuccess) { fprintf(stderr, "kernel_launch: hipFuncSetAttribute failed\n"); grid = -1; return; }
        if (hipOccupancyMaxActiveBlocksPerMultiprocessor(&per_cu, (const void*)mk_fwd, NTHREADS, LDS_BYTES) != hipSuccess || per_cu < 1) { fprintf(stderr, "kernel_launch: occupancy query says %d\n", per_cu); (void)hipGetLastError(); grid = -1; return; }
        grid = cus;
    }
    if (grid < 0) return;
    (void)hipMemsetAsync((char*)d_ws + WS_CTL, 0, CTL_BYTES, stream);
    Args a{};
    for (int i = 0; i < 25; ++i) a.in[i] = (const float*)d_in[i];
    a.out = (float*)d_out; a.ws = (unsigned char*)d_ws;
#if MK_PER_PHASE
    for (int ph = 0; ph < NPHASES; ++ph) { a.ph_lo = ph; a.ph_hi = ph + 1; hipLaunchKernelGGL(mk_fwd, dim3(grid), dim3(NTHREADS), LDS_BYTES, stream, a); }
#else
    a.ph_lo = 0; a.ph_hi = NPHASES;
    void* kargs[] = {&a};
    hipError_t e = hipLaunchCooperativeKernel((const void*)mk_fwd, dim3(grid), dim3(NTHREADS), kargs, LDS_BYTES, stream);
    if (e != hipSuccess) fprintf(stderr, "cooperative launch failed: %s (grid %d)\n", hipGetErrorString(e), grid);
#endif
}
```

```cpp
#include <hip/hip_runtime.h>
#include <hip/hip_cooperative_groups.h>
#include <hip/hip_bf16.h>
#include <cmath>
#include <cstdio>
#include <cstdint>
namespace cg = cooperative_groups;

#ifndef MK_PER_PHASE
#define MK_PER_PHASE 0
#endif
#ifndef NAIVE_GEMM
#define NAIVE_GEMM 0
#endif

#define LAS __attribute__((address_space(3)))
#define GAS __attribute__((address_space(1)))
typedef unsigned short bf16_t;
typedef short bf16x8 __attribute__((ext_vector_type(8)));
typedef float f32x4 __attribute__((ext_vector_type(4)));
typedef float f32x2 __attribute__((ext_vector_type(2)));
typedef unsigned u32x4 __attribute__((ext_vector_type(4)));
typedef unsigned u32x2 __attribute__((ext_vector_type(2)));

constexpr int NB = 4, SEQ = 4096, T = NB * SEQ, D = 1024, FF = 2816;
constexpr int NE = 2560, NO = 3328;
constexpr int YQ = 0, YCKV = 512, YQI = 768, YKI = 1280, YWI = 1344, YGATE = 1536, YXB = 2048;
constexpr int ZQ = 0, ZK = 512, ZV = 1024, ZG = 2048, ZR = 2304;
constexpr float EPS = 1e-6f;
constexpr float C2 = 0.125f * 1.4426950408889634f;

constexpr size_t MiB = 1u << 20;
constexpr size_t WS_CTL = 0, CTL_BYTES = 1 * MiB;
constexpr size_t WS_MEMN0 = 1 * MiB, WS_MEMN1 = 3 * MiB, WS_KVM = 5 * MiB, WS_VT = 9 * MiB, WS_LRUA = 11 * MiB, WS_LRUH = 11 * MiB + 512 * 1024, WS_DEC = 12 * MiB;
constexpr size_t WS_W = 17 * MiB;
constexpr size_t W_GU = 0, W_DN = 44 * MiB, W_Q = 66 * MiB, W_KV = 70 * MiB, W_O = 78 * MiB, W_EIN = 82 * MiB, W_UKV = 87 * MiB, W_EOUT = 87 * MiB + 512 * 1024,
                 W_OIN = 89 * MiB + 512 * 1024, W_OOUT = 96 * MiB;
constexpr size_t WS_A = 115 * MiB, WS_F = 147 * MiB;
constexpr size_t WS_BIG = 179 * MiB;
constexpr size_t WS_MIX = 283 * MiB;
constexpr size_t WS_END = 347 * MiB;
constexpr size_t AF_LIST = 0, AF_CNT = 8 * MiB;
constexpr size_t AF_QD = 0, AF_KI = 16 * MiB, AF_KR = 32 * MiB, AF_ATT = 48 * MiB;
constexpr size_t BG_Y = 0, BG_CKVN = 80 * MiB, BG_MASK = 88 * MiB;
constexpr size_t BG_Q = 0, BG_S = 32 * MiB;
constexpr size_t BG_H = 0;
constexpr int CW_BAR = 4096;

__device__ __forceinline__ float bf2f(bf16_t v) { return __uint_as_float((unsigned)v << 16); }
__device__ __forceinline__ unsigned f2bf(float f) { unsigned u = __float_as_uint(f); return (u + 0x7fffu + ((u >> 16) & 1u)) >> 16; }
__device__ __forceinline__ unsigned pk2(float lo, float hi) { return f2bf(lo) | (f2bf(hi) << 16); }
__device__ __forceinline__ float wave_sum(float v) {
#pragma unroll
    for (int o = 1; o < 64; o <<= 1) v += __shfl_xor(v, o);
    return v;
}
__device__ __forceinline__ float wave_max(float v) {
#pragma unroll
    for (int o = 1; o < 64; o <<= 1) v = fmaxf(v, __shfl_xor(v, o));
    return v;
}
__device__ __forceinline__ float sigmoidf_(float x) { return 1.0f / (1.0f + __expf(-x)); }

namespace pg8 {
constexpr int BM = 256, BK = 64, HALF = 128, HTB = HALF * BK * 2, STAGE_BYTES = 8 * HTB, NXCD = 8, WGM = 8;
__host__ __device__ __forceinline__ int lds_byte(int r, int c) { const int st = (r >> 4) * 2 + (c >> 5), rr = r & 15, cc = c & 31, ob = rr * 64 + cc * 2; return st * 1024 + (ob ^ (((ob >> 9) & 1) << 5)); }
__host__ __device__ __forceinline__ void stage_rc(int b, int& R, int& C) { const int st = b / 1024, sb = b % 1024, swz = sb ^ (((sb >> 9) & 1) << 5); R = (st >> 1) * 16 + swz / 64; C = (st & 1) * 32 + (swz % 64) / 2; }
__host__ __device__ __forceinline__ int perm32(int rho) { const int n = rho >> 4, i = rho & 15; return 8 * (i >> 2) + 4 * n + (i & 3); }

struct Unit { int pm, pn; };
struct Gemm {
    const bf16_t* A; const bf16_t* Bt; int lda, ldb, K, nM, nN; int a_pn_off, b_pn_off, b_batch_off, bshift;
    __device__ __forceinline__ const char* a_ptr(const Unit& u) const { return (const char*)(A + (size_t)u.pm * BM * lda + (size_t)u.pn * a_pn_off); }
    __device__ __forceinline__ const char* b_ptr(const Unit& u) const { return (const char*)(Bt + (size_t)u.pn * b_pn_off + (size_t)(u.pm >> bshift) * b_batch_off); }
};
__device__ __forceinline__ Gemm plain_gemm(const bf16_t* A, int lda, const bf16_t* Bt, int ldb, int M, int N, int K) {
    Gemm g; g.A = A; g.Bt = Bt; g.lda = lda; g.ldb = ldb; g.K = K; g.nM = M / BM; g.nN = N / BM; g.a_pn_off = 0; g.b_pn_off = BM * ldb; g.b_batch_off = 0; g.bshift = 30; return g;
}
struct StaticOrder {
    int nM, nN, nwg, G, c;
    __device__ void init(int nM_, int nN_, int G_, int c_) { nM = nM_; nN = nN_; nwg = nM * nN; G = G_; c = c_; }
    __device__ bool next(int i, Unit& u) const {
        const long L = (long)i * G + c; if (L >= nwg) return false;
        int wgid = (int)L; { const int q = nwg / NXCD, r = nwg % NXCD, xcd = wgid % NXCD, off = wgid / NXCD; wgid = (xcd < r ? xcd * (q + 1) : r * (q + 1) + (xcd - r) * q) + off; }
        const int nig = WGM * nN, gid = wgid / nig, fm = gid * WGM, gsz = (nM - fm) < WGM ? (nM - fm) : WGM;
        u.pm = fm + ((wgid % nig) % gsz); u.pn = (wgid % nig) / gsz; return true;
    }
};
__device__ __forceinline__ unsigned cvt_pk_bf16(float lo, float hi) { unsigned r; asm volatile("v_cvt_pk_bf16_f32 %0, %1, %2" : "=v"(r) : "v"(lo), "v"(hi)); return r; }

struct EpiBf16 {
    static constexpr bool PERM = true;
    bf16_t* O; int ldc; float scale;
    __device__ __forceinline__ void operator()(const f32x4 (&acc)[2][2][4][2], const Unit& u, int wr, int wc, int fr, int fq) const {
        const int row0 = u.pm * BM + wr * 64 + fr, col0 = u.pn * BM + wc * 32 + 8 * fq;
#pragma unroll
        for (int ai = 0; ai < 2; ++ai)
#pragma unroll
            for (int m = 0; m < 4; ++m) { bf16_t* rowp = O + (size_t)(row0 + ai * HALF + m * 16) * ldc + col0;
#pragma unroll
                for (int bj = 0; bj < 2; ++bj) { const f32x4 v0 = acc[ai][bj][m][0] * scale, v1 = acc[ai][bj][m][1] * scale;
                    u32x4 w; w.x = cvt_pk_bf16(v0[0], v0[1]); w.y = cvt_pk_bf16(v0[2], v0[3]); w.z = cvt_pk_bf16(v1[0], v1[1]); w.w = cvt_pk_bf16(v1[2], v1[3]);
                    *(u32x4*)(rowp + bj * HALF) = w; } }
    }
    __device__ __forceinline__ void elem(int row, int col, float a0, float) const { O[(size_t)row * ldc + col] = (bf16_t)f2bf(a0 * scale); }
};
struct EpiSwiglu {
    static constexpr bool PERM = true;
    bf16_t* O; int ldc;
    __device__ __forceinline__ void operator()(const f32x4 (&acc)[2][2][4][2], const Unit& u, int wr, int wc, int fr, int fq) const {
        const int row0 = u.pm * BM + wr * 64 + fr, col0 = u.pn * HALF + wc * 32 + 8 * fq;
#pragma unroll
        for (int ai = 0; ai < 2; ++ai)
#pragma unroll
            for (int m = 0; m < 4; ++m) { bf16_t* rowp = O + (size_t)(row0 + ai * HALF + m * 16) * ldc + col0; float o[8];
#pragma unroll
                for (int n = 0; n < 2; ++n)
#pragma unroll
                    for (int i = 0; i < 4; ++i) { const float g = acc[ai][0][m][n][i], uu = acc[ai][1][m][n][i]; o[4 * n + i] = g * __builtin_amdgcn_rcpf(1.0f + __expf(-g)) * uu; }
                u32x4 w; w.x = cvt_pk_bf16(o[0], o[1]); w.y = cvt_pk_bf16(o[2], o[3]); w.z = cvt_pk_bf16(o[4], o[5]); w.w = cvt_pk_bf16(o[6], o[7]);
                *(u32x4*)rowp = w; }
    }
    __device__ __forceinline__ void elem(int row, int j, float g, float uu) const { O[(size_t)row * ldc + j] = (bf16_t)f2bf(g / (1.0f + __expf(-g)) * uu); }
};

struct EpiAny {
    static constexpr bool PERM = true;
    bf16_t* O; int ldc; float scale; int mode;
    __device__ __forceinline__ void operator()(const f32x4 (&acc)[2][2][4][2], const Unit& u, int wr, int wc, int fr, int fq) const {
        if (mode == 0) { EpiBf16 E{O, ldc, scale}; E(acc, u, wr, wc, fr, fq); } else { EpiSwiglu E{O, ldc}; E(acc, u, wr, wc, fr, fq); }
    }
};
template <class Epi, bool ALIGN_EPI>
__device__ __forceinline__ void gemm_phase(LAS unsigned char* lds, const Gemm g, const StaticOrder& S, const Epi& E, const int tid) {
    const int wid = __builtin_amdgcn_readfirstlane(tid >> 6), lane = tid & 63, wr = wid >> 2, wc = wid & 3, fr = lane & 15, fq = lane >> 4;
    const int K = g.K, nt = K / BK;
    unsigned voffA[2], voffB[2];
#pragma unroll
    for (int i = 0; i < 2; ++i) { int R, C; stage_rc(tid * 16 + i * 8192, R, C); const int Rb = Epi::PERM ? ((R & ~31) + perm32(R & 31)) : R;
        voffA[i] = (unsigned)(R * g.lda + C) * 2u; voffB[i] = (unsigned)(Rb * g.ldb + C) * 2u; }
    const size_t kstep = (size_t)(BK * 2);
    const size_t hstepA = (size_t)HALF * g.lda * 2, hstepB = (size_t)HALF * g.ldb * 2;
    const unsigned ldsw = (unsigned)wid * 1024u;
    const int aoff = lds_byte(wr * 64 + fr, fq * 8), boff = lds_byte(wc * 32 + fr, fq * 8);
#define PG8_SA(b, h) (((b) * 2 + (h)) * HTB)
#define PG8_SB(b, h) ((4 + (b) * 2 + (h)) * HTB)
#define PG8_STAGE(bufoff, gbase, voff) do { _Pragma("unroll") for (int _i = 0; _i < 2; ++_i) \
        __builtin_amdgcn_global_load_lds((const unsigned*)((const char*)(gbase) + (voff)[_i]), (LAS unsigned*)(lds + (bufoff) + ldsw + _i * 8192), 16, 0, 0); } while (0)
#define PG8_LDA(dst, b, h) do { _Pragma("unroll") for (int m = 0; m < 4; ++m) _Pragma("unroll") for (int k = 0; k < 2; ++k) dst[m][k] = *(const LAS bf16x8*)(lds + PG8_SA(b, h) + aoff + m * 2048 + k * 1024); } while (0)
#define PG8_LDB(dst, b, h) do { _Pragma("unroll") for (int n = 0; n < 2; ++n) _Pragma("unroll") for (int k = 0; k < 2; ++k) dst[n][k] = *(const LAS bf16x8*)(lds + PG8_SB(b, h) + boff + n * 2048 + k * 1024); } while (0)
#define PG8_MMA(ai, bj, At, Bt) do { __builtin_amdgcn_s_setprio(1); _Pragma("unroll") for (int m = 0; m < 4; ++m) _Pragma("unroll") for (int n = 0; n < 2; ++n) _Pragma("unroll") for (int k = 0; k < 2; ++k) \
        acc[ai][bj][m][n] = __builtin_amdgcn_mfma_f32_16x16x32_bf16(Bt[n][k], At[m][k], acc[ai][bj][m][n], 0, 0, 0); __builtin_amdgcn_s_setprio(0); } while (0)
#define PG8_WAIT_V(n) asm volatile("s_waitcnt vmcnt(" #n ")" ::: "memory")
#define PG8_WAIT_L(n) asm volatile("s_waitcnt lgkmcnt(" #n ")" ::: "memory")
#define PG8_BAR __builtin_amdgcn_s_barrier()
#define PG8_SCHED __builtin_amdgcn_sched_barrier(0)
    Unit cur, nxt; int ui = 0;
    if (!S.next(0, cur)) return;
    f32x4 acc[2][2][4][2];
#pragma unroll
    for (int a = 0; a < 2; ++a)
#pragma unroll
        for (int b = 0; b < 2; ++b)
#pragma unroll
            for (int m = 0; m < 4; ++m)
#pragma unroll
                for (int n = 0; n < 2; ++n) acc[a][b][m][n] = (f32x4){0.f, 0.f, 0.f, 0.f};
    bf16x8 At[4][2], B0[2][2], B1[2][2];
    const char* cA = g.a_ptr(cur); const char* cB = g.b_ptr(cur);
    PG8_STAGE(PG8_SB(0, 0), cB, voffB); PG8_STAGE(PG8_SB(0, 1), cB + hstepB, voffB); PG8_STAGE(PG8_SA(0, 0), cA, voffA); PG8_STAGE(PG8_SA(0, 1), cA + hstepA, voffA);
    if (wr == 1) PG8_BAR;
    PG8_WAIT_V(2); PG8_BAR;
    PG8_STAGE(PG8_SB(1, 0), cB + kstep, voffB); PG8_STAGE(PG8_SA(1, 0), cA + kstep, voffA); PG8_STAGE(PG8_SB(1, 1), cB + hstepB + kstep, voffB);
    PG8_WAIT_V(6); PG8_BAR;
    for (;;) {
        const bool has_next = S.next(ui + 1, nxt);
        const char* nA = has_next ? g.a_ptr(nxt) : cA; const char* nB = has_next ? g.b_ptr(nxt) : cB;
        for (int t = 0; t < nt; t += 2) {
            const bool last = (t == nt - 2);
            const char* a1 = cA + (size_t)(t + 1) * kstep;
            const char* a2 = last ? nA : cA + (size_t)(t + 2) * kstep; const char* b2 = last ? nB : cB + (size_t)(t + 2) * kstep;
            const char* a3 = a2 + kstep; const char* b3 = b2 + kstep;
            PG8_LDB(B0, 0, 0); PG8_LDB(B1, 0, 1); PG8_SCHED; PG8_LDA(At, 0, 0); PG8_STAGE(PG8_SA(1, 1), a1 + hstepA, voffA);
            PG8_WAIT_V(8); PG8_WAIT_L(0); PG8_BAR; PG8_MMA(0, 0, At, B0); PG8_MMA(0, 1, At, B1); PG8_BAR; PG8_SCHED;
            PG8_LDA(At, 0, 1); PG8_STAGE(PG8_SB(0, 0), b2, voffB); PG8_STAGE(PG8_SB(0, 1), b2 + hstepB, voffB); PG8_STAGE(PG8_SA(0, 0), a2, voffA);
            PG8_WAIT_V(8); PG8_WAIT_L(0); PG8_BAR; PG8_MMA(1, 0, At, B0); PG8_MMA(1, 1, At, B1); PG8_BAR; PG8_SCHED;
            PG8_LDB(B0, 1, 0); PG8_LDB(B1, 1, 1); PG8_SCHED; PG8_LDA(At, 1, 0); PG8_STAGE(PG8_SA(0, 1), a2 + hstepA, voffA);
            PG8_WAIT_V(8); PG8_WAIT_L(0); PG8_BAR; PG8_MMA(0, 0, At, B0); PG8_MMA(0, 1, At, B1); PG8_BAR; PG8_SCHED;
            PG8_LDA(At, 1, 1); PG8_STAGE(PG8_SB(1, 0), b3, voffB); PG8_STAGE(PG8_SB(1, 1), b3 + hstepB, voffB); PG8_STAGE(PG8_SA(1, 0), a3, voffA);
            PG8_WAIT_V(8); PG8_WAIT_L(0); PG8_BAR; PG8_MMA(1, 0, At, B0); PG8_MMA(1, 1, At, B1); PG8_BAR; PG8_SCHED;
        }
        if constexpr (ALIGN_EPI) { if (wr == 0) PG8_BAR; }
        { Unit eu = cur; asm volatile("" : "+s"(eu.pm), "+s"(eu.pn));
          E(acc, eu, wr, wc, fr, fq); }
        if (!has_next) break;
#pragma unroll
        for (int a = 0; a < 2; ++a)
#pragma unroll
            for (int b = 0; b < 2; ++b)
#pragma unroll
                for (int m = 0; m < 4; ++m)
#pragma unroll
                    for (int n = 0; n < 2; ++n) acc[a][b][m][n] = (f32x4){0.f, 0.f, 0.f, 0.f};
        cur = nxt; cA = nA; cB = nB; ++ui;
        if constexpr (ALIGN_EPI) { if (wr == 1) PG8_BAR; }
    }
    PG8_WAIT_V(0);
    if constexpr (!ALIGN_EPI) { if (wr == 0) PG8_BAR; }
    PG8_BAR;
#undef PG8_SA
#undef PG8_SB
#undef PG8_STAGE
#undef PG8_LDA
#undef PG8_LDB
#undef PG8_MMA
#undef PG8_WAIT_V
#undef PG8_WAIT_L
#undef PG8_BAR
#undef PG8_SCHED
}

template <int NPAN, class Epi>
__device__ __forceinline__ void gemm_naive(LAS unsigned char* lds8, const Gemm g, const Epi& E, int nblk, int bid, const int tid) {
    LAS float* As = (LAS float*)lds8; LAS float* Bs = As + 64 * 33;
    const int ty = tid >> 4, tx = tid & 15;
    const int ntm = g.nM * 4, ntn = (NPAN == 2) ? g.nN * 2 : g.nN * 4;
    for (int tile = bid; tile < ntm * ntn; tile += nblk) {
        const int tm = tile / ntn, tn = tile % ntn;
        Unit u; u.pm = tm >> 2; u.pn = (NPAN == 2) ? (tn >> 1) : (tn >> 2);
        const bf16_t* Ab = (const bf16_t*)g.a_ptr(u) + (size_t)(tm & 3) * 64 * g.lda;
        const bf16_t* Bb = (const bf16_t*)g.b_ptr(u) + (size_t)((NPAN == 2) ? (tn & 1) * 64 : (tn & 3) * 64) * g.ldb;
        float acc[NPAN][2][4];
#pragma unroll
        for (int p = 0; p < NPAN; ++p)
#pragma unroll
            for (int r = 0; r < 2; ++r)
#pragma unroll
                for (int i = 0; i < 4; ++i) acc[p][r][i] = 0.f;
        const int lr = tid >> 3, lk = (tid & 7) * 4;
        for (int k0 = 0; k0 < g.K; k0 += 32) {
            { const u32x2 v = *(const u32x2*)(Ab + (size_t)lr * g.lda + k0 + lk);
              As[lr * 33 + lk] = __uint_as_float(v.x << 16); As[lr * 33 + lk + 1] = __uint_as_float(v.x & 0xffff0000u); As[lr * 33 + lk + 2] = __uint_as_float(v.y << 16); As[lr * 33 + lk + 3] = __uint_as_float(v.y & 0xffff0000u); }
#pragma unroll
            for (int p = 0; p < NPAN; ++p) { const u32x2 v = *(const u32x2*)(Bb + (size_t)(lr + p * 128) * g.ldb + k0 + lk); LAS float* B_ = Bs + p * 64 * 33;
              B_[lr * 33 + lk] = __uint_as_float(v.x << 16); B_[lr * 33 + lk + 1] = __uint_as_float(v.x & 0xffff0000u); B_[lr * 33 + lk + 2] = __uint_as_float(v.y << 16); B_[lr * 33 + lk + 3] = __uint_as_float(v.y & 0xffff0000u); }
            __syncthreads();
            for (int kk = 0; kk < 32; ++kk) { const float a0 = As[ty * 33 + kk], a1 = As[(ty + 32) * 33 + kk];
#pragma unroll
                for (int p = 0; p < NPAN; ++p)
#pragma unroll
                    for (int i = 0; i < 4; ++i) { const float b = Bs[p * 64 * 33 + (tx + 16 * i) * 33 + kk]; acc[p][0][i] += a0 * b; acc[p][1][i] += a1 * b; } }
            __syncthreads();
        }
#pragma unroll
        for (int r = 0; r < 2; ++r)
#pragma unroll
            for (int i = 0; i < 4; ++i) { const int row = tm * 64 + ty + 32 * r, col = tn * 64 + tx + 16 * i;
                E.elem(row, col, acc[0][r][i], NPAN == 2 ? acc[NPAN - 1][r][i] : 0.f); }
    }
}
}

#define XB_TMO      128
#define XB_XCNT(j)  (256  + 64 * (j))
#define XB_XSUB(j)  (1280 + 64 * (j))
#define XB_XGEN(j)  (2304 + 64 * (j))
#define XB_TOP      3328
#define XB_TOPGEN   3392
#define XCD_BAR_WORDS 3456
#define XB_SPIN_CAP (1u << 18)
__device__ __forceinline__ unsigned xb_ld(unsigned* p)              { return __hip_atomic_load(p, __ATOMIC_RELAXED, __HIP_MEMORY_SCOPE_AGENT); }
__device__ __forceinline__ unsigned xb_add(unsigned* p, unsigned v) { return __hip_atomic_fetch_add(p, v, __ATOMIC_RELAXED, __HIP_MEMORY_SCOPE_AGENT); }
__device__ __forceinline__ unsigned xb_xcc_id() { return (unsigned)__builtin_amdgcn_s_getreg((3 << 11) | 20) & 0xFu; }
#define XB_SPIN(cond, bar) do { unsigned _sp = 0; while (cond) { __builtin_amdgcn_s_sleep(1); \
    if ((++_sp & 255u) == 0u) { if (xb_ld(&(bar)[XB_TMO])) break; if (_sp > XB_SPIN_CAP) { atomicAdd(&(bar)[XB_TMO], 1u); break; } } } } while (0)
struct XcdBarrier { unsigned* bar; unsigned x; volatile LAS unsigned* st; };
__device__ __forceinline__ XcdBarrier xcd_barrier_post(unsigned* bar, volatile LAS unsigned* st) {
    XcdBarrier b; b.bar = bar; b.x = xb_xcc_id(); b.st = st;
    if (threadIdx.x == 0) (void)xb_add(&bar[XB_XCNT(b.x)], 1u);
    return b;
}
__device__ __forceinline__ void xcd_barrier_complete(unsigned* bar, unsigned x, unsigned& nloc, unsigned& nx) {
    const unsigned G = gridDim.x * gridDim.y * gridDim.z;
    unsigned sum, cnt, mine, sp = 0u;
    for (;;) {
        sum = 0u; cnt = 0u; mine = 0u;
#pragma unroll
        for (unsigned j = 0; j < 16; ++j) { const unsigned c = xb_ld(&bar[XB_XCNT(j)]); sum += c; cnt += (c > 0u) ? 1u : 0u; mine = (j == x) ? c : mine; }
        if (sum == G) break;
        __builtin_amdgcn_s_sleep(1);
        if ((++sp & 255u) == 0u) { if (xb_ld(&bar[XB_TMO])) break; if (sp > XB_SPIN_CAP) { atomicAdd(&bar[XB_TMO], 1u); break; } }
    }
    nloc = mine > 0u ? mine : 1u; nx = cnt > 0u ? cnt : 1u;
}
__device__ __forceinline__ void xcd_barrier(const XcdBarrier& b) {
    asm volatile("s_waitcnt vmcnt(0)" ::: "memory");
    __syncthreads();
    if (threadIdx.x == 0) {
        unsigned* bar = b.bar;
        __builtin_amdgcn_s_waitcnt(0);
        unsigned nloc = b.st[0], nx = b.st[1];
        if (nloc == 0u) { xcd_barrier_complete(bar, b.x, nloc, nx); b.st[0] = nloc; b.st[1] = nx; }
        const unsigned old = xb_add(&bar[XB_XSUB(b.x)], 1u);
        const unsigned gen = old / nloc;
        if (old + 1u == (gen + 1u) * nloc) {
            __builtin_amdgcn_fence(__ATOMIC_RELEASE, "agent");
            asm volatile("s_waitcnt vmcnt(0)" ::: "memory");
            const unsigned og = xb_add(&bar[XB_TOP], 1u);
            const unsigned tg = og / nx;
            if (og + 1u == (tg + 1u) * nx) xb_add(&bar[XB_TOPGEN], 1u);
            else XB_SPIN(xb_ld(&bar[XB_TOPGEN]) == tg, bar);
            __builtin_amdgcn_fence(__ATOMIC_ACQUIRE, "agent");
            xb_add(&bar[XB_XGEN(b.x)], 1u);
            asm volatile("s_waitcnt vmcnt(0)" ::: "memory");
        } else {
            XB_SPIN(xb_ld(&bar[XB_XGEN(b.x)]) == gen, bar);
            __builtin_amdgcn_fence(__ATOMIC_ACQUIRE, "agent");
            asm volatile("s_waitcnt vmcnt(0)" ::: "memory");
        }
    }
    __syncthreads();
}

namespace dsa {
using bf16=__hip_bfloat16;
using bf16x8=__attribute__((ext_vector_type(8)))short;
using s16x4=__attribute__((ext_vector_type(4)))short;
using f32x16=__attribute__((ext_vector_type(16)))float;
using u32x4=__attribute__((ext_vector_type(4)))unsigned;
using u32x2=__attribute__((ext_vector_type(2)))unsigned;
constexpr int BATCH=4,NHEAD=8,SEQ=4096,D=64,QP=2560,KP=1024,OP=1024;
constexpr int NW=8,QBLK=32,QB=QBLK*NW,KVBLK=64,NQB=SEQ/QB;
__device__ __forceinline__ int crow(int r,int hi){return (r&3)+8*(r>>2)+4*hi;}
#define SBAR() __builtin_amdgcn_sched_barrier(0)
__device__ __forceinline__ void bmask(f32x16&p0,f32x16&p1,unsigned w0,unsigned w1,int hi){
  const int s0=(int)(w0>>(4*hi)), s1=(int)(w1>>(4*hi));
  #pragma unroll
  for(int r=0;r<16;++r){const unsigned pos=(r&3)+8*(r>>2);
    const unsigned m0=(unsigned)__builtin_amdgcn_sbfe(s0,pos,1u), m1=(unsigned)__builtin_amdgcn_sbfe(s1,pos,1u);
    p0[r]=__uint_as_float((__float_as_uint(p0[r])&m0)|(~m0&0xff800000u)); p1[r]=__uint_as_float((__float_as_uint(p1[r])&m1)|(~m1&0xff800000u));}
}

constexpr int NSLOT=3, SLOTB=8192;
constexpr int LDS_K=0, LDS_V=NSLOT*SLOTB, LDS_WS=2*NSLOT*SLOTB, LDS_OST=LDS_WS+NW*64*4, LDS_BYTES=LDS_OST+NW*4096;
constexpr float C2=0.125f*1.4426950408889634f;
__device__ __forceinline__ void glds16(const void*gsrc,unsigned lds_dst){unsigned keep;
  asm volatile("s_mov_b32 %0, m0\n\ts_mov_b32 m0, %2\n\ts_nop 0\n\tglobal_load_lds_dwordx4 %1, off\n\ts_mov_b32 m0, %0":"=&s"(keep):"v"(gsrc),"s"(lds_dst):"memory");}
__device__ __forceinline__ float max3f(float a,float b,float c){float r;asm("v_max3_f32 %0, %1, %2, %3":"=v"(r):"v"(a),"v"(b),"v"(c));return r;}
__device__ __forceinline__ float max2f(float a,float b){float r;asm("v_max_f32_e32 %0, %1, %2":"=v"(r):"v"(a),"v"(b));return r;}
__device__ __forceinline__ float fadd_s(float a,float b){float r;asm("v_add_f32_e32 %0, %1, %2":"=v"(r):"v"(a),"v"(b));return r;}
__device__ __forceinline__ float fsub_s(float a,float b){float r;asm("v_sub_f32_e32 %0, %1, %2":"=v"(r):"v"(a),"v"(b));return r;}
typedef float f32x2_t __attribute__((ext_vector_type(2))); typedef __bf16 bf16x2_t __attribute__((ext_vector_type(2)));
__device__ __forceinline__ unsigned cvtpk_s(float lo,float hi){f32x2_t v={lo,hi};bf16x2_t b=__builtin_convertvector(v,bf16x2_t);return __builtin_bit_cast(unsigned,b);}
#define WAIT_BAR(N) asm volatile("s_waitcnt vmcnt(" #N ") lgkmcnt(0)\n\ts_barrier":::"memory")
#define WAIT_BAR_M(N,M) asm volatile("s_waitcnt vmcnt(" #N ") lgkmcnt(0)\n\ts_barrier":"+v"(M)::"memory")

__device__ __forceinline__ void qkt(f32x16&p0,f32x16&p1,const char*Kslot,const bf16x8*qr,int r32,int hi){
  const char*kb=Kslot+hi*1024+r32*16;
  #pragma unroll
  for(int d0=0;d0<4;++d0){
    const bf16x8 b0=*reinterpret_cast<const bf16x8*>(kb+d0*2048);
    const bf16x8 b1=*reinterpret_cast<const bf16x8*>(kb+d0*2048+512);
    if(d0==0){p0=__builtin_amdgcn_mfma_f32_32x32x16_bf16(b0,qr[0],f32x16{},0,0,0);p1=__builtin_amdgcn_mfma_f32_32x32x16_bf16(b1,qr[0],f32x16{},0,0,0);}
    else{p0=__builtin_amdgcn_mfma_f32_32x32x16_bf16(b0,qr[d0],p0,0,0,0);p1=__builtin_amdgcn_mfma_f32_32x32x16_bf16(b1,qr[d0],p1,0,0,0);}}
}
typedef __attribute__((address_space(3))) const char* lds_cptr;
typedef short v4i16_t __attribute__((ext_vector_type(4)));
__device__ __forceinline__ void kload8(bf16x8*kf,lds_cptr kp){
  kf[0]=*(const __attribute__((address_space(3))) bf16x8*)(kp);      kf[1]=*(const __attribute__((address_space(3))) bf16x8*)(kp+512);
  kf[2]=*(const __attribute__((address_space(3))) bf16x8*)(kp+2048); kf[3]=*(const __attribute__((address_space(3))) bf16x8*)(kp+2560);
  kf[4]=*(const __attribute__((address_space(3))) bf16x8*)(kp+4096); kf[5]=*(const __attribute__((address_space(3))) bf16x8*)(kp+4608);
  kf[6]=*(const __attribute__((address_space(3))) bf16x8*)(kp+6144); kf[7]=*(const __attribute__((address_space(3))) bf16x8*)(kp+6656);
}
__device__ __forceinline__ void kload2(bf16x8*kf,lds_cptr kp,int j){ kf[2*j]=*(const __attribute__((address_space(3))) bf16x8*)(kp+j*2048); kf[2*j+1]=*(const __attribute__((address_space(3))) bf16x8*)(kp+j*2048+512); }
__device__ __forceinline__ s16x4 vtr(lds_cptr p){ return __builtin_bit_cast(s16x4,__builtin_amdgcn_ds_read_tr16_b64_v4i16((__attribute__((address_space(3))) v4i16_t*)p)); }
__device__ __forceinline__ float rowmax(const f32x16&p0,const f32x16&p1){
  float a=max3f(p0[0],p0[1],p1[0]),b=max3f(p0[2],p0[3],p1[1]);a=max3f(a,p1[2],p1[3]);
  #pragma unroll
  for(int r=4;r<16;r+=4){a=max3f(a,p0[r],p0[r+1]);b=max3f(b,p0[r+2],p0[r+3]);a=max3f(a,p1[r],p1[r+1]);b=max3f(b,p1[r+2],p1[r+3]);}
  const float m=max2f(a,b);
  auto rr=__builtin_amdgcn_permlane32_swap(__float_as_uint(m),__float_as_uint(m),false,false);
  return max2f(__uint_as_float(rr[0]),__uint_as_float(rr[1]));
}
__device__ __forceinline__ void pv(f32x16*o,int vb,bf16x8 pa0,bf16x8 pa1,bf16x8 pa2,bf16x8 pa3){
  #pragma unroll
  for(int d0=0;d0<2;++d0){s16x4 lo[4],hi[4];
    #pragma unroll
    for(int ks=0;ks<4;++ks){
      asm volatile("ds_read_b64_tr_b16 %0,%1 offset:%c2":"=&v"(lo[ks]):"v"(vb),"i"(d0*4096+ks*1024):"memory");
      asm volatile("ds_read_b64_tr_b16 %0,%1 offset:%c2":"=&v"(hi[ks]):"v"(vb),"i"(d0*4096+ks*1024+512):"memory");}
    asm volatile("s_waitcnt lgkmcnt(0)":::"memory");SBAR();
    #define PK(k) (bf16x8){lo[k][0],lo[k][1],lo[k][2],lo[k][3],hi[k][0],hi[k][1],hi[k][2],hi[k][3]}
    o[d0]=__builtin_amdgcn_mfma_f32_32x32x16_bf16(pa0,PK(0),o[d0],0,0,0);
    o[d0]=__builtin_amdgcn_mfma_f32_32x32x16_bf16(pa1,PK(1),o[d0],0,0,0);
    o[d0]=__builtin_amdgcn_mfma_f32_32x32x16_bf16(pa2,PK(2),o[d0],0,0,0);
    o[d0]=__builtin_amdgcn_mfma_f32_32x32x16_bf16(pa3,PK(3),o[d0],0,0,0);
    #undef PK
  }
}

#ifndef ATTN_STORE16
#define ATTN_STORE16(p,v) (*(u32x4*)(p)=(v))
#endif
template<int THRL> __device__ __forceinline__ void attn_unit(const int tid,int b,int h,int qb,const bf16*Q,const bf16*__restrict__ K,const bf16*__restrict__ V,bf16*O,const u32x2*__restrict__ MT,char*shm){
  const int lane=tid&63,r32=lane&31,hi=lane>>5; const int wid=__builtin_amdgcn_readfirstlane(tid>>6);
  const long rowbase=(long)b*SEQ; const int q0=qb*QB;
  const bf16*Qw=Q+(rowbase+q0+wid*QBLK)*QP+h*D;
  const bf16*Kh=K+rowbase*KP+h*D,*Vh=V+rowbase*KP+h*D;
  const unsigned lds0=(unsigned)(uintptr_t)shm;
  float*wsf=(float*)(shm+LDS_WS)+wid*64;
  const bf16*ksrc=Kh+(long)lane*KP+wid*8;
  const bf16*vsrc=Vh+(long)(16*(wid&3)+(lane>>2))*KP+(wid>>2)*32+(lane&3)*8;
  const unsigned kdst=lds0+LDS_K+wid*1024, vdst=lds0+LDS_V+wid*1024;
  #define DMA_K(t,slot) glds16(ksrc+(long)(t)*KVBLK*KP,(unsigned)__builtin_amdgcn_readfirstlane(kdst+(slot)))
  #define DMA_V(t,slot) glds16(vsrc+(long)(t)*KVBLK*KP,(unsigned)__builtin_amdgcn_readfirstlane(vdst+(slot)))
  const int vb0=(int)(lds0+LDS_V)+((lane>>4)&1)*32+(lane&3)*8+(4*hi+((lane&15)>>2))*64;
  const char*Kbase=shm+LDS_K; bf16x8 kf[8];
  const lds_cptr shm3=(lds_cptr)shm; const lds_cptr kp0=shm3+LDS_K+hi*1024+r32*16; const lds_cptr vp0=shm3+LDS_V+((lane>>4)&1)*32+(lane&3)*8+(4*hi+((lane&15)>>2))*64;
  const int NT=(q0+QB)/KVBLK;
  const u32x2*mq=MT+(long)b*64*SEQ+q0+wid*QBLK+r32;
  u32x2 mA=mq[0],mB=mq[SEQ]; asm volatile("s_waitcnt vmcnt(0)":"+v"(mA),"+v"(mB)::"memory");
  #define MLD(M,t) asm volatile("global_load_dwordx2 %0, %1, off":"=v"(M):"v"(mq+(long)(t)*SEQ):"memory")
  DMA_K(0,0);DMA_V(0,0);DMA_K(1,SLOTB);
  bf16x8 qr[4];
  #pragma unroll
  for(int d0=0;d0<4;++d0)qr[d0]=*reinterpret_cast<const bf16x8*>(&Qw[(long)r32*QP+d0*16+hi*8]);
  float mhat=0.f,l_reg=0.f;f32x16 o[2];o[0]=f32x16{};o[1]=f32x16{};
  const int qrel=wid*QBLK+r32;
  #define CMASK(P0,P1,M) bmask(P0,P1,M.x,M.y,hi)
  bool resc=false;
  #define START(P0,P1) do{ const float rm=rowmax(P0,P1); resc=false; \
    { const float dl=__builtin_fmaxf(rm,-64.f); mhat=fadd_s(mhat,dl); \
      _Pragma("unroll") for(int r=0;r<16;++r){P0[r]=fsub_s(P0[r],dl);P1[r]=fsub_s(P1[r],dl);} } \
    _Pragma("unroll") for(int r=0;r<16;++r)P0[r]=__builtin_amdgcn_exp2f(P0[r]); }while(0)
  #define RESC() do{ if(resc){ asm volatile("s_waitcnt lgkmcnt(0)":::"memory"); \
      _Pragma("unroll") for(int d_=0;d_<2;++d_) _Pragma("unroll") for(int r=0;r<16;++r)o[d_][r]*=wsf[crow(r,hi)]; } }while(0)
  f32x16 pA0,pA1,pB0,pB1;
  int sl_prev=0,sl_cur=0,sl_next=SLOTB;
  #define ROT() do{sl_prev=sl_cur;sl_cur=sl_next;sl_next=(sl_next==(NSLOT-1)*SLOTB)?0:sl_next+SLOTB;}while(0)
  DMA_K(2,2*SLOTB);
  WAIT_BAR(3);
  qkt(pA0,pA1,Kbase,qr,r32,hi);asm volatile("s_nop 15\n\ts_nop 7":"+v"(pA0),"+v"(pA1));CMASK(pA0,pA1,mA);
  START(pA0,pA1);
  _Pragma("unroll") for(int r=0;r<16;++r)pA1[r]=__builtin_amdgcn_exp2f(pA1[r]);
  WAIT_BAR(0);
  DMA_K(3,0);DMA_V(1,SLOTB);
  ROT();
  kload8(kf,kp0+sl_cur);
  WAIT_BAR(2);
  s16x4 vl0,vh0,vl1,vh1,vl2,vh2; u32x4 pw0,pw1,pw2,pw3;
  #define PKW(P,B) cvtpk_s(P[B],P[B+1])
  #define PAF(k) __builtin_bit_cast(bf16x8,pw##k)
  #define VFRB(b) (bf16x8){vl##b[0],vl##b[1],vl##b[2],vl##b[3],vh##b[0],vh##b[1],vh##b[2],vh##b[3]}
  #define PIN(x) asm volatile("":"+v"(x))
  #define MX3(a,b,c) __builtin_fmaxf(__builtin_fmaxf((a),(b)),(c))
  #define GAPA(MF,A0,A1,A2,A3,W0,W1,PW) do{ MF; sacc+=A0; sacc+=A1; sacc+=A2; sacc+=A3; PIN(sacc); W0; W1; PIN(PW); SBAR(); }while(0)
  #define EX(v) __builtin_amdgcn_exp2f(v)
  #define GAPB(MF,X,B) do{ MF; X[B]=EX(X[B]); X[B+1]=EX(X[B+1]); X[B+2]=EX(X[B+2]); X[B+3]=EX(X[B+3]); PIN(X); SBAR(); }while(0)
  #define VRDB(b,i) do{ vl##b=vtr(vp_+(((i)>>2)*4096+((i)&3)*1024)); vh##b=vtr(vp_+(((i)>>2)*4096+((i)&3)*1024+512)); SBAR(); }while(0)
  #define KRD(G,j) do{ if(G){ kload2(kf,kp0+sl_next,j); SBAR(); } }while(0)
  #define STEP(C0,C1,P0,P1,t,GK,GV,GL,MC,MN) do{ SBAR(); if(GV){MLD(MN,(t)+1);} SBAR(); \
    const lds_cptr vp_=vp0+sl_prev; \
    float sacc=(P0[0]+P0[1]); \
    GAPA(C0=__builtin_amdgcn_mfma_f32_32x32x16_bf16(kf[0],qr[0],f32x16{},0,0,0), P0[2],P0[3],P0[4],P0[5],     pw0[0]=PKW(P0,0), pw0[1]=PKW(P0,2), pw0); \
    GAPA(C1=__builtin_amdgcn_mfma_f32_32x32x16_bf16(kf[1],qr[0],f32x16{},0,0,0), P0[6],P0[7],P0[8],P0[9],     pw0[2]=PKW(P0,4), pw0[3]=PKW(P0,6), pw0); \
    GAPA(C0=__builtin_amdgcn_mfma_f32_32x32x16_bf16(kf[2],qr[1],C0,0,0,0),   P0[10],P0[11],P0[12],P0[13], pw1[0]=PKW(P0,8), pw1[1]=PKW(P0,10), pw1); \
    GAPA(C1=__builtin_amdgcn_mfma_f32_32x32x16_bf16(kf[3],qr[1],C1,0,0,0),   P0[14],P0[15],P1[0],P1[1],   pw1[2]=PKW(P0,12),pw1[3]=PKW(P0,14), pw1); \
    KRD(GL,0); \
    GAPA(C0=__builtin_amdgcn_mfma_f32_32x32x16_bf16(kf[4],qr[2],C0,0,0,0),   P1[2],P1[3],P1[4],P1[5],     pw2[0]=PKW(P1,0), pw2[1]=PKW(P1,2), pw2); \
    GAPA(C1=__builtin_amdgcn_mfma_f32_32x32x16_bf16(kf[5],qr[2],C1,0,0,0),   P1[6],P1[7],P1[8],P1[9],     pw2[2]=PKW(P1,4), pw2[3]=PKW(P1,6), pw2); \
    KRD(GL,1); \
    GAPA(C0=__builtin_amdgcn_mfma_f32_32x32x16_bf16(kf[6],qr[3],C0,0,0,0),   P1[10],P1[11],P1[12],P1[13], pw3[0]=PKW(P1,8), pw3[1]=PKW(P1,10), pw3); \
    GAPA(C1=__builtin_amdgcn_mfma_f32_32x32x16_bf16(kf[7],qr[3],C1,0,0,0),   P1[14],P1[15],0.f,0.f,       pw3[2]=PKW(P1,12),pw3[3]=PKW(P1,14), pw3); \
    KRD(GL,2); KRD(GL,3); \
    l_reg+=sacc; \
    if(GK){DMA_K((t)+3,sl_cur);} if(GV){DMA_V((t)+1,sl_next);} \
    VRDB(0,0); VRDB(1,4); \
    CMASK(C0,C1,MC); \
    { float a=MX3(C0[0],C0[1],C1[0]),b=MX3(C0[2],C0[3],C1[1]); a=MX3(a,C1[2],C1[3]); \
      _Pragma("unroll") for(int r=4;r<16;r+=4){a=MX3(a,C0[r],C0[r+1]);b=MX3(b,C0[r+2],C0[r+3]);a=MX3(a,C1[r],C1[r+1]);b=MX3(b,C1[r+2],C1[r+3]);} \
      float rm=__builtin_fmaxf(a,b); { auto rr=__builtin_amdgcn_permlane32_swap(__float_as_uint(rm),__float_as_uint(rm),false,false); rm=__builtin_fmaxf(__uint_as_float(rr[0]),__uint_as_float(rr[1])); } \
      rm-=mhat; resc=false;     \
      if(__builtin_expect(__any(rm>(float)THRL),0)){ const float dl=__builtin_fmaxf(rm,0.f); mhat+=dl; \
        const float f=__builtin_amdgcn_exp2f(-dl); l_reg*=f; if(hi==0)wsf[r32]=f; resc=true; } \
      _Pragma("unroll") for(int r=0;r<16;++r){C0[r]-=mhat;C1[r]-=mhat;} } \
    SBAR(); \
    VRDB(2,1); GAPB(o[0]=__builtin_amdgcn_mfma_f32_32x32x16_bf16(PAF(0),VFRB(0),o[0],0,0,0), C0,0); \
    VRDB(0,5); GAPB(o[1]=__builtin_amdgcn_mfma_f32_32x32x16_bf16(PAF(0),VFRB(1),o[1],0,0,0), C0,4); \
    VRDB(1,2); GAPB(o[0]=__builtin_amdgcn_mfma_f32_32x32x16_bf16(PAF(1),VFRB(2),o[0],0,0,0), C0,8); \
    VRDB(2,6); GAPB(o[1]=__builtin_amdgcn_mfma_f32_32x32x16_bf16(PAF(1),VFRB(0),o[1],0,0,0), C0,12); \
    VRDB(0,3); GAPB(o[0]=__builtin_amdgcn_mfma_f32_32x32x16_bf16(PAF(2),VFRB(1),o[0],0,0,0), C1,0); \
    VRDB(1,7); GAPB(o[1]=__builtin_amdgcn_mfma_f32_32x32x16_bf16(PAF(2),VFRB(2),o[1],0,0,0), C1,4); \
    GAPB(o[0]=__builtin_amdgcn_mfma_f32_32x32x16_bf16(PAF(3),VFRB(0),o[0],0,0,0), C1,8); \
    GAPB(o[1]=__builtin_amdgcn_mfma_f32_32x32x16_bf16(PAF(3),VFRB(1),o[1],0,0,0), C1,12); \
    }while(0)
  int t=1;
  for(;t+5<NT;t+=2){
    STEP(pB0,pB1,pA0,pA1,t,true,true,true,mB,mA);     WAIT_BAR_M(2,mA); RESC(); ROT();
    STEP(pA0,pA1,pB0,pB1,t+1,true,true,true,mA,mB);   WAIT_BAR_M(2,mB); RESC(); ROT();
  }
  #define ENDW(tt,M) do{ if((tt)+3<NT){WAIT_BAR_M(2,M);} else if((tt)+2<NT){WAIT_BAR_M(1,M);} else {WAIT_BAR_M(0,M);} }while(0)
  for(;t+1<NT;t+=2){
    STEP(pB0,pB1,pA0,pA1,t,(t+3<NT),(t+1<NT),(t+1<NT),mB,mA);       ENDW(t,mA);   RESC(); ROT();
    STEP(pA0,pA1,pB0,pB1,t+1,(t+4<NT),(t+2<NT),(t+2<NT),mA,mB);     ENDW(t+1,mB); RESC(); ROT();
  }
  STEP(pB0,pB1,pA0,pA1,NT-1,false,false,false,mB,mA); RESC();
  { float sacc=pB0[0]+pB0[1]; _Pragma("unroll") for(int r=2;r<16;++r)sacc+=pB0[r]; _Pragma("unroll") for(int r=0;r<16;++r)sacc+=pB1[r]; l_reg+=sacc;
    pw0=(u32x4){PKW(pB0,0),PKW(pB0,2),PKW(pB0,4),PKW(pB0,6)};pw1=(u32x4){PKW(pB0,8),PKW(pB0,10),PKW(pB0,12),PKW(pB0,14)};pw2=(u32x4){PKW(pB1,0),PKW(pB1,2),PKW(pB1,4),PKW(pB1,6)};pw3=(u32x4){PKW(pB1,8),PKW(pB1,10),PKW(pB1,12),PKW(pB1,14)};
    SBAR(); pv(o,vb0+sl_cur,PAF(0),PAF(1),PAF(2),PAF(3)); }
  #undef PKW
  #undef PAF
  #undef VFRB
  #undef PIN
  #undef MX3
  #undef GAPA
  #undef GAPB
  #undef EX
  #undef VRDB
  #undef KRD
  #undef STEP
  #undef ENDW
  {auto rr=__builtin_amdgcn_permlane32_swap(__float_as_uint(l_reg),__float_as_uint(l_reg),false,false);l_reg=__uint_as_float(rr[0])+__uint_as_float(rr[1]);}
  if(hi==0)wsf[32+r32]=l_reg;asm volatile("s_waitcnt lgkmcnt(0)":::"memory");
  float rli[16];
  #pragma unroll
  for(int r=0;r<16;++r)rli[r]=__builtin_amdgcn_rcpf(wsf[32+crow(r,hi)]);
  bf16*Ow=O+(rowbase+q0+wid*QBLK)*OP+h*D;
  { bf16*stg=(bf16*)(shm+LDS_OST)+wid*2048;
    #pragma unroll
    for(int r=0;r<16;++r){const int orow=crow(r,hi);
      #pragma unroll
      for(int d0=0;d0<2;++d0)stg[orow*64+d0*32+r32]=__float2bfloat16(o[d0][r]*rli[r]);}
    asm volatile("s_waitcnt lgkmcnt(0)":::"memory");
    #pragma unroll
    for(int i=0;i<4;++i){const int row=i*8+(lane>>3),ch=lane&7; const u32x4 v=*(const u32x4*)(stg+row*64+ch*8); ATTN_STORE16(Ow+(long)row*OP+ch*8,v);} }
  asm volatile("s_waitcnt lgkmcnt(0)\n\ts_barrier":::"memory");
  #undef DMA_K
  #undef DMA_V
  #undef CMASK
  #undef MLD
  #undef START
  #undef RESC
  #undef ROT
}
constexpr int ATTN_LDS_BYTES=LDS_BYTES;
template<int THRL=8> __device__ __forceinline__ void attn_phase(const int tid,int grid,int block,const bf16*Q,const bf16*K,const bf16*V,bf16*O,const u32x2*MT,char*lds){
  for(int i=0;;++i){ const int u=i*grid+block; if(u>=BATCH*NHEAD*NQB)break; int bh,qb;
    if(grid==256){ const int vcu=(block%8)*(grid/8)+block/8, s=vcu&7; bh=vcu>>3; qb=i?15-s:s; } else { bh=u/NQB; qb=NQB-1-(u%NQB); }
    bh=__builtin_amdgcn_readfirstlane(bh); qb=__builtin_amdgcn_readfirstlane(qb);
    attn_unit<THRL>(tid,bh/NHEAD,bh%NHEAD,qb,Q,K,V,O,MT,lds); }
}
#undef SBAR
#undef WAIT_BAR
#undef WAIT_BAR_M
}
constexpr int NWAVES = 8, NTHREADS = 512;
constexpr int RING_BYTES = 131072, HIST_OFF = RING_BYTES, DESC_OFF = RING_BYTES + 8704, MISC_OFF = DESC_OFF + 6144, LDS_BYTES = 147456;
constexpr int DESC_WORDS = 32;
struct Args { const float* in[25]; float* out; unsigned char* ws; int ph_lo, ph_hi; };
struct Ctx {
    LAS unsigned char* lds; char* ldsg; int tid, lane, wave, nblk, bid;
    float* out; unsigned char* ws; const __attribute__((address_space(4))) void* kp;
};
#define inp(i) (((const float* const __attribute__((address_space(4)))*)F.kp)[i])
enum { I_X = 0, I_MEM, I_NORMS, I_WGU, I_WDN, I_XQ, I_XKV, I_XO, I_EIN, I_EKVN, I_EUK, I_EUV, I_ECW, I_ECB, I_ERA, I_EBRA, I_ERI, I_EBRI, I_ELAM, I_EOUT, I_OIN, I_OG2, I_OBG, I_OHN, I_OOUT };
enum { N_FFN1_PRE = 0, N_FFN1_POST, N_MIX_PRE, N_MIX_POST, N_XA_PRE, N_XA_POST, N_MEM_NORM, N_FFN2_PRE, N_FFN2_POST };

struct TJob { const float* W; int K, Nsrc; bf16_t* WT; int c0, nc, r0, mode; float scale; };
__device__ __forceinline__ void transpose_item(const TJob& J, int item, LAS float* scr, int lane) {
    const int nblk = (J.nc + 31) / 32, kb = item / nblk, nb = item % nblk, k0 = 64 * kb, n0 = 32 * nb;
    const int cl = n0 + (lane & 31); const bool okc = cl < J.nc;
#pragma unroll 8
    for (int i = 0; i < 32; ++i) { const int kk = 2 * i + (lane >> 5); scr[kk * 33 + (lane & 31)] = okc ? J.W[(size_t)(k0 + kk) * J.Nsrc + J.c0 + cl] * J.scale : 0.f; }
    asm volatile("s_waitcnt lgkmcnt(0)" ::: "memory");
    const int c = lane & 7;
#pragma unroll
    for (int j = 0; j < 4; ++j) { const int n = (lane >> 3) + 8 * j; const LAS float* s = scr + (8 * c) * 33 + n;
        u32x4 o; o.x = pk2(s[0 * 33], s[1 * 33]); o.y = pk2(s[2 * 33], s[3 * 33]); o.z = pk2(s[4 * 33], s[5 * 33]); o.w = pk2(s[6 * 33], s[7 * 33]);
        const int cc = n0 + n;
        if (cc < J.nc) { int row; if (J.mode == 0) row = J.r0 + cc; else { const int cg = J.c0 + cc, bj = cg / FF, jj = cg % FF; row = 256 * (jj / 128) + 128 * bj + (jj % 128); }
            *(u32x4*)(J.WT + (size_t)row * J.K + k0 + 8 * c) = o; } }
    asm volatile("s_waitcnt lgkmcnt(0)" ::: "memory");
}
constexpr int NJOBS = 4 + 4 + 6 + 7 + 2 + 1 + 5 + 1;
__device__ __forceinline__ TJob get_job(const Ctx& F, int j) {
    TJob J; J.mode = 0; J.scale = 1.f; J.c0 = 0; J.r0 = 0;
    bf16_t* Wb = (bf16_t*)(F.ws + WS_W);
    if (j < 4) { J.W = inp(I_WGU) + (size_t)j * D * 2 * FF; J.K = D; J.Nsrc = 2 * FF; J.nc = 2 * FF; J.WT = (bf16_t*)((unsigned char*)Wb + W_GU) + (size_t)j * 2 * FF * D; J.mode = 1; return J; }
    j -= 4;
    if (j < 4) { J.W = inp(I_WDN) + (size_t)j * FF * D; J.K = FF; J.Nsrc = D; J.nc = D; J.WT = (bf16_t*)((unsigned char*)Wb + W_DN) + (size_t)j * D * FF; return J; }
    j -= 4;
    if (j < 6) { const int l = j & 1, w = j >> 1;
        if (w == 0) { J.W = inp(I_XQ) + (size_t)l * D * D; J.K = D; J.Nsrc = D; J.nc = D; J.WT = (bf16_t*)((unsigned char*)Wb + W_Q) + (size_t)l * D * D; }
        else if (w == 1) { J.W = inp(I_XKV) + (size_t)l * D * 2 * D; J.K = D; J.Nsrc = 2 * D; J.nc = 2 * D; J.WT = (bf16_t*)((unsigned char*)Wb + W_KV) + (size_t)l * 2 * D * D; }
        else { J.W = inp(I_XO) + (size_t)l * D * D; J.K = D; J.Nsrc = D; J.nc = D; J.WT = (bf16_t*)((unsigned char*)Wb + W_O) + (size_t)l * D * D; }
        return J; }
    j -= 6;
    if (j < 7) { J.W = inp(I_EIN); J.K = D; J.Nsrc = 2376; J.WT = (bf16_t*)((unsigned char*)Wb + W_EIN);
        switch (j) { case 0: J.c0 = 0; J.nc = 512; J.r0 = YQ; J.scale = C2; break; case 1: J.c0 = 512; J.nc = 256; J.r0 = YCKV; break; case 2: J.c0 = 768; J.nc = 512; J.r0 = YQI; break;
                     case 3: J.c0 = 1280; J.nc = 64; J.r0 = YKI; break; case 4: J.c0 = 1344; J.nc = 8; J.r0 = YWI; break; case 5: J.c0 = 1352; J.nc = 512; J.r0 = YGATE; break; default: J.c0 = 1864; J.nc = 512; J.r0 = YXB; break; }
        return J; }
    j -= 7;
    if (j < 2) { J.W = (j == 0) ? inp(I_EUK) : inp(I_EUV); J.K = 256; J.Nsrc = 512; J.nc = 512; J.WT = (bf16_t*)((unsigned char*)Wb + W_UKV); J.r0 = 512 * j; return J; }
    j -= 2;
    if (j < 1) { J.W = inp(I_EOUT); J.K = D; J.Nsrc = D; J.nc = D; J.WT = (bf16_t*)((unsigned char*)Wb + W_EOUT); return J; }
    j -= 1;
    if (j < 5) { J.W = inp(I_OIN); J.K = D; J.Nsrc = 3088; J.WT = (bf16_t*)((unsigned char*)Wb + W_OIN);
        switch (j) { case 0: J.c0 = 0; J.nc = 512; J.r0 = ZQ; break; case 1: J.c0 = 512; J.nc = 512; J.r0 = ZK; break; case 2: J.c0 = 1024; J.nc = 1024; J.r0 = ZV; break;
                     case 3: J.c0 = 2048; J.nc = 16; J.r0 = ZG; break; default: J.c0 = 2064; J.nc = 1024; J.r0 = ZR; break; }
        return J; }
    J.W = inp(I_OOUT); J.K = D; J.Nsrc = D; J.nc = D; J.WT = (bf16_t*)((unsigned char*)Wb + W_OOUT); return J;
}
__device__ __forceinline__ void rms_row_to_bf16(const float* xrow, const float* gain, bf16_t* orow, int lane) {
    const f32x4* xr = (const f32x4*)xrow + lane; f32x4 v[4]; float s = 0.f;
#pragma unroll
    for (int j = 0; j < 4; ++j) { v[j] = xr[64 * j]; s += (v[j].x * v[j].x + v[j].y * v[j].y) + (v[j].z * v[j].z + v[j].w * v[j].w); }
    const float rstd = 1.0f / sqrtf(wave_sum(s) * (1.f / D) + EPS);
    u32x2* o8 = (u32x2*)orow + lane;
#pragma unroll
    for (int j = 0; j < 4; ++j) { const f32x4 gg = ((const f32x4*)gain)[lane + 64 * j]; u32x2 w; w.x = pk2(v[j].x * rstd * gg.x, v[j].y * rstd * gg.y); w.y = pk2(v[j].z * rstd * gg.z, v[j].w * rstd * gg.w); o8[64 * j] = w; }
}
__device__ __forceinline__ void phase_prep(const Ctx& F) {
    LAS float* scr = (LAS float*)(F.lds + F.wave * 16384);
    const int gw = F.bid * NWAVES + F.wave, NGW = F.nblk * NWAVES;
    int total = 0;
    for (int j = 0; j < NJOBS; ++j) { const TJob J = get_job(F, j); total += (J.K / 64) * ((J.nc + 31) / 32); }
    for (int it = gw; it < total; it += NGW) {
        int r = it, j = 0; TJob J = get_job(F, 0);
        for (;;) { const int n = (J.K / 64) * ((J.nc + 31) / 32); if (r < n) break; r -= n; ++j; J = get_job(F, j); }
        transpose_item(J, r, scr, F.lane);
    }
    { bf16_t* We = (bf16_t*)(F.ws + WS_W + W_EIN) + (size_t)1352 * D; bf16_t* Wo = (bf16_t*)(F.ws + WS_W + W_OIN) + (size_t)2064 * D;
      const int ne = 184 * D / 8, no = 240 * D / 8; const int gt = F.bid * NTHREADS + F.tid, NGT = F.nblk * NTHREADS;
      for (int i = gt; i < ne + no; i += NGT) { unsigned zz = 0u; asm volatile("" : "+v"(zz)); u32x4 z = {zz, zz, zz, zz}; if (i < ne) ((u32x4*)We)[i] = z; else ((u32x4*)Wo)[i - ne] = z; } }
    for (int m = gw; m < 2 * 1024 + T; m += NGW) {
        if (m < 2048) { const int l = m >> 10, r = m & 1023; rms_row_to_bf16(inp(I_MEM) + (size_t)r * D, inp(I_NORMS) + (size_t)(l * 9 + N_MEM_NORM) * D, (bf16_t*)(F.ws + (l ? WS_MEMN1 : WS_MEMN0)) + (size_t)r * D, F.lane); }
        else { const int r = m - 2048; rms_row_to_bf16(inp(I_X) + (size_t)r * D, inp(I_NORMS) + (size_t)N_FFN1_PRE * D, (bf16_t*)(F.ws + WS_A) + (size_t)r * D, F.lane); }
    }
}

__device__ __forceinline__ void phase_norm(const Ctx& F, const bf16_t* Fb, const float* hin, float* hout, float coef, const float* gpost, const float* gpre, bf16_t* Aout) {
    const int gw = F.bid * NWAVES + F.wave, NGW = F.nblk * NWAVES, lane = F.lane;
    for (int m = gw; m < T; m += NGW) {
        const u32x2* fr = (const u32x2*)(Fb + (size_t)m * D) + lane; f32x4 f[4]; float s = 0.f;
#pragma unroll
        for (int j = 0; j < 4; ++j) { const u32x2 w = fr[64 * j]; f[j].x = __uint_as_float(w.x << 16); f[j].y = __uint_as_float(w.x & 0xffff0000u); f[j].z = __uint_as_float(w.y << 16); f[j].w = __uint_as_float(w.y & 0xffff0000u);
            s += (f[j].x * f[j].x + f[j].y * f[j].y) + (f[j].z * f[j].z + f[j].w * f[j].w); }
        const float rstd = coef / sqrtf(wave_sum(s) * (1.f / D) + EPS);
        f32x4 h[4]; float s2 = 0.f;
#pragma unroll
        for (int j = 0; j < 4; ++j) { const f32x4 hv = ((const f32x4*)(hin + (size_t)m * D))[lane + 64 * j]; const f32x4 gg = ((const f32x4*)gpost)[lane + 64 * j];
            h[j] = hv + f[j] * rstd * gg; ((f32x4*)(hout + (size_t)m * D))[lane + 64 * j] = h[j];
            s2 += (h[j].x * h[j].x + h[j].y * h[j].y) + (h[j].z * h[j].z + h[j].w * h[j].w); }
        if (gpre) { const float r2 = 1.0f / sqrtf(wave_sum(s2) * (1.f / D) + EPS); u32x2* o8 = (u32x2*)(Aout + (size_t)m * D) + lane;
#pragma unroll
            for (int j = 0; j < 4; ++j) { const f32x4 gg = ((const f32x4*)gpre)[lane + 64 * j]; u32x2 w; w.x = pk2(h[j].x * r2 * gg.x, h[j].y * r2 * gg.y); w.y = pk2(h[j].z * r2 * gg.z, h[j].w * r2 * gg.w); o8[64 * j] = w; } }
    }
}

__device__ __forceinline__ void phase_ckvn(const Ctx& F) {
    const bf16_t* Y = (const bf16_t*)(F.ws + WS_BIG + BG_Y); bf16_t* O = (bf16_t*)(F.ws + WS_BIG + BG_CKVN); const float* gn = inp(I_EKVN);
    const int gw = F.bid * NWAVES + F.wave, NGW = F.nblk * NWAVES, lane = F.lane;
    for (int m = gw; m < T; m += NGW) {
        const u32x2 w = ((const u32x2*)(Y + (size_t)m * NE + YCKV))[lane];
        const float a = __uint_as_float(w.x << 16), b = __uint_as_float(w.x & 0xffff0000u), c = __uint_as_float(w.y << 16), d = __uint_as_float(w.y & 0xffff0000u);
        const float rstd = 1.0f / sqrtf(wave_sum(a * a + b * b + c * c + d * d) * (1.f / 256.f) + EPS);
        const f32x4 gg = ((const f32x4*)gn)[lane]; u32x2 o; o.x = pk2(a * rstd * gg.x, b * rstd * gg.y); o.y = pk2(c * rstd * gg.z, d * rstd * gg.w);
        ((u32x2*)(O + (size_t)m * 256))[lane] = o;
    }
}

__device__ __forceinline__ unsigned f2ord(float f) { const unsigned u = __float_as_uint(f + 0.0f); return (u & 0x80000000u) ? ~u : (u | 0x80000000u); }
typedef float f32x16 __attribute__((ext_vector_type(16)));
__device__ __forceinline__ void phase_idx(const Ctx& F) {
    const bf16_t* Y = (const bf16_t*)(F.ws + WS_BIG + BG_Y);
    u32x2* MT = (u32x2*)(F.ws + WS_BIG + BG_MASK);
    LAS float* sc = (LAS float*)F.lds;
    LAS unsigned* hist = (LAS unsigned*)(F.lds + HIST_OFF) + F.wave * 264;
    const int lane = F.lane, wave = F.wave, c = lane & 31, h2 = lane >> 5;
    for (int unit = F.bid; unit < T / 8; unit += F.nblk) {
        const int b = unit / 512, qg = 511 - (unit % 512); const int t0 = qg * 8, nkeys = t0 + 8;
        const size_t rowb = (size_t)b * SEQ;
        const int t = t0 + wave, n = t + 1;
        u32x2* mrow = MT + (size_t)b * 64 * SEQ + t;
        if (nkeys <= 256) {
            const int lo = lane * 64; unsigned long long bits = 0ull; if (lo + 63 <= t) bits = ~0ull; else if (lo <= t) bits = (2ull << (t - lo)) - 1ull;
            u32x2 w; w.x = (unsigned)bits; w.y = (unsigned)(bits >> 32); mrow[(size_t)lane * SEQ] = w;
            continue;
        }
        {
            bf16x8 afr[2][4]; float wq[2][16];
            const int head = (c & 3) + 4 * ((c >> 3) & 1), ql = ((c >> 2) & 1) + 2 * (c >> 4);
#pragma unroll
            for (int rt = 0; rt < 2; ++rt) { const bf16_t* qrow = Y + (rowb + t0 + rt * 4 + ql) * NE + YQI + head * 64 + 8 * h2;
#pragma unroll
                for (int ks = 0; ks < 4; ++ks) afr[rt][ks] = *(const bf16x8*)(qrow + 16 * ks);
#pragma unroll
                for (int r = 0; r < 16; ++r) wq[rt][r] = bf2f(Y[(rowb + t0 + rt * 4 + h2 + 2 * (r >> 3)) * NE + YWI + (r & 7)]); }
            const int nkt = (nkeys + 31) >> 5;
            for (int kt = wave; kt < nkt; kt += 8) {
                const bf16_t* krow = Y + (rowb + kt * 32 + c) * NE + YKI + 8 * h2;
                bf16x8 bfr[4];
#pragma unroll
                for (int ks = 0; ks < 4; ++ks) bfr[ks] = *(const bf16x8*)(krow + 16 * ks);
#pragma unroll
                for (int rt = 0; rt < 2; ++rt) { f32x16 acc = {};
#pragma unroll
                    for (int ks = 0; ks < 4; ++ks) acc = __builtin_amdgcn_mfma_f32_32x32x16_bf16(afr[rt][ks], bfr[ks], acc, 0, 0, 0);
                    float s0 = 0.f, s1 = 0.f;
#pragma unroll
                    for (int r = 0; r < 8; ++r) { s0 += fmaxf(acc[r], 0.f) * wq[rt][r]; s1 += fmaxf(acc[8 + r], 0.f) * wq[rt][8 + r]; }
                    sc[(rt * 4 + h2) * 4096 + kt * 32 + c] = s0; sc[(rt * 4 + h2 + 2) * 4096 + kt * 32 + c] = s1; }
            }
        }
        __syncthreads();
        {
            LAS float* row = sc + wave * 4096;
            unsigned u[64]; int nv = n - lane; asm volatile("" : "+v"(nv));
#pragma unroll
            for (int j = 0; j < 64; ++j) { u[j] = (64 * j < nv) ? f2ord(row[lane + 64 * j]) : 0u; }
            unsigned prefix = 0u; int kk = 256;
#pragma unroll
            for (int pass = 0; pass < 4; ++pass) {
                const int shift = 24 - 8 * pass;
                for (int i = lane; i < 264; i += 64) hist[i] = 0u;
                asm volatile("s_waitcnt lgkmcnt(0)" ::: "memory");
#pragma unroll
                for (int j = 0; j < 64; ++j) { const bool match = (pass == 0) ? (u[j] != 0u) : ((u[j] >> (shift + 8)) == (prefix >> (shift + 8)) && u[j] != 0u);
                    if (match) atomicAdd((unsigned*)&hist[(u[j] >> shift) & 255u], 1u); }
                asm volatile("s_waitcnt lgkmcnt(0)" ::: "memory");
                const unsigned c0 = hist[4 * lane], c1 = hist[4 * lane + 1], c2 = hist[4 * lane + 2], c3 = hist[4 * lane + 3];
                const unsigned tot = c0 + c1 + c2 + c3; unsigned suf = tot;
#pragma unroll
                for (int o = 1; o < 64; o <<= 1) { const unsigned v = __shfl_down(suf, o); if (lane + o < 64) suf += v; }
                unsigned above = suf - tot;
                const unsigned cs[4] = {c0, c1, c2, c3};
#pragma unroll
                for (int bb = 3; bb >= 0; --bb) { if ((int)above < kk && (int)(above + cs[bb]) >= kk) { hist[256] = (unsigned)(4 * lane + bb); hist[257] = (unsigned)(kk - (int)above); } above += cs[bb]; }
                asm volatile("s_waitcnt lgkmcnt(0)" ::: "memory");
                const unsigned dsel = hist[256]; kk = (int)hist[257];
                prefix |= dsel << shift;
                asm volatile("s_waitcnt lgkmcnt(0)" ::: "memory");
            }
            int eqseen = 0; u32x2 myw = {0u, 0u}; const unsigned long long lt = (1ull << lane) - 1ull;
#pragma unroll
            for (int j = 0; j < 64; ++j) {
                const bool gt = u[j] > prefix, eq = (u[j] == prefix);
                const unsigned long long beq = __ballot(eq);
                const int rk = eqseen + __popcll(beq & lt);
                const unsigned long long bs = __ballot(gt || (eq && rk < kk));
                if (lane == j) { myw.x = (unsigned)bs; myw.y = (unsigned)(bs >> 32); }
                eqseen += __popcll(beq);
                if ((j & 3) == 3) __builtin_amdgcn_sched_barrier(0);
            }
            mrow[(size_t)lane * SEQ] = myw;
        }
        __syncthreads();
    }
}

__device__ __forceinline__ void phase_att_naive(const Ctx& F) {
    const bf16_t* Y = (const bf16_t*)(F.ws + WS_BIG + BG_Y); const bf16_t* KV = (const bf16_t*)(F.ws + WS_MIX);
    const unsigned short* LIST = (const unsigned short*)(F.ws + WS_A + AF_LIST); const int* CNT = (const int*)(F.ws + WS_A + AF_CNT);
    bf16_t* C = (bf16_t*)(F.ws + WS_MIX + 32 * MiB);
    LAS float* wq = (LAS float*)F.lds + F.wave * 1024;
    LAS float* wp = wq + 64; LAS int* wi = (LAS int*)(wq + 64 + 256);
    const int gw = F.bid * NWAVES + F.wave, NGW = F.nblk * NWAVES, lane = F.lane;
    for (int unit = gw; unit < T * 8; unit += NGW) {
        const int m = unit >> 3, h = unit & 7, b = m / SEQ; const size_t rowb = (size_t)b * SEQ;
        wq[lane] = bf2f(Y[(size_t)m * NE + YQ + h * 64 + lane]);
        const int cnt = CNT[m];
        asm volatile("s_waitcnt lgkmcnt(0)" ::: "memory");
        float s[4]; int id[4]; float mx = -INFINITY;
#pragma unroll
        for (int j = 0; j < 4; ++j) { const int jj = lane + 64 * j; id[j] = LIST[(size_t)m * 256 + jj]; s[j] = -INFINITY;
            if (jj < cnt) { const u32x4* kp = (const u32x4*)(KV + (rowb + id[j]) * 1024 + h * 64); float dot = 0.f;
#pragma unroll
                for (int c = 0; c < 8; ++c) { const u32x4 w = kp[c]; const f32x4 q0 = *(const LAS f32x4*)(wq + 8 * c), q1 = *(const LAS f32x4*)(wq + 8 * c + 4);
                    dot += q0.x * __uint_as_float(w.x << 16) + q0.y * __uint_as_float(w.x & 0xffff0000u) + q0.z * __uint_as_float(w.y << 16) + q0.w * __uint_as_float(w.y & 0xffff0000u)
                         + q1.x * __uint_as_float(w.z << 16) + q1.y * __uint_as_float(w.z & 0xffff0000u) + q1.z * __uint_as_float(w.w << 16) + q1.w * __uint_as_float(w.w & 0xffff0000u); }
                s[j] = dot; }
            mx = fmaxf(mx, s[j]); }
        mx = wave_max(mx); float l = 0.f;
#pragma unroll
        for (int j = 0; j < 4; ++j) { const float p = (lane + 64 * j < cnt) ? exp2f(s[j] - mx) : 0.f; l += p; wp[lane + 64 * j] = p; wi[lane + 64 * j] = id[j]; }
        l = wave_sum(l);
        asm volatile("s_waitcnt lgkmcnt(0)" ::: "memory");
        float o = 0.f;
        for (int j = 0; j < cnt; ++j) o += wp[j] * bf2f(KV[(rowb + wi[j]) * 1024 + 512 + h * 64 + lane]);
        C[(size_t)m * 1024 + h * 64 + lane] = (bf16_t)f2bf(o / l);
        asm volatile("s_waitcnt lgkmcnt(0)" ::: "memory");
    }
}

template <int MODE> __device__ __forceinline__ void phase_lru(const Ctx& F) {
    const bf16_t* Y = (const bf16_t*)(F.ws + WS_BIG + BG_Y); bf16_t* C = (bf16_t*)(F.ws + WS_MIX + 32 * MiB);
    float* CA = (float*)(F.ws + WS_LRUA); float* CH = (float*)(F.ws + WS_LRUH);
    const int gw = F.bid * NWAVES + F.wave, NGW = F.nblk * NWAVES, lane = F.lane;
    for (int unit = gw; unit < NB * 8 * 64; unit += NGW) {
        const int g = unit & 7, ck = (unit >> 3) & 63, b = unit >> 9; const int ch = g * 64 + lane; const size_t rowb = (size_t)b * SEQ;
        float wra[64], wri[64];
#pragma unroll
        for (int i = 0; i < 64; ++i) { wra[i] = inp(I_ERA)[(size_t)(g * 64 + i) * 64 + lane]; wri[i] = inp(I_ERI)[(size_t)(g * 64 + i) * 64 + lane]; }
        const float bra = inp(I_EBRA)[ch], bri = inp(I_EBRI)[ch], lam = inp(I_ELAM)[ch], cb = inp(I_ECB)[ch];
        const float cw0 = inp(I_ECW)[ch], cw1 = inp(I_ECW)[512 + ch], cw2 = inp(I_ECW)[1024 + ch], cw3 = inp(I_ECW)[1536 + ch];
        const float spl = log1pf(__expf(-lam));
        const int t0 = ck * 64;
        float x3 = (t0 >= 3) ? bf2f(Y[(rowb + t0 - 3) * NE + YXB + ch]) : 0.f, x2 = (t0 >= 2) ? bf2f(Y[(rowb + t0 - 2) * NE + YXB + ch]) : 0.f, x1 = (t0 >= 1) ? bf2f(Y[(rowb + t0 - 1) * NE + YXB + ch]) : 0.f;
        float hst = 0.f, aprod = 1.f;
        if (MODE == 1) { for (int c = 0; c < ck; ++c) { const float a = CA[((size_t)b * 64 + c) * 512 + ch], hh = CH[((size_t)b * 64 + c) * 512 + ch]; hst = a * hst + hh; } }
        for (int tt = 0; tt < 64; ++tt) {
            const size_t m = rowb + t0 + tt;
            const float x0 = bf2f(Y[m * NE + YXB + ch]);
            const float xc = cw0 * x3 + cw1 * x2 + cw2 * x1 + cw3 * x0 + cb;
            x3 = x2; x2 = x1; x1 = x0;
            float ra = bra, ri = bri;
#pragma unroll
            for (int i = 0; i < 64; ++i) { const float xi = __uint_as_float(__builtin_amdgcn_readlane(__float_as_uint(xc), i)); ra += xi * wra[i]; ri += xi * wri[i]; }
            const float r = sigmoidf_(ra), ig = sigmoidf_(ri);
            const float log_a = -8.0f * r * spl; const float a = __expf(log_a); const float bb = sqrtf(-expm1f(2.0f * log_a)) * (ig * xc);
            hst = a * hst + bb; aprod *= a;
            if (MODE == 1) { const float gt = bf2f(Y[m * NE + YGATE + ch]); const float u = 0.7978845608028654f * (gt + 0.044715f * gt * gt * gt); const float ge = 0.5f * gt * (1.0f + tanhf(u));
                C[m * 1024 + 512 + ch] = (bf16_t)f2bf(hst * ge); }
        }
        if (MODE == 0) { CA[((size_t)b * 64 + ck) * 512 + ch] = aprod; CH[((size_t)b * 64 + ck) * 512 + ch] = hst; }
    }
}

__device__ __forceinline__ void phase_gla_a(const Ctx& F) {
    const bf16_t* Z = (const bf16_t*)(F.ws + WS_BIG + BG_Y);
    bf16_t* QD = (bf16_t*)(F.ws + WS_A + AF_QD); bf16_t* KI = (bf16_t*)(F.ws + WS_A + AF_KI); bf16_t* KR = (bf16_t*)(F.ws + WS_A + AF_KR); bf16_t* ATT = (bf16_t*)(F.ws + WS_A + AF_ATT);
    float* DEC = (float*)(F.ws + WS_DEC);
    LAS float* G = (LAS float*)F.lds;
    LAS float* qd = G + 64 * 128;
    LAS float* ki = qd + 64 * 129;
    LAS float* gl = ki + 64 * 129;
    const int tid = F.tid;
    for (int unit = F.bid; unit < NB * 64 * 4; unit += F.nblk) {
        const int h = unit & 3, n = (unit >> 2) & 63, b = unit >> 8; const size_t row0 = (size_t)b * SEQ + n * 64;
        for (int i = tid; i < 64 * 16; i += NTHREADS) gl[i] = bf2f(Z[(row0 + (i >> 4)) * NO + ZG + (i & 15)]);
        __syncthreads();
        for (int i = tid; i < 64 * 128; i += NTHREADS) { const int j = i >> 7, d = i & 127; float z = inp(I_OBG)[h * 128 + d];
#pragma unroll
            for (int r = 0; r < 16; ++r) z += gl[j * 16 + r] * inp(I_OG2)[r * 512 + h * 128 + d];
            const float ls = fminf(z, 0.f) - log1pf(__expf(-fabsf(z)));
            G[i] = ls * (1.0f / 16.0f); }
        __syncthreads();
        if (tid < 128) { float run = 0.f; for (int j = 0; j < 64; ++j) { run += G[j * 128 + tid]; G[j * 128 + tid] = run; } DEC[((size_t)b * 64 + n) * 512 + h * 128 + tid] = __expf(run); }
        __syncthreads();
        for (int i = tid; i < 64 * 128; i += NTHREADS) { const int j = i >> 7, d = i & 127; const size_t m = row0 + j;
            const float q = bf2f(Z[m * NO + ZQ + h * 128 + d]) * 0.08838834764831845f, k = bf2f(Z[m * NO + ZK + h * 128 + d]);
            const float gg = G[i], glast = G[63 * 128 + d];
            const float qdv = q * __expf(gg), kiv = k * __expf(-gg), krv = k * __expf(glast - gg);
            const bf16_t qb = (bf16_t)f2bf(qdv), kb = (bf16_t)f2bf(kiv);
            QD[m * 512 + h * 128 + d] = qb; KI[m * 512 + h * 128 + d] = kb; KR[m * 512 + h * 128 + d] = (bf16_t)f2bf(krv);
            qd[j * 129 + d] = bf2f(qb); ki[j * 129 + d] = bf2f(kb); }
        __syncthreads();
        for (int i = tid; i < 64 * 64; i += NTHREADS) { const int ii = i >> 6, jj = i & 63; float a = 0.f;
            if (jj <= ii) { for (int d = 0; d < 128; ++d) a += qd[ii * 129 + d] * ki[jj * 129 + d]; }
            ATT[(size_t)unit * 4096 + i] = (bf16_t)f2bf(a); }
        __syncthreads();
    }
}
__device__ __forceinline__ void phase_gla_b(const Ctx& F) {
    const bf16_t* Z = (const bf16_t*)(F.ws + WS_BIG + BG_Y);
    const bf16_t* QD = (const bf16_t*)(F.ws + WS_A + AF_QD); const bf16_t* KR = (const bf16_t*)(F.ws + WS_A + AF_KR); const bf16_t* ATT = (const bf16_t*)(F.ws + WS_A + AF_ATT);
    const float* DEC = (const float*)(F.ws + WS_DEC); bf16_t* ORAW = (bf16_t*)(F.ws + WS_MIX);
    LAS float* qd = (LAS float*)F.lds;
    LAS float* kr = qd + 64 * 129;
    LAS float* at = kr + 64 * 129;
    LAS float* vv = at + 64 * 65;
    LAS float* st = vv + 64 * 17;
    LAS float* dc = st + 128 * 17;
    const int tid = F.tid;
    for (int unit = F.bid; unit < NB * 4 * 16; unit += F.nblk) {
        const int vs = unit & 15, h = (unit >> 4) & 3, b = unit >> 6;
        for (int i = tid; i < 128 * 17; i += NTHREADS) st[i] = 0.f;
        __syncthreads();
        for (int n = 0; n < 64; ++n) {
            const size_t row0 = (size_t)b * SEQ + n * 64; const int au = ((b * 64 + n) << 2) + h;
            for (int i = tid; i < 64 * 128; i += NTHREADS) { const int j = i >> 7, d = i & 127; qd[j * 129 + d] = bf2f(QD[(row0 + j) * 512 + h * 128 + d]); kr[j * 129 + d] = bf2f(KR[(row0 + j) * 512 + h * 128 + d]); }
            for (int i = tid; i < 64 * 64; i += NTHREADS) at[(i >> 6) * 65 + (i & 63)] = bf2f(ATT[(size_t)au * 4096 + i]);
            for (int i = tid; i < 64 * 16; i += NTHREADS) vv[(i >> 4) * 17 + (i & 15)] = bf2f(Z[(row0 + (i >> 4)) * NO + ZV + h * 256 + vs * 16 + (i & 15)]);
            if (tid < 128) dc[tid] = DEC[((size_t)b * 64 + n) * 512 + h * 128 + tid];
            __syncthreads();
#pragma unroll
            for (int r = 0; r < 2; ++r) { const int idx = tid + r * NTHREADS, i = idx >> 4, v = idx & 15; float o = 0.f;
                for (int j = 0; j <= i; ++j) o += at[i * 65 + j] * vv[j * 17 + v];
                for (int d = 0; d < 128; ++d) o += qd[i * 129 + d] * st[d * 17 + v];
                ORAW[(row0 + i) * 1024 + h * 256 + vs * 16 + v] = (bf16_t)f2bf(o); }
            __syncthreads();
            float ns[4];
#pragma unroll
            for (int r = 0; r < 4; ++r) { const int idx = tid + r * NTHREADS, d = idx >> 4, v = idx & 15; float a = dc[d] * st[d * 17 + v];
                for (int j = 0; j < 64; ++j) a += kr[j * 129 + d] * vv[j * 17 + v];
                ns[r] = a; }
            __syncthreads();
#pragma unroll
            for (int r = 0; r < 4; ++r) { const int idx = tid + r * NTHREADS; st[(idx >> 4) * 17 + (idx & 15)] = ns[r]; }
            __syncthreads();
        }
    }
}
__device__ __forceinline__ void phase_gla_c(const Ctx& F) {
    const bf16_t* Z = (const bf16_t*)(F.ws + WS_BIG + BG_Y); const bf16_t* ORAW = (const bf16_t*)(F.ws + WS_MIX); bf16_t* C = (bf16_t*)(F.ws + WS_MIX + 32 * MiB);
    const float* hn = inp(I_OHN);
    const int gw = F.bid * NWAVES + F.wave, NGW = F.nblk * NWAVES, lane = F.lane;
    for (int m = gw; m < T; m += NGW) {
#pragma unroll
        for (int j = 0; j < 4; ++j) { const u32x2 w = ((const u32x2*)(ORAW + (size_t)m * 1024))[lane + 64 * j]; const u32x2 rw = ((const u32x2*)(Z + (size_t)m * NO + ZR))[lane + 64 * j];
            const float a = __uint_as_float(w.x << 16), bq = __uint_as_float(w.x & 0xffff0000u), c = __uint_as_float(w.y << 16), d = __uint_as_float(w.y & 0xffff0000u);
            const float rstd = 1.0f / sqrtf(wave_sum(a * a + bq * bq + c * c + d * d) * (1.f / 256.f) + EPS);
            const f32x4 gg = ((const f32x4*)hn)[lane];
            const float r0 = __uint_as_float(rw.x << 16), r1 = __uint_as_float(rw.x & 0xffff0000u), r2 = __uint_as_float(rw.y << 16), r3 = __uint_as_float(rw.y & 0xffff0000u);
            u32x2 o; o.x = pk2(a * rstd * gg.x * r0 * sigmoidf_(r0), bq * rstd * gg.y * r1 * sigmoidf_(r1)); o.y = pk2(c * rstd * gg.z * r2 * sigmoidf_(r2), d * rstd * gg.w * r3 * sigmoidf_(r3));
            ((u32x2*)(C + (size_t)m * 1024))[lane + 64 * j] = o; }
    }
}

__device__ __forceinline__ void phase_vt(const Ctx& F) {
    const bf16_t* KVm = (const bf16_t*)(F.ws + WS_KVM); bf16_t* Vt = (bf16_t*)(F.ws + WS_VT);
    const int gt = F.bid * NTHREADS + F.tid, NGT = F.nblk * NTHREADS;
    for (int i = gt; i < 1024 * 1024; i += NGT) { const int mm = i & 255, d = (i >> 8) & 255, h = (i >> 16) & 3, b = i >> 18;
        Vt[i] = KVm[(size_t)(b * 256 + mm) * 2048 + 1024 + h * 256 + d]; }
}
__device__ __forceinline__ void phase_xsoftmax(const Ctx& F) {
    const bf16_t* S = (const bf16_t*)(F.ws + WS_BIG + BG_S); bf16_t* P = (bf16_t*)(F.ws + WS_MIX);
    const int gw = F.bid * NWAVES + F.wave, NGW = F.nblk * NWAVES, lane = F.lane;
    for (int m = gw; m < T; m += NGW) {
#pragma unroll
        for (int j = 0; j < 4; ++j) { const u32x2 w = ((const u32x2*)(S + (size_t)m * 1024))[lane + 64 * j];
            const float a = __uint_as_float(w.x << 16), b = __uint_as_float(w.x & 0xffff0000u), c = __uint_as_float(w.y << 16), d = __uint_as_float(w.y & 0xffff0000u);
            const float mx = wave_max(fmaxf(fmaxf(a, b), fmaxf(c, d)));
            const float ea = __expf(a - mx), eb = __expf(b - mx), ec = __expf(c - mx), ed = __expf(d - mx);
            const float inv = 1.0f / wave_sum((ea + eb) + (ec + ed));
            u32x2 o; o.x = pk2(ea * inv, eb * inv); o.y = pk2(ec * inv, ed * inv);
            ((u32x2*)(P + (size_t)m * 1024))[lane + 64 * j] = o; }
    }
}

enum Kind { K_PREP = 0, K_SWIGLU, K_GEMM, K_NORM, K_CKVN, K_IDX, K_ATT, K_LRU_A, K_LRU_B, K_GLA_A, K_GLA_B, K_GLA_C, K_VT, K_XSOFTMAX };
enum Op { OP_UP1 = 0, OP_DN1, OP_N1, OP_IN, OP_M0, OP_M1, OP_M2, OP_M3, OP_M4, OP_M5, OP_OUT, OP_N2, OP_XQ, OP_XKV, OP_XVT, OP_XS, OP_XSM, OP_XO, OP_XOUT, OP_N3, OP_UP2, OP_DN2, OP_N4, OP_COUNT };
constexpr int NPHASES = 1 + 2 * OP_COUNT;

struct Desc { int kind; pg8::Gemm g; bf16_t* O; int ldc; float scale; const bf16_t* Fb; const float* hin; float coef; const float* gpost; const float* gpre; };
__device__ __forceinline__ void st_ptr(LAS unsigned* p, const void* q) { const unsigned long long v = (unsigned long long)(uintptr_t)q; p[0] = (unsigned)v; p[1] = (unsigned)(v >> 32); }
__device__ __forceinline__ unsigned ld_u(const LAS unsigned* p) { return (unsigned)__builtin_amdgcn_readfirstlane((int)p[0]); }
__device__ __forceinline__ const void* ld_ptr(const LAS unsigned* p) { const unsigned long long v = (unsigned long long)ld_u(p) | ((unsigned long long)ld_u(p + 1) << 32); return (const void*)(uintptr_t)v; }
__device__ __forceinline__ void desc_store(LAS unsigned* t, const Desc& d) {
    t[0] = (unsigned)d.kind; st_ptr(t + 1, d.g.A); st_ptr(t + 3, d.g.Bt); t[5] = d.g.lda; t[6] = d.g.ldb; t[7] = d.g.K; t[8] = d.g.nM; t[9] = d.g.nN; t[10] = d.g.a_pn_off; t[11] = d.g.b_pn_off; t[12] = d.g.b_batch_off; t[13] = d.g.bshift;
    st_ptr(t + 14, d.O); t[16] = d.ldc; t[17] = __float_as_uint(d.scale); st_ptr(t + 18, d.Fb); st_ptr(t + 20, d.hin); t[22] = __float_as_uint(d.coef); st_ptr(t + 23, d.gpost); st_ptr(t + 25, d.gpre);
}
__device__ __forceinline__ Desc desc_load(const LAS unsigned* t) {
    Desc d; d.kind = (int)ld_u(t); d.g.A = (const bf16_t*)ld_ptr(t + 1); d.g.Bt = (const bf16_t*)ld_ptr(t + 3); d.g.lda = ld_u(t + 5); d.g.ldb = ld_u(t + 6); d.g.K = ld_u(t + 7); d.g.nM = ld_u(t + 8); d.g.nN = ld_u(t + 9);
    d.g.a_pn_off = ld_u(t + 10); d.g.b_pn_off = ld_u(t + 11); d.g.b_batch_off = ld_u(t + 12); d.g.bshift = ld_u(t + 13);
    d.O = (bf16_t*)ld_ptr(t + 14); d.ldc = ld_u(t + 16); d.scale = __uint_as_float(ld_u(t + 17)); d.Fb = (const bf16_t*)ld_ptr(t + 18); d.hin = (const float*)ld_ptr(t + 20); d.coef = __uint_as_float(ld_u(t + 22));
    d.gpost = (const float*)ld_ptr(t + 23); d.gpre = (const float*)ld_ptr(t + 25); return d;
}

__device__ __forceinline__ Desc make_desc(const Ctx& F, int ph) {
    Desc d; d.kind = -1; d.O = nullptr; d.ldc = 0; d.scale = 1.f; d.Fb = nullptr; d.hin = nullptr; d.coef = 0.f; d.gpost = nullptr; d.gpre = nullptr;
    d.g = pg8::plain_gemm(nullptr, 0, nullptr, 0, 256, 256, 256);
    if (ph == 0) { d.kind = K_PREP; return d; }
    const int l = (ph - 1) / OP_COUNT, op = (ph - 1) % OP_COUNT;
    unsigned char* ws = F.ws; const float* nrm = inp(I_NORMS) + (size_t)l * 9 * D;
    bf16_t* A = (bf16_t*)(ws + WS_A); bf16_t* Fb = (bf16_t*)(ws + WS_F); bf16_t* BIG = (bf16_t*)(ws + WS_BIG); bf16_t* MIX = (bf16_t*)(ws + WS_MIX); bf16_t* Cc = (bf16_t*)(ws + WS_MIX + 32 * MiB);
    const unsigned char* W = ws + WS_W;
    switch (op) {
    case OP_UP1: case OP_UP2: { const int i = (op == OP_UP2); d.kind = K_SWIGLU; d.g = pg8::plain_gemm(A, D, (const bf16_t*)(W + W_GU) + (size_t)(l * 2 + i) * 2 * FF * D, D, T, 2 * FF, D); d.O = BIG; d.ldc = FF; break; }
    case OP_DN1: case OP_DN2: { const int i = (op == OP_DN2); d.kind = K_GEMM; d.g = pg8::plain_gemm(BIG, FF, (const bf16_t*)(W + W_DN) + (size_t)(l * 2 + i) * D * FF, FF, T, D, FF); d.O = Fb; d.ldc = D; break; }
    case OP_N1: d.kind = K_NORM; d.Fb = Fb; d.hin = (l == 0) ? inp(I_X) : F.out; d.coef = 0.5f; d.gpost = nrm + N_FFN1_POST * D; d.gpre = nrm + N_MIX_PRE * D; break;
    case OP_IN: d.kind = K_GEMM; if (l == 0) d.g = pg8::plain_gemm(A, D, (const bf16_t*)(W + W_EIN), D, T, NE, D); else d.g = pg8::plain_gemm(A, D, (const bf16_t*)(W + W_OIN), D, T, NO, D);
                d.O = BIG; d.ldc = (l == 0) ? NE : NO; break;
    case OP_M0: d.kind = (l == 0) ? K_CKVN : K_GLA_A; break;
    case OP_M1: if (l == 0) { d.kind = K_GEMM; d.g = pg8::plain_gemm((const bf16_t*)(ws + WS_BIG + BG_CKVN), 256, (const bf16_t*)(W + W_UKV), 256, T, 1024, 256); d.O = MIX; d.ldc = 1024; } else d.kind = K_GLA_B; break;
    case OP_M2: d.kind = (l == 0) ? K_IDX : K_GLA_C; break;
    case OP_M3: d.kind = (l == 0) ? K_ATT : -1; break;
    case OP_M4: d.kind = (l == 0) ? K_LRU_A : -1; break;
    case OP_M5: d.kind = (l == 0) ? K_LRU_B : -1; break;
    case OP_OUT: d.kind = K_GEMM; d.g = pg8::plain_gemm(Cc, D, (const bf16_t*)(W + (l == 0 ? W_EOUT : W_OOUT)), D, T, D, D); d.O = Fb; d.ldc = D; break;
    case OP_N2: d.kind = K_NORM; d.Fb = Fb; d.hin = F.out; d.coef = 1.0f; d.gpost = nrm + N_MIX_POST * D; d.gpre = nrm + N_XA_PRE * D; break;
    case OP_XQ: d.kind = K_GEMM; d.g = pg8::plain_gemm(A, D, (const bf16_t*)(W + W_Q) + (size_t)l * D * D, D, T, D, D); d.O = BIG; d.ldc = D; break;
    case OP_XKV: d.kind = K_GEMM; d.g = pg8::plain_gemm((const bf16_t*)(ws + (l ? WS_MEMN1 : WS_MEMN0)), D, (const bf16_t*)(W + W_KV) + (size_t)l * 2 * D * D, D, 1024, 2 * D, D); d.O = (bf16_t*)(ws + WS_KVM); d.ldc = 2 * D; break;
    case OP_XVT: d.kind = K_VT; break;
    case OP_XS: { d.kind = K_GEMM; pg8::Gemm g; g.A = BIG; g.Bt = (const bf16_t*)(ws + WS_KVM); g.lda = D; g.ldb = 2 * D; g.K = 256; g.nM = T / 256; g.nN = 4; g.a_pn_off = 256; g.b_pn_off = 256; g.b_batch_off = 256 * 2 * D; g.bshift = 4;
                  d.g = g; d.O = (bf16_t*)(ws + WS_BIG + BG_S); d.ldc = D; d.scale = 0.0625f; break; }
    case OP_XSM: d.kind = K_XSOFTMAX; break;
    case OP_XO: { d.kind = K_GEMM; pg8::Gemm g; g.A = MIX; g.Bt = (const bf16_t*)(ws + WS_VT); g.lda = D; g.ldb = 256; g.K = 256; g.nM = T / 256; g.nN = 4; g.a_pn_off = 256; g.b_pn_off = 256 * 256; g.b_batch_off = 4 * 256 * 256; g.bshift = 4;
                  d.g = g; d.O = BIG; d.ldc = D; break; }
    case OP_XOUT: d.kind = K_GEMM; d.g = pg8::plain_gemm(BIG, D, (const bf16_t*)(W + W_O) + (size_t)l * D * D, D, T, D, D); d.O = Fb; d.ldc = D; break;
    case OP_N3: d.kind = K_NORM; d.Fb = Fb; d.hin = F.out; d.coef = 1.0f; d.gpost = nrm + N_XA_POST * D; d.gpre = nrm + N_FFN2_PRE * D; break;
    case OP_N4: d.kind = K_NORM; d.Fb = Fb; d.hin = F.out; d.coef = 0.5f; d.gpost = nrm + N_FFN2_POST * D; d.gpre = (l == 0) ? (inp(I_NORMS) + (size_t)(9 + N_FFN1_PRE) * D) : nullptr; break;
    default: break;
    }
    return d;
}

__global__ void __launch_bounds__(NTHREADS, 2) mk_fwd(Args args) {
    extern __shared__ __attribute__((aligned(16))) unsigned char lds_raw[];
    Ctx F; F.lds = (LAS unsigned char*)lds_raw; F.ldsg = (char*)lds_raw; F.tid = threadIdx.x; F.lane = F.tid & 63; F.wave = __builtin_amdgcn_readfirstlane(F.tid >> 6);
    F.nblk = gridDim.x; F.bid = blockIdx.x; F.out = args.out; F.ws = args.ws;
    volatile LAS unsigned* MISC = (volatile LAS unsigned*)(F.lds + MISC_OFF);
    for (int u = F.tid; u < (LDS_BYTES - MISC_OFF) / 4; u += NTHREADS) MISC[u] = 0u;
    __syncthreads();
    XcdBarrier bar; bar.bar = (unsigned*)(args.ws + WS_CTL) + CW_BAR; bar.x = 0; bar.st = nullptr;
#if !MK_PER_PHASE
    bar = xcd_barrier_post((unsigned*)(args.ws + WS_CTL) + CW_BAR, MISC + 8);
#endif
    F.kp = (const __attribute__((address_space(4))) void*)__builtin_amdgcn_kernarg_segment_ptr();
    if (F.tid < NPHASES) { const Desc dd = make_desc(F, F.tid); desc_store((LAS unsigned*)(F.lds + DESC_OFF) + F.tid * DESC_WORDS, dd); }
    __syncthreads();
    const Ctx F0 = F;
    for (int ph = args.ph_lo; ph < args.ph_hi; ++ph) {
        Ctx F = F0;
        asm volatile("" ::: "v16","v17","v18","v19","v20","v21","v22","v23","v24","v25","v26","v27","v28","v29","v30","v31","v32","v33","v34","v35","v36","v37","v38","v39","v40","v41","v42","v43","v44","v45","v46","v47","v48","v49","v50","v51","v52","v53","v54","v55","v56","v57","v58","v59","v60","v61","v62","v63","v64","v65","v66","v67","v68","v69","v70","v71","v72","v73","v74","v75","v76","v77","v78","v79","v80","v81","v82","v83","v84","v85","v86","v87","v88","v89","v90","v91","v92","v93","v94","v95","v96","v97","v98","v99","v100","v101","v102","v103","v104","v105","v106","v107","v108","v109","v110","v111","v112","v113","v114","v115","v116","v117","v118","v119","v120","v121","v122","v123","v124","v125","v126","v127","v128","v129","v130","v131","v132","v133","v134","v135","v136","v137","v138","v139","v140","v141","v142","v143","v144","v145","v146","v147","v148","v149","v150","v151","v152","v153","v154","v155","v156","v157","v158","v159","v160","v161","v162","v163","v164","v165","v166","v167","v168","v169","v170","v171","v172","v173","v174","v175","v176","v177","v178","v179","v180","v181","v182","v183","v184","v185","v186","v187","v188","v189","v190","v191","v192","v193","v194","v195","v196","v197","v198","v199","v200","v201","v202","v203","v204","v205","v206","v207","v208","v209","v210","v211","v212","v213","v214","v215","v216","v217","v218","v219","v220","v221","v222","v223","v224","v225","v226","v227","v228","v229","v230","v231","v232","v233","v234","v235");
        F.tid = F0.tid;
        const Desc d = desc_load((const LAS unsigned*)(F.lds + DESC_OFF) + ph * DESC_WORDS);
        if (d.kind < 0) continue;
#ifndef PH_ENABLE
#define PH_ENABLE 0xffffffffu
#endif
#define EN(k) (((PH_ENABLE) >> (k)) & 1u)
#ifndef REPEAT_MASK
#define REPEAT_MASK 0u
#endif
        for (int rep = 0; rep < 1 + (int)((REPEAT_MASK >> d.kind) & 1u); ++rep) {
        if (rep) __syncthreads();
        F = F0;
        { unsigned long long p0 = (unsigned long long)(uintptr_t)F.ws, p1 = (unsigned long long)(uintptr_t)F.out, p2 = (unsigned long long)(uintptr_t)F.kp;
          unsigned a0 = (unsigned)p0, a1 = (unsigned)(p0 >> 32), b0 = (unsigned)p1, b1 = (unsigned)(p1 >> 32), c0 = (unsigned)p2, c1 = (unsigned)(p2 >> 32); int w_ = F.wave, n_ = F.nblk, i_ = F.bid;
          int ln_; asm volatile("v_mbcnt_lo_u32_b32 %0, -1, 0\n\tv_mbcnt_hi_u32_b32 %0, -1, %0" : "=v"(ln_));
          asm volatile("" : "+v"(a0), "+v"(a1), "+v"(b0), "+v"(b1), "+v"(c0), "+v"(c1), "+v"(w_), "+v"(n_), "+v"(i_));
#define RFL(x) ((unsigned)__builtin_amdgcn_readfirstlane((int)(x)))
          F.ws = (unsigned char*)(uintptr_t)((unsigned long long)RFL(a0) | ((unsigned long long)RFL(a1) << 32)); F.out = (float*)(uintptr_t)((unsigned long long)RFL(b0) | ((unsigned long long)RFL(b1) << 32));
          F.kp = (const __attribute__((address_space(4))) void*)(uintptr_t)((unsigned long long)RFL(c0) | ((unsigned long long)RFL(c1) << 32)); F.wave = (int)RFL(w_); F.nblk = (int)RFL(n_); F.bid = (int)RFL(i_); F.lane = ln_; F.tid = F.wave * 64 + ln_; }
        switch (d.kind) {
        case K_PREP: if constexpr (EN(K_PREP)) { phase_prep(F); } break;
#if NAIVE_GEMM
        case K_SWIGLU: { pg8::EpiSwiglu E{d.O, d.ldc}; pg8::gemm_naive<2>(F.lds, d.g, E, F.nblk, F.bid, F.tid); break; }
        case K_GEMM: { pg8::EpiBf16 E{d.O, d.ldc, d.scale}; pg8::gemm_naive<1>(F.lds, d.g, E, F.nblk, F.bid, F.tid); break; }
#else
        case K_SWIGLU: case K_GEMM: if constexpr (EN(K_GEMM)) {
            pg8::StaticOrder S; S.init(d.g.nM, d.g.nN, F.nblk, F.bid); pg8::EpiAny E{d.O, d.ldc, d.scale, d.kind == K_SWIGLU ? 1 : 0}; pg8::gemm_phase<pg8::EpiAny, true>(F.lds, d.g, S, E, F.tid);
            break; }
#endif
        case K_NORM: if constexpr (EN(K_NORM)) { phase_norm(F, d.Fb, d.hin, F.out, d.coef, d.gpost, d.gpre, (bf16_t*)(F.ws + WS_A)); } break;
        case K_CKVN: if constexpr (EN(K_CKVN)) { phase_ckvn(F); } break;
        case K_IDX: if constexpr (EN(K_IDX)) { phase_idx(F); } break;
        #ifdef ATT_NAIVE
        case K_ATT: if constexpr (EN(K_ATT)) { phase_att_naive(F); } break;
#else
        case K_ATT: if constexpr (EN(K_ATT)) { dsa::attn_phase<8>(F.tid, F.nblk, F.bid, (const dsa::bf16*)(F.ws + WS_BIG + BG_Y) + YQ, (const dsa::bf16*)(F.ws + WS_MIX), (const dsa::bf16*)(F.ws + WS_MIX) + 512,
                                                                  (dsa::bf16*)(F.ws + WS_MIX + 32 * MiB), (const dsa::u32x2*)(F.ws + WS_BIG + BG_MASK), F.ldsg); } break;
#endif
        case K_LRU_A: if constexpr (EN(K_LRU_A)) { phase_lru<0>(F); } break;
        case K_LRU_B: if constexpr (EN(K_LRU_B)) { phase_lru<1>(F); } break;
        case K_GLA_A: if constexpr (EN(K_GLA_A)) { phase_gla_a(F); } break;
        case K_GLA_B: if constexpr (EN(K_GLA_B)) { phase_gla_b(F); } break;
        case K_GLA_C: if constexpr (EN(K_GLA_C)) { phase_gla_c(F); } break;
        case K_VT: if constexpr (EN(K_VT)) { phase_vt(F); } break;
        case K_XSOFTMAX: if constexpr (EN(K_XSOFTMAX)) { phase_xsoftmax(F); } break;
        default: break;
        }
        }
#if !MK_PER_PHASE
        if (ph + 1 < args.ph_hi) {
            if (ph == 0) { cg::this_grid().sync(); }
            XcdBarrier bb = bar; { unsigned long long p = (unsigned long long)(uintptr_t)bb.bar; unsigned lo = (unsigned)p, hi = (unsigned)(p >> 32), xx = bb.x; asm volatile("" : "+v"(lo), "+v"(hi), "+v"(xx));
                bb.bar = (unsigned*)(uintptr_t)((unsigned long long)RFL(lo) | ((unsigned long long)RFL(hi) << 32)); bb.x = RFL(xx); }
            xcd_barrier(bb);
        }
#endif
    }
}

extern "C" void kernel_launch(void* const* d_in, const int* in_sizes, int n_in, void* d_out, int out_size, void* d_ws, size_t ws_size, hipStream_t stream) {
    static int grid = 0;
    if (grid == 0) {
        if (n_in != 25 || in_sizes[0] != T * D || out_size != T * D || ws_size < WS_END) { fprintf(stderr, "kernel_launch: unexpected shapes (n_in %d, in0 %d, out %d, ws %zu); nothing launched\n", n_in, n_in > 0 ? in_sizes[0] : -1, out_size, ws_size); grid = -1; return; }
        int dev = 0, cus = 0, per_cu = 0;
        if (hipGetDevice(&dev) != hipSuccess || hipDeviceGetAttribute(&cus, hipDeviceAttributeMultiprocessorCount, dev) != hipSuccess) { grid = -1; return; }
        if (hipFuncSetAttribute((const void*)mk_fwd, hipFuncAttributeMaxDynamicSharedMemorySize, LDS_BYTES) != hipSuccess) { fprintf(stderr, "kernel_launch: hipFuncSetAttribute failed\n"); grid = -1; return; }
        if (hipOccupancyMaxActiveBlocksPerMultiprocessor(&per_cu, (const void*)mk_fwd, NTHREADS, LDS_BYTES) != hipSuccess || per_cu < 1) { fprintf(stderr, "kernel_launch: occupancy query says %d\n", per_cu); (void)hipGetLastError(); grid = -1; return; }
        grid = cus;
    }
    if (grid < 0) return;
    (void)hipMemsetAsync((char*)d_ws + WS_CTL, 0, CTL_BYTES, stream);
    Args a{};
    for (int i = 0; i < 25; ++i) a.in[i] = (const float*)d_in[i];
    a.out = (float*)d_out; a.ws = (unsigned char*)d_ws;
#if MK_PER_PHASE
    for (int ph = 0; ph < NPHASES; ++ph) { a.ph_lo = ph; a.ph_hi = ph + 1; hipLaunchKernelGGL(mk_fwd, dim3(grid), dim3(NTHREADS), LDS_BYTES, stream, a); }
#else
    a.ph_lo = 0; a.ph_hi = NPHASES;
    void* kargs[] = {&a};
    hipError_t e = hipLaunchCooperativeKernel((const void*)mk_fwd, dim3(grid), dim3(NTHREADS), kargs, LDS_BYTES, stream);
    if (e != hipSuccess) fprintf(stderr, "cooperative launch failed: %s (grid %d)\n", hipGetErrorString(e), grid);
#endif
}
```

```cpp
#include <hip/hip_runtime.h>
#include <hip/hip_cooperative_groups.h>
#include <hip/hip_bf16.h>
#include <cmath>
#include <cstdio>
#include <cstdint>
namespace cg = cooperative_groups;

#ifndef MK_PER_PHASE
#define MK_PER_PHASE 0
#endif
#ifndef NAIVE_GEMM
#define NAIVE_GEMM 0
#endif

#define LAS __attribute__((address_space(3)))
#define GAS __attribute__((address_space(1)))
typedef unsigned short bf16_t;
typedef short bf16x8 __attribute__((ext_vector_type(8)));
typedef float f32x4 __attribute__((ext_vector_type(4)));
typedef float f32x2 __attribute__((ext_vector_type(2)));
typedef unsigned u32x4 __attribute__((ext_vector_type(4)));
typedef unsigned u32x2 __attribute__((ext_vector_type(2)));

constexpr int NB = 4, SEQ = 4096, T = NB * SEQ, D = 1024, FF = 2816;
constexpr int NE = 2560, NO = 3328;
constexpr int YQ = 0, YCKV = 512, YQI = 768, YKI = 1280, YWI = 1344, YGATE = 1536, YXB = 2048;
constexpr int ZQ = 0, ZK = 512, ZV = 1024, ZG = 2048, ZR = 2304;
constexpr float EPS = 1e-6f;
constexpr float C2 = 0.125f * 1.4426950408889634f;

constexpr size_t MiB = 1u << 20;
constexpr size_t WS_CTL = 0, CTL_BYTES = 1 * MiB;
constexpr size_t WS_MEMN0 = 1 * MiB, WS_MEMN1 = 3 * MiB, WS_KVM = 5 * MiB, WS_VT = 9 * MiB, WS_LRUA = 11 * MiB, WS_LRUH = 11 * MiB + 512 * 1024, WS_DEC = 12 * MiB;
constexpr size_t WS_W = 17 * MiB;
constexpr size_t W_GU = 0, W_DN = 44 * MiB, W_Q = 66 * MiB, W_KV = 70 * MiB, W_O = 78 * MiB, W_EIN = 82 * MiB, W_UKV = 87 * MiB, W_EOUT = 87 * MiB + 512 * 1024,
                 W_OIN = 89 * MiB + 512 * 1024, W_OOUT = 96 * MiB;
constexpr size_t WS_A = 115 * MiB, WS_F = 147 * MiB;
constexpr size_t WS_BIG = 179 * MiB;
constexpr size_t WS_MIX = 283 * MiB;
constexpr size_t WS_END = 347 * MiB;
constexpr size_t AF_QD = 0, AF_KRT = 16 * MiB, AF_ATT = 32 * MiB;
constexpr size_t BG_Y = 0, BG_CKVN = 80 * MiB, BG_MASK = 88 * MiB;
constexpr size_t BG_Q = 0, BG_S = 32 * MiB;
constexpr size_t BG_H = 0;
constexpr int CW_BAR = 4096;

__device__ __forceinline__ float bf2f(bf16_t v) { return __uint_as_float((unsigned)v << 16); }
__device__ __forceinline__ unsigned f2bf(float f) { unsigned u = __float_as_uint(f); return (u + 0x7fffu + ((u >> 16) & 1u)) >> 16; }
__device__ __forceinline__ unsigned pk2(float lo, float hi) { return f2bf(lo) | (f2bf(hi) << 16); }
__device__ __forceinline__ float wave_sum(float v) {
#pragma unroll
    for (int o = 1; o < 64; o <<= 1) v += __shfl_xor(v, o);
    return v;
}
__device__ __forceinline__ float wave_max(float v) {
#pragma unroll
    for (int o = 1; o < 64; o <<= 1) v = fmaxf(v, __shfl_xor(v, o));
    return v;
}
__device__ __forceinline__ float sigmoidf_(float x) { return 1.0f / (1.0f + __expf(-x)); }

namespace pg8 {
constexpr int BM = 256, BK = 64, HALF = 128, HTB = HALF * BK * 2, STAGE_BYTES = 8 * HTB, NXCD = 8, WGM = 8;
__host__ __device__ __forceinline__ int lds_byte(int r, int c) { const int st = (r >> 4) * 2 + (c >> 5), rr = r & 15, cc = c & 31, ob = rr * 64 + cc * 2; return st * 1024 + (ob ^ (((ob >> 9) & 1) << 5)); }
__host__ __device__ __forceinline__ void stage_rc(int b, int& R, int& C) { const int st = b / 1024, sb = b % 1024, swz = sb ^ (((sb >> 9) & 1) << 5); R = (st >> 1) * 16 + swz / 64; C = (st & 1) * 32 + (swz % 64) / 2; }
__host__ __device__ __forceinline__ int perm32(int rho) { const int n = rho >> 4, i = rho & 15; return 8 * (i >> 2) + 4 * n + (i & 3); }

struct Unit { int pm, pn; };
struct Gemm {
    const bf16_t* A; const bf16_t* Bt; int lda, ldb, K, nM, nN; int a_pn_off, b_pn_off, b_batch_off, bshift;
    __device__ __forceinline__ const char* a_ptr(const Unit& u) const { return (const char*)(A + (size_t)u.pm * BM * lda + (size_t)u.pn * a_pn_off); }
    __device__ __forceinline__ const char* b_ptr(const Unit& u) const { return (const char*)(Bt + (size_t)u.pn * b_pn_off + (size_t)(u.pm >> bshift) * b_batch_off); }
};
__device__ __forceinline__ Gemm plain_gemm(const bf16_t* A, int lda, const bf16_t* Bt, int ldb, int M, int N, int K) {
    Gemm g; g.A = A; g.Bt = Bt; g.lda = lda; g.ldb = ldb; g.K = K; g.nM = M / BM; g.nN = N / BM; g.a_pn_off = 0; g.b_pn_off = BM * ldb; g.b_batch_off = 0; g.bshift = 30; return g;
}
struct StaticOrder {
    int nM, nN, nwg, G, c;
    __device__ void init(int nM_, int nN_, int G_, int c_) { nM = nM_; nN = nN_; nwg = nM * nN; G = G_; c = c_; }
    __device__ bool next(int i, Unit& u) const {
        const long L = (long)i * G + c; if (L >= nwg) return false;
        int wgid = (int)L; { const int q = nwg / NXCD, r = nwg % NXCD, xcd = wgid % NXCD, off = wgid / NXCD; wgid = (xcd < r ? xcd * (q + 1) : r * (q + 1) + (xcd - r) * q) + off; }
        const int nig = WGM * nN, gid = wgid / nig, fm = gid * WGM, gsz = (nM - fm) < WGM ? (nM - fm) : WGM;
        u.pm = fm + ((wgid % nig) % gsz); u.pn = (wgid % nig) / gsz; return true;
    }
};
__device__ __forceinline__ unsigned cvt_pk_bf16(float lo, float hi) { unsigned r; asm volatile("v_cvt_pk_bf16_f32 %0, %1, %2" : "=v"(r) : "v"(lo), "v"(hi)); return r; }

struct EpiBf16 {
    static constexpr bool PERM = true;
    bf16_t* O; int ldc; float scale;
    __device__ __forceinline__ void operator()(const f32x4 (&acc)[2][2][4][2], const Unit& u, int wr, int wc, int fr, int fq) const {
        const int row0 = u.pm * BM + wr * 64 + fr, col0 = u.pn * BM + wc * 32 + 8 * fq;
#pragma unroll
        for (int ai = 0; ai < 2; ++ai)
#pragma unroll
            for (int m = 0; m < 4; ++m) { bf16_t* rowp = O + (size_t)(row0 + ai * HALF + m * 16) * ldc + col0;
#pragma unroll
                for (int bj = 0; bj < 2; ++bj) { const f32x4 v0 = acc[ai][bj][m][0] * scale, v1 = acc[ai][bj][m][1] * scale;
                    u32x4 w; w.x = cvt_pk_bf16(v0[0], v0[1]); w.y = cvt_pk_bf16(v0[2], v0[3]); w.z = cvt_pk_bf16(v1[0], v1[1]); w.w = cvt_pk_bf16(v1[2], v1[3]);
                    *(u32x4*)(rowp + bj * HALF) = w; } }
    }
    __device__ __forceinline__ void elem(int row, int col, float a0, float) const { O[(size_t)row * ldc + col] = (bf16_t)f2bf(a0 * scale); }
};
struct EpiSwiglu {
    static constexpr bool PERM = true;
    bf16_t* O; int ldc;
    __device__ __forceinline__ void operator()(const f32x4 (&acc)[2][2][4][2], const Unit& u, int wr, int wc, int fr, int fq) const {
        const int row0 = u.pm * BM + wr * 64 + fr, col0 = u.pn * HALF + wc * 32 + 8 * fq;
#pragma unroll
        for (int ai = 0; ai < 2; ++ai)
#pragma unroll
            for (int m = 0; m < 4; ++m) { bf16_t* rowp = O + (size_t)(row0 + ai * HALF + m * 16) * ldc + col0; float o[8];
#pragma unroll
                for (int n = 0; n < 2; ++n)
#pragma unroll
                    for (int i = 0; i < 4; ++i) { const float g = acc[ai][0][m][n][i], uu = acc[ai][1][m][n][i]; o[4 * n + i] = g * __builtin_amdgcn_rcpf(1.0f + __expf(-g)) * uu; }
                u32x4 w; w.x = cvt_pk_bf16(o[0], o[1]); w.y = cvt_pk_bf16(o[2], o[3]); w.z = cvt_pk_bf16(o[4], o[5]); w.w = cvt_pk_bf16(o[6], o[7]);
                *(u32x4*)rowp = w; }
    }
    __device__ __forceinline__ void elem(int row, int j, float g, float uu) const { O[(size_t)row * ldc + j] = (bf16_t)f2bf(g / (1.0f + __expf(-g)) * uu); }
};

struct EpiAny {
    static constexpr bool PERM = true;
    bf16_t* O; int ldc; float scale; int mode;
    __device__ __forceinline__ void operator()(const f32x4 (&acc)[2][2][4][2], const Unit& u, int wr, int wc, int fr, int fq) const {
        if (mode == 0) { EpiBf16 E{O, ldc, scale}; E(acc, u, wr, wc, fr, fq); } else { EpiSwiglu E{O, ldc}; E(acc, u, wr, wc, fr, fq); }
    }
};
template <class Epi, bool ALIGN_EPI>
__device__ __forceinline__ void gemm_phase(LAS unsigned char* lds, const Gemm g, const StaticOrder& S, const Epi& E, const int tid) {
    const int wid = __builtin_amdgcn_readfirstlane(tid >> 6), lane = tid & 63, wr = wid >> 2, wc = wid & 3, fr = lane & 15, fq = lane >> 4;
    const int K = g.K, nt = K / BK;
    unsigned voffA[2], voffB[2];
#pragma unroll
    for (int i = 0; i < 2; ++i) { int R, C; stage_rc(tid * 16 + i * 8192, R, C); const int Rb = Epi::PERM ? ((R & ~31) + perm32(R & 31)) : R;
        voffA[i] = (unsigned)(R * g.lda + C) * 2u; voffB[i] = (unsigned)(Rb * g.ldb + C) * 2u; }
    const size_t kstep = (size_t)(BK * 2);
    const size_t hstepA = (size_t)HALF * g.lda * 2, hstepB = (size_t)HALF * g.ldb * 2;
    const unsigned ldsw = (unsigned)wid * 1024u;
    const int aoff = lds_byte(wr * 64 + fr, fq * 8), boff = lds_byte(wc * 32 + fr, fq * 8);
#define PG8_SA(b, h) (((b) * 2 + (h)) * HTB)
#define PG8_SB(b, h) ((4 + (b) * 2 + (h)) * HTB)
#define PG8_STAGE(bufoff, gbase, voff) do { _Pragma("unroll") for (int _i = 0; _i < 2; ++_i) \
        __builtin_amdgcn_global_load_lds((const unsigned*)((const char*)(gbase) + (voff)[_i]), (LAS unsigned*)(lds + (bufoff) + ldsw + _i * 8192), 16, 0, 0); } while (0)
#define PG8_LDA(dst, b, h) do { _Pragma("unroll") for (int m = 0; m < 4; ++m) _Pragma("unroll") for (int k = 0; k < 2; ++k) dst[m][k] = *(const LAS bf16x8*)(lds + PG8_SA(b, h) + aoff + m * 2048 + k * 1024); } while (0)
#define PG8_LDB(dst, b, h) do { _Pragma("unroll") for (int n = 0; n < 2; ++n) _Pragma("unroll") for (int k = 0; k < 2; ++k) dst[n][k] = *(const LAS bf16x8*)(lds + PG8_SB(b, h) + boff + n * 2048 + k * 1024); } while (0)
#define PG8_MMA(ai, bj, At, Bt) do { __builtin_amdgcn_s_setprio(1); _Pragma("unroll") for (int m = 0; m < 4; ++m) _Pragma("unroll") for (int n = 0; n < 2; ++n) _Pragma("unroll") for (int k = 0; k < 2; ++k) \
        acc[ai][bj][m][n] = __builtin_amdgcn_mfma_f32_16x16x32_bf16(Bt[n][k], At[m][k], acc[ai][bj][m][n], 0, 0, 0); __builtin_amdgcn_s_setprio(0); } while (0)
#define PG8_WAIT_V(n) asm volatile("s_waitcnt vmcnt(" #n ")" ::: "memory")
#define PG8_WAIT_L(n) asm volatile("s_waitcnt lgkmcnt(" #n ")" ::: "memory")
#define PG8_BAR __builtin_amdgcn_s_barrier()
#define PG8_SCHED __builtin_amdgcn_sched_barrier(0)
    Unit cur, nxt; int ui = 0;
    if (!S.next(0, cur)) return;
    f32x4 acc[2][2][4][2];
#pragma unroll
    for (int a = 0; a < 2; ++a)
#pragma unroll
        for (int b = 0; b < 2; ++b)
#pragma unroll
            for (int m = 0; m < 4; ++m)
#pragma unroll
                for (int n = 0; n < 2; ++n) acc[a][b][m][n] = (f32x4){0.f, 0.f, 0.f, 0.f};
    bf16x8 At[4][2], B0[2][2], B1[2][2];
    const char* cA = g.a_ptr(cur); const char* cB = g.b_ptr(cur);
    PG8_STAGE(PG8_SB(0, 0), cB, voffB); PG8_STAGE(PG8_SB(0, 1), cB + hstepB, voffB); PG8_STAGE(PG8_SA(0, 0), cA, voffA); PG8_STAGE(PG8_SA(0, 1), cA + hstepA, voffA);
    if (wr == 1) PG8_BAR;
    PG8_WAIT_V(2); PG8_BAR;
    PG8_STAGE(PG8_SB(1, 0), cB + kstep, voffB); PG8_STAGE(PG8_SA(1, 0), cA + kstep, voffA); PG8_STAGE(PG8_SB(1, 1), cB + hstepB + kstep, voffB);
    PG8_WAIT_V(6); PG8_BAR;
    for (;;) {
        const bool has_next = S.next(ui + 1, nxt);
        const char* nA = has_next ? g.a_ptr(nxt) : cA; const char* nB = has_next ? g.b_ptr(nxt) : cB;
        for (int t = 0; t < nt; t += 2) {
            const bool last = (t == nt - 2);
            const char* a1 = cA + (size_t)(t + 1) * kstep;
            const char* a2 = last ? nA : cA + (size_t)(t + 2) * kstep; const char* b2 = last ? nB : cB + (size_t)(t + 2) * kstep;
            const char* a3 = a2 + kstep; const char* b3 = b2 + kstep;
            PG8_LDB(B0, 0, 0); PG8_LDB(B1, 0, 1); PG8_SCHED; PG8_LDA(At, 0, 0); PG8_STAGE(PG8_SA(1, 1), a1 + hstepA, voffA);
            PG8_WAIT_V(8); PG8_WAIT_L(0); PG8_BAR; PG8_MMA(0, 0, At, B0); PG8_MMA(0, 1, At, B1); PG8_BAR; PG8_SCHED;
            PG8_LDA(At, 0, 1); PG8_STAGE(PG8_SB(0, 0), b2, voffB); PG8_STAGE(PG8_SB(0, 1), b2 + hstepB, voffB); PG8_STAGE(PG8_SA(0, 0), a2, voffA);
            PG8_WAIT_V(8); PG8_WAIT_L(0); PG8_BAR; PG8_MMA(1, 0, At, B0); PG8_MMA(1, 1, At, B1); PG8_BAR; PG8_SCHED;
            PG8_LDB(B0, 1, 0); PG8_LDB(B1, 1, 1); PG8_SCHED; PG8_LDA(At, 1, 0); PG8_STAGE(PG8_SA(0, 1), a2 + hstepA, voffA);
            PG8_WAIT_V(8); PG8_WAIT_L(0); PG8_BAR; PG8_MMA(0, 0, At, B0); PG8_MMA(0, 1, At, B1); PG8_BAR; PG8_SCHED;
            PG8_LDA(At, 1, 1); PG8_STAGE(PG8_SB(1, 0), b3, voffB); PG8_STAGE(PG8_SB(1, 1), b3 + hstepB, voffB); PG8_STAGE(PG8_SA(1, 0), a3, voffA);
            PG8_WAIT_V(8); PG8_WAIT_L(0); PG8_BAR; PG8_MMA(1, 0, At, B0); PG8_MMA(1, 1, At, B1); PG8_BAR; PG8_SCHED;
        }
        if constexpr (ALIGN_EPI) { if (wr == 0) PG8_BAR; }
        { Unit eu = cur; asm volatile("" : "+s"(eu.pm), "+s"(eu.pn));
          E(acc, eu, wr, wc, fr, fq); }
        if (!has_next) break;
#pragma unroll
        for (int a = 0; a < 2; ++a)
#pragma unroll
            for (int b = 0; b < 2; ++b)
#pragma unroll
                for (int m = 0; m < 4; ++m)
#pragma unroll
                    for (int n = 0; n < 2; ++n) acc[a][b][m][n] = (f32x4){0.f, 0.f, 0.f, 0.f};
        cur = nxt; cA = nA; cB = nB; ++ui;
        if constexpr (ALIGN_EPI) { if (wr == 1) PG8_BAR; }
    }
    PG8_WAIT_V(0);
    if constexpr (!ALIGN_EPI) { if (wr == 0) PG8_BAR; }
    PG8_BAR;
#undef PG8_SA
#undef PG8_SB
#undef PG8_STAGE
#undef PG8_LDA
#undef PG8_LDB
#undef PG8_MMA
#undef PG8_WAIT_V
#undef PG8_WAIT_L
#undef PG8_BAR
#undef PG8_SCHED
}

template <int NPAN, class Epi>
__device__ __forceinline__ void gemm_naive(LAS unsigned char* lds8, const Gemm g, const Epi& E, int nblk, int bid, const int tid) {
    LAS float* As = (LAS float*)lds8; LAS float* Bs = As + 64 * 33;
    const int ty = tid >> 4, tx = tid & 15;
    const int ntm = g.nM * 4, ntn = (NPAN == 2) ? g.nN * 2 : g.nN * 4;
    for (int tile = bid; tile < ntm * ntn; tile += nblk) {
        const int tm = tile / ntn, tn = tile % ntn;
        Unit u; u.pm = tm >> 2; u.pn = (NPAN == 2) ? (tn >> 1) : (tn >> 2);
        const bf16_t* Ab = (const bf16_t*)g.a_ptr(u) + (size_t)(tm & 3) * 64 * g.lda;
        const bf16_t* Bb = (const bf16_t*)g.b_ptr(u) + (size_t)((NPAN == 2) ? (tn & 1) * 64 : (tn & 3) * 64) * g.ldb;
        float acc[NPAN][2][4];
#pragma unroll
        for (int p = 0; p < NPAN; ++p)
#pragma unroll
            for (int r = 0; r < 2; ++r)
#pragma unroll
                for (int i = 0; i < 4; ++i) acc[p][r][i] = 0.f;
        const int lr = tid >> 3, lk = (tid & 7) * 4;
        for (int k0 = 0; k0 < g.K; k0 += 32) {
            { const u32x2 v = *(const u32x2*)(Ab + (size_t)lr * g.lda + k0 + lk);
              As[lr * 33 + lk] = __uint_as_float(v.x << 16); As[lr * 33 + lk + 1] = __uint_as_float(v.x & 0xffff0000u); As[lr * 33 + lk + 2] = __uint_as_float(v.y << 16); As[lr * 33 + lk + 3] = __uint_as_float(v.y & 0xffff0000u); }
#pragma unroll
            for (int p = 0; p < NPAN; ++p) { const u32x2 v = *(const u32x2*)(Bb + (size_t)(lr + p * 128) * g.ldb + k0 + lk); LAS float* B_ = Bs + p * 64 * 33;
              B_[lr * 33 + lk] = __uint_as_float(v.x << 16); B_[lr * 33 + lk + 1] = __uint_as_float(v.x & 0xffff0000u); B_[lr * 33 + lk + 2] = __uint_as_float(v.y << 16); B_[lr * 33 + lk + 3] = __uint_as_float(v.y & 0xffff0000u); }
            __syncthreads();
            for (int kk = 0; kk < 32; ++kk) { const float a0 = As[ty * 33 + kk], a1 = As[(ty + 32) * 33 + kk];
#pragma unroll
                for (int p = 0; p < NPAN; ++p)
#pragma unroll
                    for (int i = 0; i < 4; ++i) { const float b = Bs[p * 64 * 33 + (tx + 16 * i) * 33 + kk]; acc[p][0][i] += a0 * b; acc[p][1][i] += a1 * b; } }
            __syncthreads();
        }
#pragma unroll
        for (int r = 0; r < 2; ++r)
#pragma unroll
            for (int i = 0; i < 4; ++i) { const int row = tm * 64 + ty + 32 * r, col = tn * 64 + tx + 16 * i;
                E.elem(row, col, acc[0][r][i], NPAN == 2 ? acc[NPAN - 1][r][i] : 0.f); }
    }
}
}

#define XB_TMO      128
#define XB_XCNT(j)  (256  + 64 * (j))
#define XB_XSUB(j)  (1280 + 64 * (j))
#define XB_XGEN(j)  (2304 + 64 * (j))
#define XB_TOP      3328
#define XB_TOPGEN   3392
#define XCD_BAR_WORDS 3456
#define XB_SPIN_CAP (1u << 18)
__device__ __forceinline__ unsigned xb_ld(unsigned* p)              { return __hip_atomic_load(p, __ATOMIC_RELAXED, __HIP_MEMORY_SCOPE_AGENT); }
__device__ __forceinline__ unsigned xb_add(unsigned* p, unsigned v) { return __hip_atomic_fetch_add(p, v, __ATOMIC_RELAXED, __HIP_MEMORY_SCOPE_AGENT); }
__device__ __forceinline__ unsigned xb_xcc_id() { return (unsigned)__builtin_amdgcn_s_getreg((3 << 11) | 20) & 0xFu; }
#define XB_SPIN(cond, bar) do { unsigned _sp = 0; while (cond) { __builtin_amdgcn_s_sleep(1); \
    if ((++_sp & 255u) == 0u) { if (xb_ld(&(bar)[XB_TMO])) break; if (_sp > XB_SPIN_CAP) { atomicAdd(&(bar)[XB_TMO], 1u); break; } } } } while (0)
struct XcdBarrier { unsigned* bar; unsigned x; volatile LAS unsigned* st; };
__device__ __forceinline__ XcdBarrier xcd_barrier_post(unsigned* bar, volatile LAS unsigned* st) {
    XcdBarrier b; b.bar = bar; b.x = xb_xcc_id(); b.st = st;
    if (threadIdx.x == 0) (void)xb_add(&bar[XB_XCNT(b.x)], 1u);
    return b;
}
__device__ __forceinline__ void xcd_barrier_complete(unsigned* bar, unsigned x, unsigned& nloc, unsigned& nx) {
    const unsigned G = gridDim.x * gridDim.y * gridDim.z;
    unsigned sum, cnt, mine, sp = 0u;
    for (;;) {
        sum = 0u; cnt = 0u; mine = 0u;
#pragma unroll
        for (unsigned j = 0; j < 16; ++j) { const unsigned c = xb_ld(&bar[XB_XCNT(j)]); sum += c; cnt += (c > 0u) ? 1u : 0u; mine = (j == x) ? c : mine; }
        if (sum == G) break;
        __builtin_amdgcn_s_sleep(1);
        if ((++sp & 255u) == 0u) { if (xb_ld(&bar[XB_TMO])) break; if (sp > XB_SPIN_CAP) { atomicAdd(&bar[XB_TMO], 1u); break; } }
    }
    nloc = mine > 0u ? mine : 1u; nx = cnt > 0u ? cnt : 1u;
}
__device__ __forceinline__ void xcd_barrier(const XcdBarrier& b) {
    asm volatile("s_waitcnt vmcnt(0)" ::: "memory");
    __syncthreads();
    if (threadIdx.x == 0) {
        unsigned* bar = b.bar;
        __builtin_amdgcn_s_waitcnt(0);
        unsigned nloc = b.st[0], nx = b.st[1];
        if (nloc == 0u) { xcd_barrier_complete(bar, b.x, nloc, nx); b.st[0] = nloc; b.st[1] = nx; }
        const unsigned old = xb_add(&bar[XB_XSUB(b.x)], 1u);
        const unsigned gen = old / nloc;
        if (old + 1u == (gen + 1u) * nloc) {
            __builtin_amdgcn_fence(__ATOMIC_RELEASE, "agent");
            asm volatile("s_waitcnt vmcnt(0)" ::: "memory");
            const unsigned og = xb_add(&bar[XB_TOP], 1u);
            const unsigned tg = og / nx;
            if (og + 1u == (tg + 1u) * nx) xb_add(&bar[XB_TOPGEN], 1u);
            else XB_SPIN(xb_ld(&bar[XB_TOPGEN]) == tg, bar);
            __builtin_amdgcn_fence(__ATOMIC_ACQUIRE, "agent");
            xb_add(&bar[XB_XGEN(b.x)], 1u);
            asm volatile("s_waitcnt vmcnt(0)" ::: "memory");
        } else {
            XB_SPIN(xb_ld(&bar[XB_XGEN(b.x)]) == gen, bar);
            __builtin_amdgcn_fence(__ATOMIC_ACQUIRE, "agent");
            asm volatile("s_waitcnt vmcnt(0)" ::: "memory");
        }
    }
    __syncthreads();
}

namespace dsa {
using bf16=__hip_bfloat16;
using bf16x8=__attribute__((ext_vector_type(8)))short;
using s16x4=__attribute__((ext_vector_type(4)))short;
using f32x16=__attribute__((ext_vector_type(16)))float;
using u32x4=__attribute__((ext_vector_type(4)))unsigned;
using u32x2=__attribute__((ext_vector_type(2)))unsigned;
constexpr int BATCH=4,NHEAD=8,SEQ=4096,D=64,QP=2560,KP=1024,OP=1024;
constexpr int NW=8,QBLK=32,QB=QBLK*NW,KVBLK=64,NQB=SEQ/QB;
__device__ __forceinline__ int crow(int r,int hi){return (r&3)+8*(r>>2)+4*hi;}
#define SBAR() __builtin_amdgcn_sched_barrier(0)
__device__ __forceinline__ void bmask(f32x16&p0,f32x16&p1,unsigned w0,unsigned w1,int hi){
  const int s0=(int)(w0>>(4*hi)), s1=(int)(w1>>(4*hi));
  #pragma unroll
  for(int r=0;r<16;++r){const unsigned pos=(r&3)+8*(r>>2);
    const unsigned m0=(unsigned)__builtin_amdgcn_sbfe(s0,pos,1u), m1=(unsigned)__builtin_amdgcn_sbfe(s1,pos,1u);
    p0[r]=__uint_as_float((__float_as_uint(p0[r])&m0)|(~m0&0xff800000u)); p1[r]=__uint_as_float((__float_as_uint(p1[r])&m1)|(~m1&0xff800000u));}
}

constexpr int NSLOT=3, SLOTB=8192;
constexpr int LDS_K=0, LDS_V=NSLOT*SLOTB, LDS_WS=2*NSLOT*SLOTB, LDS_OST=LDS_WS+NW*64*4, LDS_BYTES=LDS_OST+NW*4096;
constexpr float C2=0.125f*1.4426950408889634f;
__device__ __forceinline__ void glds16(const void*gsrc,unsigned lds_dst){unsigned keep;
  asm volatile("s_mov_b32 %0, m0\n\ts_mov_b32 m0, %2\n\ts_nop 0\n\tglobal_load_lds_dwordx4 %1, off\n\ts_mov_b32 m0, %0":"=&s"(keep):"v"(gsrc),"s"(lds_dst):"memory");}
__device__ __forceinline__ float max3f(float a,float b,float c){float r;asm("v_max3_f32 %0, %1, %2, %3":"=v"(r):"v"(a),"v"(b),"v"(c));return r;}
__device__ __forceinline__ float max2f(float a,float b){float r;asm("v_max_f32_e32 %0, %1, %2":"=v"(r):"v"(a),"v"(b));return r;}
__device__ __forceinline__ float fadd_s(float a,float b){float r;asm("v_add_f32_e32 %0, %1, %2":"=v"(r):"v"(a),"v"(b));return r;}
__device__ __forceinline__ float fsub_s(float a,float b){float r;asm("v_sub_f32_e32 %0, %1, %2":"=v"(r):"v"(a),"v"(b));return r;}
typedef float f32x2_t __attribute__((ext_vector_type(2))); typedef __bf16 bf16x2_t __attribute__((ext_vector_type(2)));
__device__ __forceinline__ unsigned cvtpk_s(float lo,float hi){f32x2_t v={lo,hi};bf16x2_t b=__builtin_convertvector(v,bf16x2_t);return __builtin_bit_cast(unsigned,b);}
#define WAIT_BAR(N) asm volatile("s_waitcnt vmcnt(" #N ") lgkmcnt(0)\n\ts_barrier":::"memory")
#define WAIT_BAR_M(N,M) asm volatile("s_waitcnt vmcnt(" #N ") lgkmcnt(0)\n\ts_barrier":"+v"(M)::"memory")

__device__ __forceinline__ void qkt(f32x16&p0,f32x16&p1,const char*Kslot,const bf16x8*qr,int r32,int hi){
  const char*kb=Kslot+hi*1024+r32*16;
  #pragma unroll
  for(int d0=0;d0<4;++d0){
    const bf16x8 b0=*reinterpret_cast<const bf16x8*>(kb+d0*2048);
    const bf16x8 b1=*reinterpret_cast<const bf16x8*>(kb+d0*2048+512);
    if(d0==0){p0=__builtin_amdgcn_mfma_f32_32x32x16_bf16(b0,qr[0],f32x16{},0,0,0);p1=__builtin_amdgcn_mfma_f32_32x32x16_bf16(b1,qr[0],f32x16{},0,0,0);}
    else{p0=__builtin_amdgcn_mfma_f32_32x32x16_bf16(b0,qr[d0],p0,0,0,0);p1=__builtin_amdgcn_mfma_f32_32x32x16_bf16(b1,qr[d0],p1,0,0,0);}}
}
typedef __attribute__((address_space(3))) const char* lds_cptr;
typedef short v4i16_t __attribute__((ext_vector_type(4)));
__device__ __forceinline__ void kload8(bf16x8*kf,lds_cptr kp){
  kf[0]=*(const __attribute__((address_space(3))) bf16x8*)(kp);      kf[1]=*(const __attribute__((address_space(3))) bf16x8*)(kp+512);
  kf[2]=*(const __attribute__((address_space(3))) bf16x8*)(kp+2048); kf[3]=*(const __attribute__((address_space(3))) bf16x8*)(kp+2560);
  kf[4]=*(const __attribute__((address_space(3))) bf16x8*)(kp+4096); kf[5]=*(const __attribute__((address_space(3))) bf16x8*)(kp+4608);
  kf[6]=*(const __attribute__((address_space(3))) bf16x8*)(kp+6144); kf[7]=*(const __attribute__((address_space(3))) bf16x8*)(kp+6656);
}
__device__ __forceinline__ void kload2(bf16x8*kf,lds_cptr kp,int j){ kf[2*j]=*(const __attribute__((address_space(3))) bf16x8*)(kp+j*2048); kf[2*j+1]=*(const __attribute__((address_space(3))) bf16x8*)(kp+j*2048+512); }
__device__ __forceinline__ s16x4 vtr(lds_cptr p){ return __builtin_bit_cast(s16x4,__builtin_amdgcn_ds_read_tr16_b64_v4i16((__attribute__((address_space(3))) v4i16_t*)p)); }
__device__ __forceinline__ float rowmax(const f32x16&p0,const f32x16&p1){
  float a=max3f(p0[0],p0[1],p1[0]),b=max3f(p0[2],p0[3],p1[1]);a=max3f(a,p1[2],p1[3]);
  #pragma unroll
  for(int r=4;r<16;r+=4){a=max3f(a,p0[r],p0[r+1]);b=max3f(b,p0[r+2],p0[r+3]);a=max3f(a,p1[r],p1[r+1]);b=max3f(b,p1[r+2],p1[r+3]);}
  const float m=max2f(a,b);
  auto rr=__builtin_amdgcn_permlane32_swap(__float_as_uint(m),__float_as_uint(m),false,false);
  return max2f(__uint_as_float(rr[0]),__uint_as_float(rr[1]));
}
__device__ __forceinline__ void pv(f32x16*o,int vb,bf16x8 pa0,bf16x8 pa1,bf16x8 pa2,bf16x8 pa3){
  #pragma unroll
  for(int d0=0;d0<2;++d0){s16x4 lo[4],hi[4];
    #pragma unroll
    for(int ks=0;ks<4;++ks){
      asm volatile("ds_read_b64_tr_b16 %0,%1 offset:%c2":"=&v"(lo[ks]):"v"(vb),"i"(d0*4096+ks*1024):"memory");
      asm volatile("ds_read_b64_tr_b16 %0,%1 offset:%c2":"=&v"(hi[ks]):"v"(vb),"i"(d0*4096+ks*1024+512):"memory");}
    asm volatile("s_waitcnt lgkmcnt(0)":::"memory");SBAR();
    #define PK(k) (bf16x8){lo[k][0],lo[k][1],lo[k][2],lo[k][3],hi[k][0],hi[k][1],hi[k][2],hi[k][3]}
    o[d0]=__builtin_amdgcn_mfma_f32_32x32x16_bf16(pa0,PK(0),o[d0],0,0,0);
    o[d0]=__builtin_amdgcn_mfma_f32_32x32x16_bf16(pa1,PK(1),o[d0],0,0,0);
    o[d0]=__builtin_amdgcn_mfma_f32_32x32x16_bf16(pa2,PK(2),o[d0],0,0,0);
    o[d0]=__builtin_amdgcn_mfma_f32_32x32x16_bf16(pa3,PK(3),o[d0],0,0,0);
    #undef PK
  }
}

#ifndef ATTN_STORE16
#define ATTN_STORE16(p,v) (*(u32x4*)(p)=(v))
#endif
template<int THRL> __device__ __forceinline__ void attn_unit(const int tid,int b,int h,int qb,const bf16*Q,const bf16*__restrict__ K,const bf16*__restrict__ V,bf16*O,const u32x2*__restrict__ MT,char*shm){
  const int lane=tid&63,r32=lane&31,hi=lane>>5; const int wid=__builtin_amdgcn_readfirstlane(tid>>6);
  const long rowbase=(long)b*SEQ; const int q0=qb*QB;
  const bf16*Qw=Q+(rowbase+q0+wid*QBLK)*QP+h*D;
  const bf16*Kh=K+rowbase*KP+h*D,*Vh=V+rowbase*KP+h*D;
  const unsigned lds0=(unsigned)(uintptr_t)shm;
  float*wsf=(float*)(shm+LDS_WS)+wid*64;
  const bf16*ksrc=Kh+(long)lane*KP+wid*8;
  const bf16*vsrc=Vh+(long)(16*(wid&3)+(lane>>2))*KP+(wid>>2)*32+(lane&3)*8;
  const unsigned kdst=lds0+LDS_K+wid*1024, vdst=lds0+LDS_V+wid*1024;
  #define DMA_K(t,slot) glds16(ksrc+(long)(t)*KVBLK*KP,(unsigned)__builtin_amdgcn_readfirstlane(kdst+(slot)))
  #define DMA_V(t,slot) glds16(vsrc+(long)(t)*KVBLK*KP,(unsigned)__builtin_amdgcn_readfirstlane(vdst+(slot)))
  const int vb0=(int)(lds0+LDS_V)+((lane>>4)&1)*32+(lane&3)*8+(4*hi+((lane&15)>>2))*64;
  const char*Kbase=shm+LDS_K; bf16x8 kf[8];
  const lds_cptr shm3=(lds_cptr)shm; const lds_cptr kp0=shm3+LDS_K+hi*1024+r32*16; const lds_cptr vp0=shm3+LDS_V+((lane>>4)&1)*32+(lane&3)*8+(4*hi+((lane&15)>>2))*64;
  const int NT=(q0+QB)/KVBLK;
  const u32x2*mq=MT+(long)b*64*SEQ+q0+wid*QBLK+r32;
  u32x2 mA=mq[0],mB=mq[SEQ]; asm volatile("s_waitcnt vmcnt(0)":"+v"(mA),"+v"(mB)::"memory");
  #define MLD(M,t) asm volatile("global_load_dwordx2 %0, %1, off":"=v"(M):"v"(mq+(long)(t)*SEQ):"memory")
  DMA_K(0,0);DMA_V(0,0);DMA_K(1,SLOTB);
  bf16x8 qr[4];
  #pragma unroll
  for(int d0=0;d0<4;++d0)qr[d0]=*reinterpret_cast<const bf16x8*>(&Qw[(long)r32*QP+d0*16+hi*8]);
  float mhat=0.f,l_reg=0.f;f32x16 o[2];o[0]=f32x16{};o[1]=f32x16{};
  const int qrel=wid*QBLK+r32;
  #define CMASK(P0,P1,M) bmask(P0,P1,M.x,M.y,hi)
  bool resc=false;
  #define START(P0,P1) do{ const float rm=rowmax(P0,P1); resc=false; \
    { const float dl=__builtin_fmaxf(rm,-64.f); mhat=fadd_s(mhat,dl); \
      _Pragma("unroll") for(int r=0;r<16;++r){P0[r]=fsub_s(P0[r],dl);P1[r]=fsub_s(P1[r],dl);} } \
    _Pragma("unroll") for(int r=0;r<16;++r)P0[r]=__builtin_amdgcn_exp2f(P0[r]); }while(0)
  #define RESC() do{ if(resc){ asm volatile("s_waitcnt lgkmcnt(0)":::"memory"); \
      _Pragma("unroll") for(int d_=0;d_<2;++d_) _Pragma("unroll") for(int r=0;r<16;++r)o[d_][r]*=wsf[crow(r,hi)]; } }while(0)
  f32x16 pA0,pA1,pB0,pB1;
  int sl_prev=0,sl_cur=0,sl_next=SLOTB;
  #define ROT() do{sl_prev=sl_cur;sl_cur=sl_next;sl_next=(sl_next==(NSLOT-1)*SLOTB)?0:sl_next+SLOTB;}while(0)
  DMA_K(2,2*SLOTB);
  WAIT_BAR(3);
  qkt(pA0,pA1,Kbase,qr,r32,hi);asm volatile("s_nop 15\n\ts_nop 7":"+v"(pA0),"+v"(pA1));CMASK(pA0,pA1,mA);
  START(pA0,pA1);
  _Pragma("unroll") for(int r=0;r<16;++r)pA1[r]=__builtin_amdgcn_exp2f(pA1[r]);
  WAIT_BAR(0);
  DMA_K(3,0);DMA_V(1,SLOTB);
  ROT();
  kload8(kf,kp0+sl_cur);
  WAIT_BAR(2);
  s16x4 vl0,vh0,vl1,vh1,vl2,vh2; u32x4 pw0,pw1,pw2,pw3;
  #define PKW(P,B) cvtpk_s(P[B],P[B+1])
  #define PAF(k) __builtin_bit_cast(bf16x8,pw##k)
  #define VFRB(b) (bf16x8){vl##b[0],vl##b[1],vl##b[2],vl##b[3],vh##b[0],vh##b[1],vh##b[2],vh##b[3]}
  #define PIN(x) asm volatile("":"+v"(x))
  #define MX3(a,b,c) __builtin_fmaxf(__builtin_fmaxf((a),(b)),(c))
  #define GAPA(MF,A0,A1,A2,A3,W0,W1,PW) do{ MF; sacc+=A0; sacc+=A1; sacc+=A2; sacc+=A3; PIN(sacc); W0; W1; PIN(PW); SBAR(); }while(0)
  #define EX(v) __builtin_amdgcn_exp2f(v)
  #define GAPB(MF,X,B) do{ MF; X[B]=EX(X[B]); X[B+1]=EX(X[B+1]); X[B+2]=EX(X[B+2]); X[B+3]=EX(X[B+3]); PIN(X); SBAR(); }while(0)
  #define VRDB(b,i) do{ vl##b=vtr(vp_+(((i)>>2)*4096+((i)&3)*1024)); vh##b=vtr(vp_+(((i)>>2)*4096+((i)&3)*1024+512)); SBAR(); }while(0)
  #define KRD(G,j) do{ if(G){ kload2(kf,kp0+sl_next,j); SBAR(); } }while(0)
  #define STEP(C0,C1,P0,P1,t,GK,GV,GL,MC,MN) do{ SBAR(); if(GV){MLD(MN,(t)+1);} SBAR(); \
    const lds_cptr vp_=vp0+sl_prev; \
    float sacc=(P0[0]+P0[1]); \
    GAPA(C0=__builtin_amdgcn_mfma_f32_32x32x16_bf16(kf[0],qr[0],f32x16{},0,0,0), P0[2],P0[3],P0[4],P0[5],     pw0[0]=PKW(P0,0), pw0[1]=PKW(P0,2), pw0); \
    GAPA(C1=__builtin_amdgcn_mfma_f32_32x32x16_bf16(kf[1],qr[0],f32x16{},0,0,0), P0[6],P0[7],P0[8],P0[9],     pw0[2]=PKW(P0,4), pw0[3]=PKW(P0,6), pw0); \
    GAPA(C0=__builtin_amdgcn_mfma_f32_32x32x16_bf16(kf[2],qr[1],C0,0,0,0),   P0[10],P0[11],P0[12],P0[13], pw1[0]=PKW(P0,8), pw1[1]=PKW(P0,10), pw1); \
    GAPA(C1=__builtin_amdgcn_mfma_f32_32x32x16_bf16(kf[3],qr[1],C1,0,0,0),   P0[14],P0[15],P1[0],P1[1],   pw1[2]=PKW(P0,12),pw1[3]=PKW(P0,14), pw1); \
    KRD(GL,0); \
    GAPA(C0=__builtin_amdgcn_mfma_f32_32x32x16_bf16(kf[4],qr[2],C0,0,0,0),   P1[2],P1[3],P1[4],P1[5],     pw2[0]=PKW(P1,0), pw2[1]=PKW(P1,2), pw2); \
    GAPA(C1=__builtin_amdgcn_mfma_f32_32x32x16_bf16(kf[5],qr[2],C1,0,0,0),   P1[6],P1[7],P1[8],P1[9],     pw2[2]=PKW(P1,4), pw2[3]=PKW(P1,6), pw2); \
    KRD(GL,1); \
    GAPA(C0=__builtin_amdgcn_mfma_f32_32x32x16_bf16(kf[6],qr[3],C0,0,0,0),   P1[10],P1[11],P1[12],P1[13], pw3[0]=PKW(P1,8), pw3[1]=PKW(P1,10), pw3); \
    GAPA(C1=__builtin_amdgcn_mfma_f32_32x32x16_bf16(kf[7],qr[3],C1,0,0,0),   P1[14],P1[15],0.f,0.f,       pw3[2]=PKW(P1,12),pw3[3]=PKW(P1,14), pw3); \
    KRD(GL,2); KRD(GL,3); \
    l_reg+=sacc; \
    if(GK){DMA_K((t)+3,sl_cur);} if(GV){DMA_V((t)+1,sl_next);} \
    VRDB(0,0); VRDB(1,4); \
    CMASK(C0,C1,MC); \
    { float a=MX3(C0[0],C0[1],C1[0]),b=MX3(C0[2],C0[3],C1[1]); a=MX3(a,C1[2],C1[3]); \
      _Pragma("unroll") for(int r=4;r<16;r+=4){a=MX3(a,C0[r],C0[r+1]);b=MX3(b,C0[r+2],C0[r+3]);a=MX3(a,C1[r],C1[r+1]);b=MX3(b,C1[r+2],C1[r+3]);} \
      float rm=__builtin_fmaxf(a,b); { auto rr=__builtin_amdgcn_permlane32_swap(__float_as_uint(rm),__float_as_uint(rm),false,false); rm=__builtin_fmaxf(__uint_as_float(rr[0]),__uint_as_float(rr[1])); } \
      rm-=mhat; resc=false;     \
      if(__builtin_expect(__any(rm>(float)THRL),0)){ const float dl=__builtin_fmaxf(rm,0.f); mhat+=dl; \
        const float f=__builtin_amdgcn_exp2f(-dl); l_reg*=f; if(hi==0)wsf[r32]=f; resc=true; } \
      _Pragma("unroll") for(int r=0;r<16;++r){C0[r]-=mhat;C1[r]-=mhat;} } \
    SBAR(); \
    VRDB(2,1); GAPB(o[0]=__builtin_amdgcn_mfma_f32_32x32x16_bf16(PAF(0),VFRB(0),o[0],0,0,0), C0,0); \
    VRDB(0,5); GAPB(o[1]=__builtin_amdgcn_mfma_f32_32x32x16_bf16(PAF(0),VFRB(1),o[1],0,0,0), C0,4); \
    VRDB(1,2); GAPB(o[0]=__builtin_amdgcn_mfma_f32_32x32x16_bf16(PAF(1),VFRB(2),o[0],0,0,0), C0,8); \
    VRDB(2,6); GAPB(o[1]=__builtin_amdgcn_mfma_f32_32x32x16_bf16(PAF(1),VFRB(0),o[1],0,0,0), C0,12); \
    VRDB(0,3); GAPB(o[0]=__builtin_amdgcn_mfma_f32_32x32x16_bf16(PAF(2),VFRB(1),o[0],0,0,0), C1,0); \
    VRDB(1,7); GAPB(o[1]=__builtin_amdgcn_mfma_f32_32x32x16_bf16(PAF(2),VFRB(2),o[1],0,0,0), C1,4); \
    GAPB(o[0]=__builtin_amdgcn_mfma_f32_32x32x16_bf16(PAF(3),VFRB(0),o[0],0,0,0), C1,8); \
    GAPB(o[1]=__builtin_amdgcn_mfma_f32_32x32x16_bf16(PAF(3),VFRB(1),o[1],0,0,0), C1,12); \
    }while(0)
  int t=1;
  for(;t+5<NT;t+=2){
    STEP(pB0,pB1,pA0,pA1,t,true,true,true,mB,mA);     WAIT_BAR_M(2,mA); RESC(); ROT();
    STEP(pA0,pA1,pB0,pB1,t+1,true,true,true,mA,mB);   WAIT_BAR_M(2,mB); RESC(); ROT();
  }
  #define ENDW(tt,M) do{ if((tt)+3<NT){WAIT_BAR_M(2,M);} else if((tt)+2<NT){WAIT_BAR_M(1,M);} else {WAIT_BAR_M(0,M);} }while(0)
  for(;t+1<NT;t+=2){
    STEP(pB0,pB1,pA0,pA1,t,(t+3<NT),(t+1<NT),(t+1<NT),mB,mA);       ENDW(t,mA);   RESC(); ROT();
    STEP(pA0,pA1,pB0,pB1,t+1,(t+4<NT),(t+2<NT),(t+2<NT),mA,mB);     ENDW(t+1,mB); RESC(); ROT();
  }
  STEP(pB0,pB1,pA0,pA1,NT-1,false,false,false,mB,mA); RESC();
  { float sacc=pB0[0]+pB0[1]; _Pragma("unroll") for(int r=2;r<16;++r)sacc+=pB0[r]; _Pragma("unroll") for(int r=0;r<16;++r)sacc+=pB1[r]; l_reg+=sacc;
    pw0=(u32x4){PKW(pB0,0),PKW(pB0,2),PKW(pB0,4),PKW(pB0,6)};pw1=(u32x4){PKW(pB0,8),PKW(pB0,10),PKW(pB0,12),PKW(pB0,14)};pw2=(u32x4){PKW(pB1,0),PKW(pB1,2),PKW(pB1,4),PKW(pB1,6)};pw3=(u32x4){PKW(pB1,8),PKW(pB1,10),PKW(pB1,12),PKW(pB1,14)};
    SBAR(); pv(o,vb0+sl_cur,PAF(0),PAF(1),PAF(2),PAF(3)); }
  #undef PKW
  #undef PAF
  #undef VFRB
  #undef PIN
  #undef MX3
  #undef GAPA
  #undef GAPB
  #undef EX
  #undef VRDB
  #undef KRD
  #undef STEP
  #undef ENDW
  {auto rr=__builtin_amdgcn_permlane32_swap(__float_as_uint(l_reg),__float_as_uint(l_reg),false,false);l_reg=__uint_as_float(rr[0])+__uint_as_float(rr[1]);}
  if(hi==0)wsf[32+r32]=l_reg;asm volatile("s_waitcnt lgkmcnt(0)":::"memory");
  float rli[16];
  #pragma unroll
  for(int r=0;r<16;++r)rli[r]=__builtin_amdgcn_rcpf(wsf[32+crow(r,hi)]);
  bf16*Ow=O+(rowbase+q0+wid*QBLK)*OP+h*D;
  { bf16*stg=(bf16*)(shm+LDS_OST)+wid*2048;
    #pragma unroll
    for(int r=0;r<16;++r){const int orow=crow(r,hi);
      #pragma unroll
      for(int d0=0;d0<2;++d0)stg[orow*64+d0*32+r32]=__float2bfloat16(o[d0][r]*rli[r]);}
    asm volatile("s_waitcnt lgkmcnt(0)":::"memory");
    #pragma unroll
    for(int i=0;i<4;++i){const int row=i*8+(lane>>3),ch=lane&7; const u32x4 v=*(const u32x4*)(stg+row*64+ch*8); ATTN_STORE16(Ow+(long)row*OP+ch*8,v);} }
  asm volatile("s_waitcnt lgkmcnt(0)\n\ts_barrier":::"memory");
  #undef DMA_K
  #undef DMA_V
  #undef CMASK
  #undef MLD
  #undef START
  #undef RESC
  #undef ROT
}
constexpr int ATTN_LDS_BYTES=LDS_BYTES;
template<int THRL=8> __device__ __forceinline__ void attn_phase(const int tid,int grid,int block,const bf16*Q,const bf16*K,const bf16*V,bf16*O,const u32x2*MT,char*lds){
  for(int i=0;;++i){ const int u=i*grid+block; if(u>=BATCH*NHEAD*NQB)break; int bh,qb;
    if(grid==256){ const int vcu=(block%8)*(grid/8)+block/8, s=vcu&7; bh=vcu>>3; qb=i?15-s:s; } else { bh=u/NQB; qb=NQB-1-(u%NQB); }
    bh=__builtin_amdgcn_readfirstlane(bh); qb=__builtin_amdgcn_readfirstlane(qb);
    attn_unit<THRL>(tid,bh/NHEAD,bh%NHEAD,qb,Q,K,V,O,MT,lds); }
}
#undef SBAR
#undef WAIT_BAR
#undef WAIT_BAR_M
}
constexpr int NWAVES = 8, NTHREADS = 512;
constexpr int RING_BYTES = 131072, HIST_OFF = RING_BYTES, DESC_OFF = RING_BYTES + 8704, MISC_OFF = DESC_OFF + 6144, LDS_BYTES = 147456;
constexpr int DESC_WORDS = 32;
struct Args { const float* in[25]; float* out; unsigned char* ws; int ph_lo, ph_hi; };
struct Ctx {
    LAS unsigned char* lds; char* ldsg; int tid, lane, wave, nblk, bid;
    float* out; unsigned char* ws; const __attribute__((address_space(4))) void* kp;
};
#define inp(i) (((const float* const __attribute__((address_space(4)))*)F.kp)[i])
enum { I_X = 0, I_MEM, I_NORMS, I_WGU, I_WDN, I_XQ, I_XKV, I_XO, I_EIN, I_EKVN, I_EUK, I_EUV, I_ECW, I_ECB, I_ERA, I_EBRA, I_ERI, I_EBRI, I_ELAM, I_EOUT, I_OIN, I_OG2, I_OBG, I_OHN, I_OOUT };
enum { N_FFN1_PRE = 0, N_FFN1_POST, N_MIX_PRE, N_MIX_POST, N_XA_PRE, N_XA_POST, N_MEM_NORM, N_FFN2_PRE, N_FFN2_POST };

struct TJob { const float* W; int K, Nsrc; bf16_t* WT; int c0, nc, r0, mode; float scale; };
__device__ __forceinline__ void transpose_item(const TJob& J, int item, LAS float* scr, int lane) {
    const int nblk = (J.nc + 31) / 32, kb = item / nblk, nb = item % nblk, k0 = 64 * kb, n0 = 32 * nb;
    const int cl = n0 + (lane & 31); const bool okc = cl < J.nc;
#pragma unroll 8
    for (int i = 0; i < 32; ++i) { const int kk = 2 * i + (lane >> 5); scr[kk * 33 + (lane & 31)] = okc ? J.W[(size_t)(k0 + kk) * J.Nsrc + J.c0 + cl] * J.scale : 0.f; }
    asm volatile("s_waitcnt lgkmcnt(0)" ::: "memory");
    const int c = lane & 7;
#pragma unroll
    for (int j = 0; j < 4; ++j) { const int n = (lane >> 3) + 8 * j; const LAS float* s = scr + (8 * c) * 33 + n;
        u32x4 o; o.x = pk2(s[0 * 33], s[1 * 33]); o.y = pk2(s[2 * 33], s[3 * 33]); o.z = pk2(s[4 * 33], s[5 * 33]); o.w = pk2(s[6 * 33], s[7 * 33]);
        const int cc = n0 + n;
        if (cc < J.nc) { int row; if (J.mode == 0) row = J.r0 + cc; else { const int cg = J.c0 + cc, bj = cg / FF, jj = cg % FF; row = 256 * (jj / 128) + 128 * bj + (jj % 128); }
            *(u32x4*)(J.WT + (size_t)row * J.K + k0 + 8 * c) = o; } }
    asm volatile("s_waitcnt lgkmcnt(0)" ::: "memory");
}
constexpr int NJOBS = 4 + 4 + 6 + 7 + 2 + 1 + 5 + 1;
__device__ __forceinline__ TJob get_job(const Ctx& F, int j) {
    TJob J; J.mode = 0; J.scale = 1.f; J.c0 = 0; J.r0 = 0;
    bf16_t* Wb = (bf16_t*)(F.ws + WS_W);
    if (j < 4) { J.W = inp(I_WGU) + (size_t)j * D * 2 * FF; J.K = D; J.Nsrc = 2 * FF; J.nc = 2 * FF; J.WT = (bf16_t*)((unsigned char*)Wb + W_GU) + (size_t)j * 2 * FF * D; J.mode = 1; return J; }
    j -= 4;
    if (j < 4) { J.W = inp(I_WDN) + (size_t)j * FF * D; J.K = FF; J.Nsrc = D; J.nc = D; J.WT = (bf16_t*)((unsigned char*)Wb + W_DN) + (size_t)j * D * FF; return J; }
    j -= 4;
    if (j < 6) { const int l = j & 1, w = j >> 1;
        if (w == 0) { J.W = inp(I_XQ) + (size_t)l * D * D; J.K = D; J.Nsrc = D; J.nc = D; J.WT = (bf16_t*)((unsigned char*)Wb + W_Q) + (size_t)l * D * D; }
        else if (w == 1) { J.W = inp(I_XKV) + (size_t)l * D * 2 * D; J.K = D; J.Nsrc = 2 * D; J.nc = 2 * D; J.WT = (bf16_t*)((unsigned char*)Wb + W_KV) + (size_t)l * 2 * D * D; }
        else { J.W = inp(I_XO) + (size_t)l * D * D; J.K = D; J.Nsrc = D; J.nc = D; J.WT = (bf16_t*)((unsigned char*)Wb + W_O) + (size_t)l * D * D; }
        return J; }
    j -= 6;
    if (j < 7) { J.W = inp(I_EIN); J.K = D; J.Nsrc = 2376; J.WT = (bf16_t*)((unsigned char*)Wb + W_EIN);
        switch (j) { case 0: J.c0 = 0; J.nc = 512; J.r0 = YQ; J.scale = C2; break; case 1: J.c0 = 512; J.nc = 256; J.r0 = YCKV; break; case 2: J.c0 = 768; J.nc = 512; J.r0 = YQI; break;
                     case 3: J.c0 = 1280; J.nc = 64; J.r0 = YKI; break; case 4: J.c0 = 1344; J.nc = 8; J.r0 = YWI; break; case 5: J.c0 = 1352; J.nc = 512; J.r0 = YGATE; break; default: J.c0 = 1864; J.nc = 512; J.r0 = YXB; break; }
        return J; }
    j -= 7;
    if (j < 2) { J.W = (j == 0) ? inp(I_EUK) : inp(I_EUV); J.K = 256; J.Nsrc = 512; J.nc = 512; J.WT = (bf16_t*)((unsigned char*)Wb + W_UKV); J.r0 = 512 * j; return J; }
    j -= 2;
    if (j < 1) { J.W = inp(I_EOUT); J.K = D; J.Nsrc = D; J.nc = D; J.WT = (bf16_t*)((unsigned char*)Wb + W_EOUT); return J; }
    j -= 1;
    if (j < 5) { J.W = inp(I_OIN); J.K = D; J.Nsrc = 3088; J.WT = (bf16_t*)((unsigned char*)Wb + W_OIN);
        switch (j) { case 0: J.c0 = 0; J.nc = 512; J.r0 = ZQ; break; case 1: J.c0 = 512; J.nc = 512; J.r0 = ZK; break; case 2: J.c0 = 1024; J.nc = 1024; J.r0 = ZV; break;
                     case 3: J.c0 = 2048; J.nc = 16; J.r0 = ZG; break; default: J.c0 = 2064; J.nc = 1024; J.r0 = ZR; break; }
        return J; }
    J.W = inp(I_OOUT); J.K = D; J.Nsrc = D; J.nc = D; J.WT = (bf16_t*)((unsigned char*)Wb + W_OOUT); return J;
}
__device__ __forceinline__ void rms_row_to_bf16(const float* xrow, const float* gain, bf16_t* orow, int lane) {
    const f32x4* xr = (const f32x4*)xrow + lane; f32x4 v[4]; float s = 0.f;
#pragma unroll
    for (int j = 0; j < 4; ++j) { v[j] = xr[64 * j]; s += (v[j].x * v[j].x + v[j].y * v[j].y) + (v[j].z * v[j].z + v[j].w * v[j].w); }
    const float rstd = 1.0f / sqrtf(wave_sum(s) * (1.f / D) + EPS);
    u32x2* o8 = (u32x2*)orow + lane;
#pragma unroll
    for (int j = 0; j < 4; ++j) { const f32x4 gg = ((const f32x4*)gain)[lane + 64 * j]; u32x2 w; w.x = pk2(v[j].x * rstd * gg.x, v[j].y * rstd * gg.y); w.y = pk2(v[j].z * rstd * gg.z, v[j].w * rstd * gg.w); o8[64 * j] = w; }
}
__device__ __forceinline__ void phase_prep(const Ctx& F) {
    LAS float* scr = (LAS float*)(F.lds + F.wave * 16384);
    const int gw = F.bid * NWAVES + F.wave, NGW = F.nblk * NWAVES;
    int total = 0;
    for (int j = 0; j < NJOBS; ++j) { const TJob J = get_job(F, j); total += (J.K / 64) * ((J.nc + 31) / 32); }
    for (int it = gw; it < total; it += NGW) {
        int r = it, j = 0; TJob J = get_job(F, 0);
        for (;;) { const int n = (J.K / 64) * ((J.nc + 31) / 32); if (r < n) break; r -= n; ++j; J = get_job(F, j); }
        transpose_item(J, r, scr, F.lane);
    }
    { bf16_t* We = (bf16_t*)(F.ws + WS_W + W_EIN) + (size_t)1352 * D; bf16_t* Wo = (bf16_t*)(F.ws + WS_W + W_OIN) + (size_t)2064 * D;
      const int ne = 184 * D / 8, no = 240 * D / 8; const int gt = F.bid * NTHREADS + F.tid, NGT = F.nblk * NTHREADS;
      for (int i = gt; i < ne + no; i += NGT) { unsigned zz = 0u; asm volatile("" : "+v"(zz)); u32x4 z = {zz, zz, zz, zz}; if (i < ne) ((u32x4*)We)[i] = z; else ((u32x4*)Wo)[i - ne] = z; } }
    for (int m = gw; m < 2 * 1024 + T; m += NGW) {
        if (m < 2048) { const int l = m >> 10, r = m & 1023; rms_row_to_bf16(inp(I_MEM) + (size_t)r * D, inp(I_NORMS) + (size_t)(l * 9 + N_MEM_NORM) * D, (bf16_t*)(F.ws + (l ? WS_MEMN1 : WS_MEMN0)) + (size_t)r * D, F.lane); }
        else { const int r = m - 2048; rms_row_to_bf16(inp(I_X) + (size_t)r * D, inp(I_NORMS) + (size_t)N_FFN1_PRE * D, (bf16_t*)(F.ws + WS_A) + (size_t)r * D, F.lane); }
    }
}

__device__ __forceinline__ void phase_norm(const Ctx& F, const bf16_t* Fb, const float* hin, float* hout, float coef, const float* gpost, const float* gpre, bf16_t* Aout) {
    const int gw = F.bid * NWAVES + F.wave, NGW = F.nblk * NWAVES, lane = F.lane;
    for (int m = gw; m < T; m += NGW) {
        const u32x2* fr = (const u32x2*)(Fb + (size_t)m * D) + lane; f32x4 f[4]; float s = 0.f;
#pragma unroll
        for (int j = 0; j < 4; ++j) { const u32x2 w = fr[64 * j]; f[j].x = __uint_as_float(w.x << 16); f[j].y = __uint_as_float(w.x & 0xffff0000u); f[j].z = __uint_as_float(w.y << 16); f[j].w = __uint_as_float(w.y & 0xffff0000u);
            s += (f[j].x * f[j].x + f[j].y * f[j].y) + (f[j].z * f[j].z + f[j].w * f[j].w); }
        const float rstd = coef / sqrtf(wave_sum(s) * (1.f / D) + EPS);
        f32x4 h[4]; float s2 = 0.f;
#pragma unroll
        for (int j = 0; j < 4; ++j) { const f32x4 hv = ((const f32x4*)(hin + (size_t)m * D))[lane + 64 * j]; const f32x4 gg = ((const f32x4*)gpost)[lane + 64 * j];
            h[j] = hv + f[j] * rstd * gg; ((f32x4*)(hout + (size_t)m * D))[lane + 64 * j] = h[j];
            s2 += (h[j].x * h[j].x + h[j].y * h[j].y) + (h[j].z * h[j].z + h[j].w * h[j].w); }
        if (gpre) { const float r2 = 1.0f / sqrtf(wave_sum(s2) * (1.f / D) + EPS); u32x2* o8 = (u32x2*)(Aout + (size_t)m * D) + lane;
#pragma unroll
            for (int j = 0; j < 4; ++j) { const f32x4 gg = ((const f32x4*)gpre)[lane + 64 * j]; u32x2 w; w.x = pk2(h[j].x * r2 * gg.x, h[j].y * r2 * gg.y); w.y = pk2(h[j].z * r2 * gg.z, h[j].w * r2 * gg.w); o8[64 * j] = w; } }
    }
}

__device__ __forceinline__ void phase_ckvn(const Ctx& F) {
    const bf16_t* Y = (const bf16_t*)(F.ws + WS_BIG + BG_Y); bf16_t* O = (bf16_t*)(F.ws + WS_BIG + BG_CKVN); const float* gn = inp(I_EKVN);
    const int gw = F.bid * NWAVES + F.wave, NGW = F.nblk * NWAVES, lane = F.lane;
    for (int m = gw; m < T; m += NGW) {
        const u32x2 w = ((const u32x2*)(Y + (size_t)m * NE + YCKV))[lane];
        const float a = __uint_as_float(w.x << 16), b = __uint_as_float(w.x & 0xffff0000u), c = __uint_as_float(w.y << 16), d = __uint_as_float(w.y & 0xffff0000u);
        const float rstd = 1.0f / sqrtf(wave_sum(a * a + b * b + c * c + d * d) * (1.f / 256.f) + EPS);
        const f32x4 gg = ((const f32x4*)gn)[lane]; u32x2 o; o.x = pk2(a * rstd * gg.x, b * rstd * gg.y); o.y = pk2(c * rstd * gg.z, d * rstd * gg.w);
        ((u32x2*)(O + (size_t)m * 256))[lane] = o;
    }
}

__device__ __forceinline__ unsigned f2ord(float f) { const unsigned u = __float_as_uint(f + 0.0f); return (u & 0x80000000u) ? ~u : (u | 0x80000000u); }
typedef float f32x16 __attribute__((ext_vector_type(16)));
__device__ __forceinline__ void phase_idx(const Ctx& F) {
    const bf16_t* Y = (const bf16_t*)(F.ws + WS_BIG + BG_Y);
    u32x2* MT = (u32x2*)(F.ws + WS_BIG + BG_MASK);
    LAS float* sc = (LAS float*)F.lds;
    LAS unsigned* hist = (LAS unsigned*)(F.lds + HIST_OFF) + F.wave * 264;
    const int lane = F.lane, wave = F.wave, c = lane & 31, h2 = lane >> 5;
    for (int unit = F.bid; unit < T / 8; unit += F.nblk) {
        const int b = unit / 512, qg = 511 - (unit % 512); const int t0 = qg * 8, nkeys = t0 + 8;
        const size_t rowb = (size_t)b * SEQ;
        const int t = t0 + wave, n = t + 1;
        u32x2* mrow = MT + (size_t)b * 64 * SEQ + t;
        if (nkeys <= 256) {
            const int lo = lane * 64; unsigned long long bits = 0ull; if (lo + 63 <= t) bits = ~0ull; else if (lo <= t) bits = (2ull << (t - lo)) - 1ull;
            u32x2 w; w.x = (unsigned)bits; w.y = (unsigned)(bits >> 32); mrow[(size_t)lane * SEQ] = w;
            continue;
        }
        {
            bf16x8 afr[2][4]; float wq[2][16];
            const int head = (c & 3) + 4 * ((c >> 3) & 1), ql = ((c >> 2) & 1) + 2 * (c >> 4);
#pragma unroll
            for (int rt = 0; rt < 2; ++rt) { const bf16_t* qrow = Y + (rowb + t0 + rt * 4 + ql) * NE + YQI + head * 64 + 8 * h2;
#pragma unroll
                for (int ks = 0; ks < 4; ++ks) afr[rt][ks] = *(const bf16x8*)(qrow + 16 * ks);
#pragma unroll
                for (int r = 0; r < 16; ++r) wq[rt][r] = bf2f(Y[(rowb + t0 + rt * 4 + h2 + 2 * (r >> 3)) * NE + YWI + (r & 7)]); }
            const int nkt = (nkeys + 31) >> 5;
            for (int kt = wave; kt < nkt; kt += 8) {
                const bf16_t* krow = Y + (rowb + kt * 32 + c) * NE + YKI + 8 * h2;
                bf16x8 bfr[4];
#pragma unroll
                for (int ks = 0; ks < 4; ++ks) bfr[ks] = *(const bf16x8*)(krow + 16 * ks);
#pragma unroll
                for (int rt = 0; rt < 2; ++rt) { f32x16 acc = {};
#pragma unroll
                    for (int ks = 0; ks < 4; ++ks) acc = __builtin_amdgcn_mfma_f32_32x32x16_bf16(afr[rt][ks], bfr[ks], acc, 0, 0, 0);
                    float s0 = 0.f, s1 = 0.f;
#pragma unroll
                    for (int r = 0; r < 8; ++r) { s0 += fmaxf(acc[r], 0.f) * wq[rt][r]; s1 += fmaxf(acc[8 + r], 0.f) * wq[rt][8 + r]; }
                    sc[(rt * 4 + h2) * 4096 + kt * 32 + c] = s0; sc[(rt * 4 + h2 + 2) * 4096 + kt * 32 + c] = s1; }
            }
        }
        __syncthreads();
        {
            LAS float* row = sc + wave * 4096;
            unsigned u[64]; int nv = n - lane; asm volatile("" : "+v"(nv));
#pragma unroll
            for (int j = 0; j < 64; ++j) { u[j] = (64 * j < nv) ? f2ord(row[lane + 64 * j]) : 0u; }
            unsigned prefix = 0u; int kk = 256;
#pragma unroll
            for (int pass = 0; pass < 4; ++pass) {
                const int shift = 24 - 8 * pass;
                for (int i = lane; i < 264; i += 64) hist[i] = 0u;
                asm volatile("s_waitcnt lgkmcnt(0)" ::: "memory");
#pragma unroll
                for (int j = 0; j < 64; ++j) { const bool match = (pass == 0) ? (u[j] != 0u) : ((u[j] >> (shift + 8)) == (prefix >> (shift + 8)) && u[j] != 0u);
                    if (match) atomicAdd((unsigned*)&hist[(u[j] >> shift) & 255u], 1u); }
                asm volatile("s_waitcnt lgkmcnt(0)" ::: "memory");
                const unsigned c0 = hist[4 * lane], c1 = hist[4 * lane + 1], c2 = hist[4 * lane + 2], c3 = hist[4 * lane + 3];
                const unsigned tot = c0 + c1 + c2 + c3; unsigned suf = tot;
#pragma unroll
                for (int o = 1; o < 64; o <<= 1) { const unsigned v = __shfl_down(suf, o); if (lane + o < 64) suf += v; }
                unsigned above = suf - tot;
                const unsigned cs[4] = {c0, c1, c2, c3};
#pragma unroll
                for (int bb = 3; bb >= 0; --bb) { if ((int)above < kk && (int)(above + cs[bb]) >= kk) { hist[256] = (unsigned)(4 * lane + bb); hist[257] = (unsigned)(kk - (int)above); } above += cs[bb]; }
                asm volatile("s_waitcnt lgkmcnt(0)" ::: "memory");
                const unsigned dsel = hist[256]; kk = (int)hist[257];
                prefix |= dsel << shift;
                asm volatile("s_waitcnt lgkmcnt(0)" ::: "memory");
            }
            int eqseen = 0; u32x2 myw = {0u, 0u}; const unsigned long long lt = (1ull << lane) - 1ull;
#pragma unroll
            for (int j = 0; j < 64; ++j) {
                const bool gt = u[j] > prefix, eq = (u[j] == prefix);
                const unsigned long long beq = __ballot(eq);
                const int rk = eqseen + __popcll(beq & lt);
                const unsigned long long bs = __ballot(gt || (eq && rk < kk));
                if (lane == j) { myw.x = (unsigned)bs; myw.y = (unsigned)(bs >> 32); }
                eqseen += __popcll(beq);
                if ((j & 3) == 3) __builtin_amdgcn_sched_barrier(0);
            }
            mrow[(size_t)lane * SEQ] = myw;
        }
        __syncthreads();
    }
}

template <int MODE> __device__ __forceinline__ void phase_lru(const Ctx& F) {
    const bf16_t* Y = (const bf16_t*)(F.ws + WS_BIG + BG_Y); bf16_t* C = (bf16_t*)(F.ws + WS_MIX + 32 * MiB);
    float* CA = (float*)(F.ws + WS_LRUA); float* CH = (float*)(F.ws + WS_LRUH);
    const int gw = F.bid * NWAVES + F.wave, NGW = F.nblk * NWAVES, lane = F.lane;
    for (int unit = gw; unit < NB * 8 * 64; unit += NGW) {
        const int g = unit & 7, ck = (unit >> 3) & 63, b = unit >> 9; const int ch = g * 64 + lane; const size_t rowb = (size_t)b * SEQ;
        float wra[64], wri[64];
#pragma unroll
        for (int i = 0; i < 64; ++i) { wra[i] = inp(I_ERA)[(size_t)(g * 64 + i) * 64 + lane]; wri[i] = inp(I_ERI)[(size_t)(g * 64 + i) * 64 + lane]; }
        const float bra = inp(I_EBRA)[ch], bri = inp(I_EBRI)[ch], lam = inp(I_ELAM)[ch], cb = inp(I_ECB)[ch];
        const float cw0 = inp(I_ECW)[ch], cw1 = inp(I_ECW)[512 + ch], cw2 = inp(I_ECW)[1024 + ch], cw3 = inp(I_ECW)[1536 + ch];
        const float spl = log1pf(__expf(-lam));
        const int t0 = ck * 64;
        float x3 = (t0 >= 3) ? bf2f(Y[(rowb + t0 - 3) * NE + YXB + ch]) : 0.f, x2 = (t0 >= 2) ? bf2f(Y[(rowb + t0 - 2) * NE + YXB + ch]) : 0.f, x1 = (t0 >= 1) ? bf2f(Y[(rowb + t0 - 1) * NE + YXB + ch]) : 0.f;
        float hst = 0.f, aprod = 1.f;
        if (MODE == 1) { for (int c = 0; c < ck; ++c) { const float a = CA[((size_t)b * 64 + c) * 512 + ch], hh = CH[((size_t)b * 64 + c) * 512 + ch]; hst = a * hst + hh; } }
        for (int tt = 0; tt < 64; ++tt) {
            const size_t m = rowb + t0 + tt;
            const float x0 = bf2f(Y[m * NE + YXB + ch]);
            const float xc = cw0 * x3 + cw1 * x2 + cw2 * x1 + cw3 * x0 + cb;
            x3 = x2; x2 = x1; x1 = x0;
            float ra = bra, ri = bri;
#pragma unroll
            for (int i = 0; i < 64; ++i) { const float xi = __uint_as_float(__builtin_amdgcn_readlane(__float_as_uint(xc), i)); ra += xi * wra[i]; ri += xi * wri[i]; }
            const float r = sigmoidf_(ra), ig = sigmoidf_(ri);
            const float log_a = -8.0f * r * spl; const float a = __expf(log_a); const float bb = sqrtf(-expm1f(2.0f * log_a)) * (ig * xc);
            hst = a * hst + bb; aprod *= a;
            if (MODE == 1) { const float gt = bf2f(Y[m * NE + YGATE + ch]); const float u = 0.7978845608028654f * (gt + 0.044715f * gt * gt * gt); const float ge = 0.5f * gt * (1.0f + tanhf(u));
                C[m * 1024 + 512 + ch] = (bf16_t)f2bf(hst * ge); }
        }
        if (MODE == 0) { CA[((size_t)b * 64 + ck) * 512 + ch] = aprod; CH[((size_t)b * 64 + ck) * 512 + ch] = hst; }
    }
}

__device__ __forceinline__ void phase_gla_a(const Ctx& F) {
    const bf16_t* Z = (const bf16_t*)(F.ws + WS_BIG + BG_Y);
    bf16_t* QD = (bf16_t*)(F.ws + WS_A + AF_QD); bf16_t* KRT = (bf16_t*)(F.ws + WS_A + AF_KRT); bf16_t* ATT = (bf16_t*)(F.ws + WS_A + AF_ATT); bf16_t* VT = (bf16_t*)(F.ws + WS_MIX + 32 * MiB);
    float* DEC = (float*)(F.ws + WS_DEC);
    LAS float* G = (LAS float*)F.lds;
    LAS float* qd = G + 64 * 128;
    LAS float* ki = qd + 64 * 129;
    LAS float* gl = ki + 64 * 129;
    LAS bf16_t* krt = (LAS bf16_t*)(gl + 64 * 16);
    LAS bf16_t* vtl = (LAS bf16_t*)G;
    const int tid = F.tid;
    for (int unit = F.bid; unit < NB * 64 * 4; unit += F.nblk) {
        const int h = unit & 3, n = (unit >> 2) & 63, b = unit >> 8; const size_t row0 = (size_t)b * SEQ + n * 64;
        for (int i = tid; i < 64 * 16; i += NTHREADS) gl[i] = bf2f(Z[(row0 + (i >> 4)) * NO + ZG + (i & 15)]);
        __syncthreads();
        for (int i = tid; i < 64 * 128; i += NTHREADS) { const int j = i >> 7, d = i & 127; float z = inp(I_OBG)[h * 128 + d];
#pragma unroll
            for (int r = 0; r < 16; ++r) z += gl[j * 16 + r] * inp(I_OG2)[r * 512 + h * 128 + d];
            const float ls = fminf(z, 0.f) - log1pf(__expf(-fabsf(z)));
            G[i] = ls * (1.0f / 16.0f); }
        __syncthreads();
        if (tid < 128) { float run = 0.f; for (int j = 0; j < 64; ++j) { run += G[j * 128 + tid]; G[j * 128 + tid] = run; } DEC[((size_t)b * 64 + n) * 512 + h * 128 + tid] = __expf(run); }
        __syncthreads();
        for (int i = tid; i < 64 * 128; i += NTHREADS) { const int j = i >> 7, d = i & 127; const size_t m = row0 + j;
            const float q = bf2f(Z[m * NO + ZQ + h * 128 + d]) * 0.08838834764831845f, k = bf2f(Z[m * NO + ZK + h * 128 + d]);
            const float gg = G[i], glast = G[63 * 128 + d];
            const float qdv = q * __expf(gg), kiv = k * __expf(-gg), krv = k * __expf(glast - gg);
            const bf16_t qb = (bf16_t)f2bf(qdv), kb = (bf16_t)f2bf(kiv);
            QD[(size_t)unit * 8192 + i] = qb; krt[d * 64 + j] = (bf16_t)f2bf(krv);
            qd[j * 129 + d] = bf2f(qb); ki[j * 129 + d] = bf2f(kb); }
        __syncthreads();
        for (int i = tid; i < 64 * 64; i += NTHREADS) { const int ii = i >> 6, jj = i & 63; float a = 0.f;
            if (jj <= ii) { for (int d = 0; d < 128; ++d) a += qd[ii * 129 + d] * ki[jj * 129 + d]; }
            ATT[(size_t)unit * 4096 + i] = (bf16_t)f2bf(a); }
        for (int i = tid; i < 128 * 64 / 8; i += NTHREADS) ((u32x4*)(KRT + (size_t)unit * 8192))[i] = ((const LAS u32x4*)krt)[i];
        for (int i = tid; i < 64 * 256; i += NTHREADS) { const int j = i >> 8, v = i & 255; vtl[v * 64 + j] = Z[(row0 + j) * NO + ZV + h * 256 + v]; }
        __syncthreads();
        for (int i = tid; i < 256 * 64 / 8; i += NTHREADS) ((u32x4*)(VT + (size_t)unit * 16384))[i] = ((const LAS u32x4*)vtl)[i];
        __syncthreads();
    }
}
__device__ __forceinline__ void phase_gla_b(const Ctx& F) {
    const bf16_t* QD = (const bf16_t*)(F.ws + WS_A + AF_QD); const bf16_t* KRT = (const bf16_t*)(F.ws + WS_A + AF_KRT); const bf16_t* ATT = (const bf16_t*)(F.ws + WS_A + AF_ATT); const bf16_t* VT = (const bf16_t*)(F.ws + WS_MIX + 32 * MiB);
    const float* DEC = (const float*)(F.ws + WS_DEC); bf16_t* ORAW = (bf16_t*)(F.ws + WS_MIX);
    constexpr int QP_ = 272, KP_ = 144, BUF = 64 * QP_ + 128 * KP_ + 64 * KP_;
    static_assert(2 * BUF <= RING_BYTES, "GLA_B LDS");
    const int tid = F.tid, lane = F.lane, wave = F.wave, i16 = lane & 15, g = lane >> 4;
    for (int unit = F.bid; unit < NB * 4 * 2; unit += F.nblk) {
        const int vhalf = unit & 1, h = (unit >> 1) & 3, b = unit >> 3; const int v0 = (vhalf * 8 + wave) * 16;
        f32x4 sacc[8];
#pragma unroll
        for (int m = 0; m < 8; ++m) sacc[m] = (f32x4){0.f, 0.f, 0.f, 0.f};
        u32x4 stg[5];
        auto issue = [&](int n) { const size_t u = (size_t)(((b * 64 + n) << 2) + h);
#pragma unroll
            for (int k = 0; k < 5; ++k) { const int p = tid + 512 * k; const bf16_t* src = (k < 2) ? QD + u * 8192 + (size_t)p * 8 : (k < 4) ? KRT + u * 8192 + (size_t)(p - 1024) * 8 : ATT + u * 4096 + (size_t)(p - 2048) * 8;
                stg[k] = *(const u32x4*)src; } };
        auto commit = [&](int buf) { LAS unsigned char* base = F.lds + buf * BUF;
#pragma unroll
            for (int k = 0; k < 5; ++k) { const int p = tid + 512 * k; LAS unsigned char* dst;
                if (k < 2) dst = base + (p >> 4) * QP_ + (p & 15) * 16; else if (k < 4) { const int q = p - 1024; dst = base + 64 * QP_ + (q >> 3) * KP_ + (q & 7) * 16; } else { const int q = p - 2048; dst = base + 64 * QP_ + 128 * KP_ + (q >> 3) * KP_ + (q & 7) * 16; }
                *(LAS u32x4*)dst = stg[k]; } };
        issue(0); commit(0);
        __syncthreads();
        for (int n = 0; n < 64; ++n) {
            const size_t row0 = (size_t)b * SEQ + n * 64; const size_t u = (size_t)(((b * 64 + n) << 2) + h);
            LAS unsigned char* base = F.lds + (n & 1) * BUF; LAS unsigned char* qdl = base; LAS unsigned char* krl = base + 64 * QP_; LAS unsigned char* atl = krl + 128 * KP_;
            bf16x8 vtf[2];
#pragma unroll
            for (int s2 = 0; s2 < 2; ++s2) vtf[s2] = *(const bf16x8*)(VT + u * 16384 + (size_t)(v0 + i16) * 64 + 32 * s2 + 8 * g);
            f32x4 dec4[8];
#pragma unroll
            for (int m = 0; m < 8; ++m) dec4[m] = *(const f32x4*)(DEC + ((size_t)b * 64 + n) * 512 + h * 128 + 16 * m + 4 * g);
            if (n + 1 < 64) issue(n + 1);
            f32x4 oacc[4];
#pragma unroll
            for (int m = 0; m < 4; ++m) oacc[m] = (f32x4){0.f, 0.f, 0.f, 0.f};
#pragma unroll
            for (int m = 0; m < 4; ++m)
#pragma unroll
                for (int s2 = 0; s2 < 2; ++s2) { const bf16x8 a = *(const LAS bf16x8*)(atl + (16 * m + i16) * KP_ + (32 * s2 + 8 * g) * 2); oacc[m] = __builtin_amdgcn_mfma_f32_16x16x32_bf16(a, vtf[s2], oacc[m], 0, 0, 0); }
#pragma unroll
            for (int s4 = 0; s4 < 4; ++s4) {
                u32x4 bw; bw.x = pg8::cvt_pk_bf16(sacc[2 * s4][0], sacc[2 * s4][1]); bw.y = pg8::cvt_pk_bf16(sacc[2 * s4][2], sacc[2 * s4][3]); bw.z = pg8::cvt_pk_bf16(sacc[2 * s4 + 1][0], sacc[2 * s4 + 1][1]); bw.w = pg8::cvt_pk_bf16(sacc[2 * s4 + 1][2], sacc[2 * s4 + 1][3]);
                const bf16x8 bS = __builtin_bit_cast(bf16x8, bw);
#pragma unroll
                for (int m = 0; m < 4; ++m) { const LAS unsigned char* ap = qdl + (16 * m + i16) * QP_ + (32 * s4 + 4 * g) * 2; const u32x2 lo = *(const LAS u32x2*)ap, hi = *(const LAS u32x2*)(ap + 32);
                    u32x4 aw; aw.x = lo.x; aw.y = lo.y; aw.z = hi.x; aw.w = hi.y; oacc[m] = __builtin_amdgcn_mfma_f32_16x16x32_bf16(__builtin_bit_cast(bf16x8, aw), bS, oacc[m], 0, 0, 0); }
            }
#pragma unroll
            for (int m = 0; m < 4; ++m)
#pragma unroll
                for (int r = 0; r < 4; ++r) ORAW[(row0 + 16 * m + 4 * g + r) * 1024 + h * 256 + v0 + i16] = (bf16_t)f2bf(oacc[m][r]);
#pragma unroll
            for (int m = 0; m < 8; ++m) { sacc[m] = sacc[m] * dec4[m];
#pragma unroll
                for (int s2 = 0; s2 < 2; ++s2) { const bf16x8 a = *(const LAS bf16x8*)(krl + (16 * m + i16) * KP_ + (32 * s2 + 8 * g) * 2); sacc[m] = __builtin_amdgcn_mfma_f32_16x16x32_bf16(a, vtf[s2], sacc[m], 0, 0, 0); } }
            if (n + 1 < 64) commit((n + 1) & 1);
            __syncthreads();
        }
    }
}
__device__ __forceinline__ void phase_gla_c(const Ctx& F) {
    const bf16_t* Z = (const bf16_t*)(F.ws + WS_BIG + BG_Y); const bf16_t* ORAW = (const bf16_t*)(F.ws + WS_MIX); bf16_t* C = (bf16_t*)(F.ws + WS_MIX + 32 * MiB);
    const float* hn = inp(I_OHN);
    const int gw = F.bid * NWAVES + F.wave, NGW = F.nblk * NWAVES, lane = F.lane;
    for (int m = gw; m < T; m += NGW) {
#pragma unroll
        for (int j = 0; j < 4; ++j) { const u32x2 w = ((const u32x2*)(ORAW + (size_t)m * 1024))[lane + 64 * j]; const u32x2 rw = ((const u32x2*)(Z + (size_t)m * NO + ZR))[lane + 64 * j];
            const float a = __uint_as_float(w.x << 16), bq = __uint_as_float(w.x & 0xffff0000u), c = __uint_as_float(w.y << 16), d = __uint_as_float(w.y & 0xffff0000u);
            const float rstd = 1.0f / sqrtf(wave_sum(a * a + bq * bq + c * c + d * d) * (1.f / 256.f) + EPS);
            const f32x4 gg = ((const f32x4*)hn)[lane];
            const float r0 = __uint_as_float(rw.x << 16), r1 = __uint_as_float(rw.x & 0xffff0000u), r2 = __uint_as_float(rw.y << 16), r3 = __uint_as_float(rw.y & 0xffff0000u);
            u32x2 o; o.x = pk2(a * rstd * gg.x * r0 * sigmoidf_(r0), bq * rstd * gg.y * r1 * sigmoidf_(r1)); o.y = pk2(c * rstd * gg.z * r2 * sigmoidf_(r2), d * rstd * gg.w * r3 * sigmoidf_(r3));
            ((u32x2*)(C + (size_t)m * 1024))[lane + 64 * j] = o; }
    }
}

__device__ __forceinline__ void phase_vt(const Ctx& F) {
    const bf16_t* KVm = (const bf16_t*)(F.ws + WS_KVM); bf16_t* Vt = (bf16_t*)(F.ws + WS_VT);
    const int gt = F.bid * NTHREADS + F.tid, NGT = F.nblk * NTHREADS;
    for (int i = gt; i < 1024 * 1024; i += NGT) { const int mm = i & 255, d = (i >> 8) & 255, h = (i >> 16) & 3, b = i >> 18;
        Vt[i] = KVm[(size_t)(b * 256 + mm) * 2048 + 1024 + h * 256 + d]; }
}
__device__ __forceinline__ void phase_xsoftmax(const Ctx& F) {
    const bf16_t* S = (const bf16_t*)(F.ws + WS_BIG + BG_S); bf16_t* P = (bf16_t*)(F.ws + WS_MIX);
    const int gw = F.bid * NWAVES + F.wave, NGW = F.nblk * NWAVES, lane = F.lane;
    for (int m = gw; m < T; m += NGW) {
#pragma unroll
        for (int j = 0; j < 4; ++j) { const u32x2 w = ((const u32x2*)(S + (size_t)m * 1024))[lane + 64 * j];
            const float a = __uint_as_float(w.x << 16), b = __uint_as_float(w.x & 0xffff0000u), c = __uint_as_float(w.y << 16), d = __uint_as_float(w.y & 0xffff0000u);
            const float mx = wave_max(fmaxf(fmaxf(a, b), fmaxf(c, d)));
            const float ea = __expf(a - mx), eb = __expf(b - mx), ec = __expf(c - mx), ed = __expf(d - mx);
            const float inv = 1.0f / wave_sum((ea + eb) + (ec + ed));
            u32x2 o; o.x = pk2(ea * inv, eb * inv); o.y = pk2(ec * inv, ed * inv);
            ((u32x2*)(P + (size_t)m * 1024))[lane + 64 * j] = o; }
    }
}

enum Kind { K_PREP = 0, K_SWIGLU, K_GEMM, K_NORM, K_CKVN, K_IDX, K_ATT, K_LRU_A, K_LRU_B, K_GLA_A, K_GLA_B, K_GLA_C, K_VT, K_XSOFTMAX };
enum Op { OP_UP1 = 0, OP_DN1, OP_N1, OP_IN, OP_M0, OP_M1, OP_M2, OP_M3, OP_M4, OP_M5, OP_OUT, OP_N2, OP_XQ, OP_XKV, OP_XVT, OP_XS, OP_XSM, OP_XO, OP_XOUT, OP_N3, OP_UP2, OP_DN2, OP_N4, OP_COUNT };
constexpr int NPHASES = 1 + 2 * OP_COUNT;

struct Desc { int kind; pg8::Gemm g; bf16_t* O; int ldc; float scale; const bf16_t* Fb; const float* hin; float coef; const float* gpost; const float* gpre; };
__device__ __forceinline__ void st_ptr(LAS unsigned* p, const void* q) { const unsigned long long v = (unsigned long long)(uintptr_t)q; p[0] = (unsigned)v; p[1] = (unsigned)(v >> 32); }
__device__ __forceinline__ unsigned ld_u(const LAS unsigned* p) { return (unsigned)__builtin_amdgcn_readfirstlane((int)p[0]); }
__device__ __forceinline__ const void* ld_ptr(const LAS unsigned* p) { const unsigned long long v = (unsigned long long)ld_u(p) | ((unsigned long long)ld_u(p + 1) << 32); return (const void*)(uintptr_t)v; }
__device__ __forceinline__ void desc_store(LAS unsigned* t, const Desc& d) {
    t[0] = (unsigned)d.kind; st_ptr(t + 1, d.g.A); st_ptr(t + 3, d.g.Bt); t[5] = d.g.lda; t[6] = d.g.ldb; t[7] = d.g.K; t[8] = d.g.nM; t[9] = d.g.nN; t[10] = d.g.a_pn_off; t[11] = d.g.b_pn_off; t[12] = d.g.b_batch_off; t[13] = d.g.bshift;
    st_ptr(t + 14, d.O); t[16] = d.ldc; t[17] = __float_as_uint(d.scale); st_ptr(t + 18, d.Fb); st_ptr(t + 20, d.hin); t[22] = __float_as_uint(d.coef); st_ptr(t + 23, d.gpost); st_ptr(t + 25, d.gpre);
}
__device__ __forceinline__ Desc desc_load(const LAS unsigned* t) {
    Desc d; d.kind = (int)ld_u(t); d.g.A = (const bf16_t*)ld_ptr(t + 1); d.g.Bt = (const bf16_t*)ld_ptr(t + 3); d.g.lda = ld_u(t + 5); d.g.ldb = ld_u(t + 6); d.g.K = ld_u(t + 7); d.g.nM = ld_u(t + 8); d.g.nN = ld_u(t + 9);
    d.g.a_pn_off = ld_u(t + 10); d.g.b_pn_off = ld_u(t + 11); d.g.b_batch_off = ld_u(t + 12); d.g.bshift = ld_u(t + 13);
    d.O = (bf16_t*)ld_ptr(t + 14); d.ldc = ld_u(t + 16); d.scale = __uint_as_float(ld_u(t + 17)); d.Fb = (const bf16_t*)ld_ptr(t + 18); d.hin = (const float*)ld_ptr(t + 20); d.coef = __uint_as_float(ld_u(t + 22));
    d.gpost = (const float*)ld_ptr(t + 23); d.gpre = (const float*)ld_ptr(t + 25); return d;
}

__device__ __forceinline__ Desc make_desc(const Ctx& F, int ph) {
    Desc d; d.kind = -1; d.O = nullptr; d.ldc = 0; d.scale = 1.f; d.Fb = nullptr; d.hin = nullptr; d.coef = 0.f; d.gpost = nullptr; d.gpre = nullptr;
    d.g = pg8::plain_gemm(nullptr, 0, nullptr, 0, 256, 256, 256);
    if (ph == 0) { d.kind = K_PREP; return d; }
    const int l = (ph - 1) / OP_COUNT, op = (ph - 1) % OP_COUNT;
    unsigned char* ws = F.ws; const float* nrm = inp(I_NORMS) + (size_t)l * 9 * D;
    bf16_t* A = (bf16_t*)(ws + WS_A); bf16_t* Fb = (bf16_t*)(ws + WS_F); bf16_t* BIG = (bf16_t*)(ws + WS_BIG); bf16_t* MIX = (bf16_t*)(ws + WS_MIX); bf16_t* Cc = (bf16_t*)(ws + WS_MIX + 32 * MiB);
    const unsigned char* W = ws + WS_W;
    switch (op) {
    case OP_UP1: case OP_UP2: { const int i = (op == OP_UP2); d.kind = K_SWIGLU; d.g = pg8::plain_gemm(A, D, (const bf16_t*)(W + W_GU) + (size_t)(l * 2 + i) * 2 * FF * D, D, T, 2 * FF, D); d.O = BIG; d.ldc = FF; break; }
    case OP_DN1: case OP_DN2: { const int i = (op == OP_DN2); d.kind = K_GEMM; d.g = pg8::plain_gemm(BIG, FF, (const bf16_t*)(W + W_DN) + (size_t)(l * 2 + i) * D * FF, FF, T, D, FF); d.O = Fb; d.ldc = D; break; }
    case OP_N1: d.kind = K_NORM; d.Fb = Fb; d.hin = (l == 0) ? inp(I_X) : F.out; d.coef = 0.5f; d.gpost = nrm + N_FFN1_POST * D; d.gpre = nrm + N_MIX_PRE * D; break;
    case OP_IN: d.kind = K_GEMM; if (l == 0) d.g = pg8::plain_gemm(A, D, (const bf16_t*)(W + W_EIN), D, T, NE, D); else d.g = pg8::plain_gemm(A, D, (const bf16_t*)(W + W_OIN), D, T, NO, D);
                d.O = BIG; d.ldc = (l == 0) ? NE : NO; break;
    case OP_M0: d.kind = (l == 0) ? K_CKVN : K_GLA_A; break;
    case OP_M1: if (l == 0) { d.kind = K_GEMM; d.g = pg8::plain_gemm((const bf16_t*)(ws + WS_BIG + BG_CKVN), 256, (const bf16_t*)(W + W_UKV), 256, T, 1024, 256); d.O = MIX; d.ldc = 1024; } else d.kind = K_GLA_B; break;
    case OP_M2: d.kind = (l == 0) ? K_IDX : K_GLA_C; break;
    case OP_M3: d.kind = (l == 0) ? K_ATT : -1; break;
    case OP_M4: d.kind = (l == 0) ? K_LRU_A : -1; break;
    case OP_M5: d.kind = (l == 0) ? K_LRU_B : -1; break;
    case OP_OUT: d.kind = K_GEMM; d.g = pg8::plain_gemm(Cc, D, (const bf16_t*)(W + (l == 0 ? W_EOUT : W_OOUT)), D, T, D, D); d.O = Fb; d.ldc = D; break;
    case OP_N2: d.kind = K_NORM; d.Fb = Fb; d.hin = F.out; d.coef = 1.0f; d.gpost = nrm + N_MIX_POST * D; d.gpre = nrm + N_XA_PRE * D; break;
    case OP_XQ: d.kind = K_GEMM; d.g = pg8::plain_gemm(A, D, (const bf16_t*)(W + W_Q) + (size_t)l * D * D, D, T, D, D); d.O = BIG; d.ldc = D; break;
    case OP_XKV: d.kind = K_GEMM; d.g = pg8::plain_gemm((const bf16_t*)(ws + (l ? WS_MEMN1 : WS_MEMN0)), D, (const bf16_t*)(W + W_KV) + (size_t)l * 2 * D * D, D, 1024, 2 * D, D); d.O = (bf16_t*)(ws + WS_KVM); d.ldc = 2 * D; break;
    case OP_XVT: d.kind = K_VT; break;
    case OP_XS: { d.kind = K_GEMM; pg8::Gemm g; g.A = BIG; g.Bt = (const bf16_t*)(ws + WS_KVM); g.lda = D; g.ldb = 2 * D; g.K = 256; g.nM = T / 256; g.nN = 4; g.a_pn_off = 256; g.b_pn_off = 256; g.b_batch_off = 256 * 2 * D; g.bshift = 4;
                  d.g = g; d.O = (bf16_t*)(ws + WS_BIG + BG_S); d.ldc = D; d.scale = 0.0625f; break; }
    case OP_XSM: d.kind = K_XSOFTMAX; break;
    case OP_XO: { d.kind = K_GEMM; pg8::Gemm g; g.A = MIX; g.Bt = (const bf16_t*)(ws + WS_VT); g.lda = D; g.ldb = 256; g.K = 256; g.nM = T / 256; g.nN = 4; g.a_pn_off = 256; g.b_pn_off = 256 * 256; g.b_batch_off = 4 * 256 * 256; g.bshift = 4;
                  d.g = g; d.O = BIG; d.ldc = D; break; }
    case OP_XOUT: d.kind = K_GEMM; d.g = pg8::plain_gemm(BIG, D, (const bf16_t*)(W + W_O) + (size_t)l * D * D, D, T, D, D); d.O = Fb; d.ldc = D; break;
    case OP_N3: d.kind = K_NORM; d.Fb = Fb; d.hin = F.out; d.coef = 1.0f; d.gpost = nrm + N_XA_POST * D; d.gpre = nrm + N_FFN2_PRE * D; break;
    case OP_N4: d.kind = K_NORM; d.Fb = Fb; d.hin = F.out; d.coef = 0.5f; d.gpost = nrm + N_FFN2_POST * D; d.gpre = (l == 0) ? (inp(I_NORMS) + (size_t)(9 + N_FFN1_PRE) * D) : nullptr; break;
    default: break;
    }
    return d;
}

__global__ void __launch_bounds__(NTHREADS, 2) mk_fwd(Args args) {
    extern __shared__ __attribute__((aligned(16))) unsigned char lds_raw[];
    Ctx F; F.lds = (LAS unsigned char*)lds_raw; F.ldsg = (char*)lds_raw; F.tid = threadIdx.x; F.lane = F.tid & 63; F.wave = __builtin_amdgcn_readfirstlane(F.tid >> 6);
    F.nblk = gridDim.x; F.bid = blockIdx.x; F.out = args.out; F.ws = args.ws;
    volatile LAS unsigned* MISC = (volatile LAS unsigned*)(F.lds + MISC_OFF);
    for (int u = F.tid; u < (LDS_BYTES - MISC_OFF) / 4; u += NTHREADS) MISC[u] = 0u;
    __syncthreads();
    XcdBarrier bar; bar.bar = (unsigned*)(args.ws + WS_CTL) + CW_BAR; bar.x = 0; bar.st = nullptr;
#if !MK_PER_PHASE
    bar = xcd_barrier_post((unsigned*)(args.ws + WS_CTL) + CW_BAR, MISC + 8);
#endif
    F.kp = (const __attribute__((address_space(4))) void*)__builtin_amdgcn_kernarg_segment_ptr();
    if (F.tid < NPHASES) { const Desc dd = make_desc(F, F.tid); desc_store((LAS unsigned*)(F.lds + DESC_OFF) + F.tid * DESC_WORDS, dd); }
    __syncthreads();
    const Ctx F0 = F;
    for (int ph = args.ph_lo; ph < args.ph_hi; ++ph) {
        Ctx F = F0;
        asm volatile("" ::: "v16","v17","v18","v19","v20","v21","v22","v23","v24","v25","v26","v27","v28","v29","v30","v31","v32","v33","v34","v35","v36","v37","v38","v39","v40","v41","v42","v43","v44","v45","v46","v47","v48","v49","v50","v51","v52","v53","v54","v55","v56","v57","v58","v59","v60","v61","v62","v63","v64","v65","v66","v67","v68","v69","v70","v71","v72","v73","v74","v75","v76","v77","v78","v79","v80","v81","v82","v83","v84","v85","v86","v87","v88","v89","v90","v91","v92","v93","v94","v95","v96","v97","v98","v99","v100","v101","v102","v103","v104","v105","v106","v107","v108","v109","v110","v111","v112","v113","v114","v115","v116","v117","v118","v119","v120","v121","v122","v123","v124","v125","v126","v127","v128","v129","v130","v131","v132","v133","v134","v135","v136","v137","v138","v139","v140","v141","v142","v143","v144","v145","v146","v147","v148","v149","v150","v151","v152","v153","v154","v155","v156","v157","v158","v159","v160","v161","v162","v163","v164","v165","v166","v167","v168","v169","v170","v171","v172","v173","v174","v175","v176","v177","v178","v179","v180","v181","v182","v183","v184","v185","v186","v187","v188","v189","v190","v191","v192","v193","v194","v195","v196","v197","v198","v199","v200","v201","v202","v203","v204","v205","v206","v207","v208","v209","v210","v211","v212","v213","v214","v215","v216","v217","v218","v219","v220","v221","v222","v223","v224","v225","v226","v227","v228","v229","v230","v231","v232","v233","v234","v235");
        F.tid = F0.tid;
        const Desc d = desc_load((const LAS unsigned*)(F.lds + DESC_OFF) + ph * DESC_WORDS);
        if (d.kind < 0) continue;
#ifndef PH_ENABLE
#define PH_ENABLE 0xffffffffu
#endif
#define EN(k) (((PH_ENABLE) >> (k)) & 1u)
#ifndef REPEAT_MASK
#define REPEAT_MASK 0u
#endif
        for (int rep = 0; rep < 1 + (int)((REPEAT_MASK >> d.kind) & 1u); ++rep) {
        if (rep) __syncthreads();
        F = F0;
        { unsigned long long p0 = (unsigned long long)(uintptr_t)F.ws, p1 = (unsigned long long)(uintptr_t)F.out, p2 = (unsigned long long)(uintptr_t)F.kp;
          unsigned a0 = (unsigned)p0, a1 = (unsigned)(p0 >> 32), b0 = (unsigned)p1, b1 = (unsigned)(p1 >> 32), c0 = (unsigned)p2, c1 = (unsigned)(p2 >> 32); int w_ = F.wave, n_ = F.nblk, i_ = F.bid;
          int ln_; asm volatile("v_mbcnt_lo_u32_b32 %0, -1, 0\n\tv_mbcnt_hi_u32_b32 %0, -1, %0" : "=v"(ln_));
          asm volatile("" : "+v"(a0), "+v"(a1), "+v"(b0), "+v"(b1), "+v"(c0), "+v"(c1), "+v"(w_), "+v"(n_), "+v"(i_));
#define RFL(x) ((unsigned)__builtin_amdgcn_readfirstlane((int)(x)))
          F.ws = (unsigned char*)(uintptr_t)((unsigned long long)RFL(a0) | ((unsigned long long)RFL(a1) << 32)); F.out = (float*)(uintptr_t)((unsigned long long)RFL(b0) | ((unsigned long long)RFL(b1) << 32));
          F.kp = (const __attribute__((address_space(4))) void*)(uintptr_t)((unsigned long long)RFL(c0) | ((unsigned long long)RFL(c1) << 32)); F.wave = (int)RFL(w_); F.nblk = (int)RFL(n_); F.bid = (int)RFL(i_); F.lane = ln_; F.tid = F.wave * 64 + ln_; }
        switch (d.kind) {
        case K_PREP: if constexpr (EN(K_PREP)) { phase_prep(F); } break;
#if NAIVE_GEMM
        case K_SWIGLU: { pg8::EpiSwiglu E{d.O, d.ldc}; pg8::gemm_naive<2>(F.lds, d.g, E, F.nblk, F.bid, F.tid); break; }
        case K_GEMM: { pg8::EpiBf16 E{d.O, d.ldc, d.scale}; pg8::gemm_naive<1>(F.lds, d.g, E, F.nblk, F.bid, F.tid); break; }
#else
        case K_SWIGLU: case K_GEMM: if constexpr (EN(K_GEMM)) {
            pg8::StaticOrder S; S.init(d.g.nM, d.g.nN, F.nblk, F.bid); pg8::EpiAny E{d.O, d.ldc, d.scale, d.kind == K_SWIGLU ? 1 : 0}; pg8::gemm_phase<pg8::EpiAny, true>(F.lds, d.g, S, E, F.tid);
            break; }
#endif
        case K_NORM: if constexpr (EN(K_NORM)) { phase_norm(F, d.Fb, d.hin, F.out, d.coef, d.gpost, d.gpre, (bf16_t*)(F.ws + WS_A)); } break;
        case K_CKVN: if constexpr (EN(K_CKVN)) { phase_ckvn(F); } break;
        case K_IDX: if constexpr (EN(K_IDX)) { phase_idx(F); } break;
                case K_ATT: if constexpr (EN(K_ATT)) { dsa::attn_phase<8>(F.tid, F.nblk, F.bid, (const dsa::bf16*)(F.ws + WS_BIG + BG_Y) + YQ, (const dsa::bf16*)(F.ws + WS_MIX), (const dsa::bf16*)(F.ws + WS_MIX) + 512,
                                                                  (dsa::bf16*)(F.ws + WS_MIX + 32 * MiB), (const dsa::u32x2*)(F.ws + WS_BIG + BG_MASK), F.ldsg); } break;
        case K_LRU_A: if constexpr (EN(K_LRU_A)) { phase_lru<0>(F); } break;
        case K_LRU_B: if constexpr (EN(K_LRU_B)) { phase_lru<1>(F); } break;
        case K_GLA_A: if constexpr (EN(K_GLA_A)) { phase_gla_a(F); } break;
        case K_GLA_B: if constexpr (EN(K_GLA_B)) { phase_gla_b(F); } break;
        case K_GLA_C: if constexpr (EN(K_GLA_C)) { phase_gla_c(F); } break;
        case K_VT: if constexpr (EN(K_VT)) { phase_vt(F); } break;
        case K_XSOFTMAX: if constexpr (EN(K_XSOFTMAX)) { phase_xsoftmax(F); } break;
        default: break;
        }
        }
#if !MK_PER_PHASE
        if (ph + 1 < args.ph_hi) {
            if (ph == 0) { cg::this_grid().sync(); }
            XcdBarrier bb = bar; { unsigned long long p = (unsigned long long)(uintptr_t)bb.bar; unsigned lo = (unsigned)p, hi = (unsigned)(p >> 32), xx = bb.x; asm volatile("" : "+v"(lo), "+v"(hi), "+v"(xx));
                bb.bar = (unsigned*)(uintptr_t)((unsigned long long)RFL(lo) | ((unsigned long long)RFL(hi) << 32)); bb.x = RFL(xx); }
            xcd_barrier(bb);
        }
#endif
    }
}

extern "C" void kernel_launch(void* const* d_in, const int* in_sizes, int n_in, void* d_out, int out_size, void* d_ws, size_t ws_size, hipStream_t stream) {
    static int grid = 0;
    if (grid == 0) {
        if (n_in != 25 || in_sizes[0] != T * D || out_size != T * D || ws_size < WS_END) { fprintf(stderr, "kernel_launch: unexpected shapes (n_in %d, in0 %d, out %d, ws %zu); nothing launched\n", n_in, n_in > 0 ? in_sizes[0] : -1, out_size, ws_size); grid = -1; return; }
        int dev = 0, cus = 0, per_cu = 0;
        if (hipGetDevice(&dev) != hipSuccess || hipDeviceGetAttribute(&cus, hipDeviceAttributeMultiprocessorCount, dev) != hipSuccess) { grid = -1; return; }
        if (hipFuncSetAttribute((const void*)mk_fwd, hipFuncAttributeMaxDynamicSharedMemorySize, LDS_BYTES) != hipSuccess) { fprintf(stderr, "kernel_launch: hipFuncSetAttribute failed\n"); grid = -1; return; }
        if (hipOccupancyMaxActiveBlocksPerMultiprocessor(&per_cu, (const void*)mk_fwd, NTHREADS, LDS_BYTES) != hipSuccess || per_cu < 1) { fprintf(stderr, "kernel_launch: occupancy query says %d\n", per_cu); (void)hipGetLastError(); grid = -1; return; }
        grid = cus;
    }
    if (grid < 0) return;
    (void)hipMemsetAsync((char*)d_ws + WS_CTL, 0, CTL_BYTES, stream);
    Args a{};
    for (int i = 0; i < 25; ++i) a.in[i] = (const float*)d_in[i];
    a.out = (float*)d_out; a.ws = (unsigned char*)d_ws;
#if MK_PER_PHASE
    for (int ph = 0; ph < NPHASES; ++ph) { a.ph_lo = ph; a.ph_hi = ph + 1; hipLaunchKernelGGL(mk_fwd, dim3(grid), dim3(NTHREADS), LDS_BYTES, stream, a); }
#else
    a.ph_lo = 0; a.ph_hi = NPHASES;
    void* kargs[] = {&a};
    hipError_t e = hipLaunchCooperativeKernel((const void*)mk_fwd, dim3(grid), dim3(NTHREADS), kargs, LDS_BYTES, stream);
    if (e != hipSuccess) fprintf(stderr, "cooperative launch failed: %s (grid %d)\n", hipGetErrorString(e), grid);
#endif
}
```

```cpp
#include <hip/hip_runtime.h>
#include <hip/hip_cooperative_groups.h>
#include <hip/hip_bf16.h>
#include <cmath>
#include <cstdio>
#include <cstdint>
namespace cg = cooperative_groups;

#ifndef MK_PER_PHASE
#define MK_PER_PHASE 0
#endif
#ifndef NAIVE_GEMM
#define NAIVE_GEMM 0
#endif

#define LAS __attribute__((address_space(3)))
#define GAS __attribute__((address_space(1)))
typedef unsigned short bf16_t;
typedef short bf16x8 __attribute__((ext_vector_type(8)));
typedef float f32x4 __attribute__((ext_vector_type(4)));
typedef float f32x2 __attribute__((ext_vector_type(2)));
typedef unsigned u32x4 __attribute__((ext_vector_type(4)));
typedef unsigned u32x2 __attribute__((ext_vector_type(2)));

constexpr int NB = 4, SEQ = 4096, T = NB * SEQ, D = 1024, FF = 2816;
constexpr int NE = 2560, NO = 3328;
constexpr int YQ = 0, YCKV = 512, YQI = 768, YKI = 1280, YWI = 1344, YGATE = 1536, YXB = 2048;
constexpr int ZQ = 0, ZK = 512, ZV = 1024, ZG = 2048, ZR = 2304;
constexpr float EPS = 1e-6f;
constexpr float C2 = 0.125f * 1.4426950408889634f;

constexpr size_t MiB = 1u << 20;
constexpr size_t WS_CTL = 0, CTL_BYTES = 1 * MiB;
constexpr size_t WS_MEMN0 = 1 * MiB, WS_MEMN1 = 3 * MiB, WS_KX0 = 5 * MiB, WS_KX1 = 7 * MiB, WS_VT0 = 9 * MiB, WS_LRUA = 11 * MiB, WS_LRUH = 11 * MiB + 512 * 1024, WS_DEC = 12 * MiB, WS_VT1 = 13 * MiB;
constexpr size_t WS_W = 17 * MiB;
constexpr size_t W_GU = 0, W_DN = 44 * MiB, W_Q = 66 * MiB, W_KV = 70 * MiB, W_O = 78 * MiB, W_EIN = 82 * MiB, W_UKV = 87 * MiB, W_EOUT = 87 * MiB + 512 * 1024,
                 W_OIN = 89 * MiB + 512 * 1024, W_OOUT = 96 * MiB;
constexpr size_t WS_A = 115 * MiB, WS_F = 147 * MiB;
constexpr size_t WS_BIG = 179 * MiB;
constexpr size_t WS_MIX = 283 * MiB;
constexpr size_t WS_END = 347 * MiB;
constexpr size_t AF_QD = 0, AF_KRT = 16 * MiB, AF_ATT = 32 * MiB;
constexpr size_t BG_Y = 0, BG_CKVN = 80 * MiB, BG_MASK = 88 * MiB;
constexpr size_t BG_Q = 0, BG_S = 32 * MiB;
constexpr size_t BG_H = 0;
constexpr int CW_BAR = 4096;

__device__ __forceinline__ float bf2f(bf16_t v) { return __uint_as_float((unsigned)v << 16); }
__device__ __forceinline__ unsigned f2bf(float f) { unsigned u = __float_as_uint(f); return (u + 0x7fffu + ((u >> 16) & 1u)) >> 16; }
__device__ __forceinline__ unsigned pk2(float lo, float hi) { return f2bf(lo) | (f2bf(hi) << 16); }
__device__ __forceinline__ float wave_sum(float v) {
#pragma unroll
    for (int o = 1; o < 64; o <<= 1) v += __shfl_xor(v, o);
    return v;
}
__device__ __forceinline__ float wave_max(float v) {
#pragma unroll
    for (int o = 1; o < 64; o <<= 1) v = fmaxf(v, __shfl_xor(v, o));
    return v;
}
__device__ __forceinline__ float sigmoidf_(float x) { return 1.0f / (1.0f + __expf(-x)); }

namespace pg8 {
constexpr int BM = 256, BK = 64, HALF = 128, HTB = HALF * BK * 2, STAGE_BYTES = 8 * HTB, NXCD = 8, WGM = 8;
__host__ __device__ __forceinline__ int lds_byte(int r, int c) { const int st = (r >> 4) * 2 + (c >> 5), rr = r & 15, cc = c & 31, ob = rr * 64 + cc * 2; return st * 1024 + (ob ^ (((ob >> 9) & 1) << 5)); }
__host__ __device__ __forceinline__ void stage_rc(int b, int& R, int& C) { const int st = b / 1024, sb = b % 1024, swz = sb ^ (((sb >> 9) & 1) << 5); R = (st >> 1) * 16 + swz / 64; C = (st & 1) * 32 + (swz % 64) / 2; }
__host__ __device__ __forceinline__ int perm32(int rho) { const int n = rho >> 4, i = rho & 15; return 8 * (i >> 2) + 4 * n + (i & 3); }

struct Unit { int pm, pn; };
struct Gemm {
    const bf16_t* A; const bf16_t* Bt; int lda, ldb, K, nM, nN; int a_pn_off, b_pn_off, b_batch_off, bshift;
    __device__ __forceinline__ const char* a_ptr(const Unit& u) const { return (const char*)(A + (size_t)u.pm * BM * lda + (size_t)u.pn * a_pn_off); }
    __device__ __forceinline__ const char* b_ptr(const Unit& u) const { return (const char*)(Bt + (size_t)u.pn * b_pn_off + (size_t)(u.pm >> bshift) * b_batch_off); }
};
__device__ __forceinline__ Gemm plain_gemm(const bf16_t* A, int lda, const bf16_t* Bt, int ldb, int M, int N, int K) {
    Gemm g; g.A = A; g.Bt = Bt; g.lda = lda; g.ldb = ldb; g.K = K; g.nM = M / BM; g.nN = N / BM; g.a_pn_off = 0; g.b_pn_off = BM * ldb; g.b_batch_off = 0; g.bshift = 30; return g;
}
struct StaticOrder {
    int nM, nN, nwg, G, c;
    __device__ void init(int nM_, int nN_, int G_, int c_) { nM = nM_; nN = nN_; nwg = nM * nN; G = G_; c = c_; }
    __device__ bool next(int i, Unit& u) const {
        const long L = (long)i * G + c; if (L >= nwg) return false;
        int wgid = (int)L; { const int q = nwg / NXCD, r = nwg % NXCD, xcd = wgid % NXCD, off = wgid / NXCD; wgid = (xcd < r ? xcd * (q + 1) : r * (q + 1) + (xcd - r) * q) + off; }
        const int nig = WGM * nN, gid = wgid / nig, fm = gid * WGM, gsz = (nM - fm) < WGM ? (nM - fm) : WGM;
        u.pm = fm + ((wgid % nig) % gsz); u.pn = (wgid % nig) / gsz; return true;
    }
};
__device__ __forceinline__ unsigned cvt_pk_bf16(float lo, float hi) { unsigned r; asm volatile("v_cvt_pk_bf16_f32 %0, %1, %2" : "=v"(r) : "v"(lo), "v"(hi)); return r; }

struct EpiBf16 {
    static constexpr bool PERM = true;
    bf16_t* O; int ldc; float scale;
    __device__ __forceinline__ void operator()(const f32x4 (&acc)[2][2][4][2], const Unit& u, int wr, int wc, int fr, int fq) const {
        const int row0 = u.pm * BM + wr * 64 + fr, col0 = u.pn * BM + wc * 32 + 8 * fq;
#pragma unroll
        for (int ai = 0; ai < 2; ++ai)
#pragma unroll
            for (int m = 0; m < 4; ++m) { bf16_t* rowp = O + (size_t)(row0 + ai * HALF + m * 16) * ldc + col0;
#pragma unroll
                for (int bj = 0; bj < 2; ++bj) { const f32x4 v0 = acc[ai][bj][m][0] * scale, v1 = acc[ai][bj][m][1] * scale;
                    u32x4 w; w.x = cvt_pk_bf16(v0[0], v0[1]); w.y = cvt_pk_bf16(v0[2], v0[3]); w.z = cvt_pk_bf16(v1[0], v1[1]); w.w = cvt_pk_bf16(v1[2], v1[3]);
                    *(u32x4*)(rowp + bj * HALF) = w; } }
    }
    __device__ __forceinline__ void elem(int row, int col, float a0, float) const { O[(size_t)row * ldc + col] = (bf16_t)f2bf(a0 * scale); }
};
struct EpiSwiglu {
    static constexpr bool PERM = true;
    bf16_t* O; int ldc;
    __device__ __forceinline__ void operator()(const f32x4 (&acc)[2][2][4][2], const Unit& u, int wr, int wc, int fr, int fq) const {
        const int row0 = u.pm * BM + wr * 64 + fr, col0 = u.pn * HALF + wc * 32 + 8 * fq;
#pragma unroll
        for (int ai = 0; ai < 2; ++ai)
#pragma unroll
            for (int m = 0; m < 4; ++m) { bf16_t* rowp = O + (size_t)(row0 + ai * HALF + m * 16) * ldc + col0; float o[8];
#pragma unroll
                for (int n = 0; n < 2; ++n)
#pragma unroll
                    for (int i = 0; i < 4; ++i) { const float g = acc[ai][0][m][n][i], uu = acc[ai][1][m][n][i]; o[4 * n + i] = g * __builtin_amdgcn_rcpf(1.0f + __expf(-g)) * uu; }
                u32x4 w; w.x = cvt_pk_bf16(o[0], o[1]); w.y = cvt_pk_bf16(o[2], o[3]); w.z = cvt_pk_bf16(o[4], o[5]); w.w = cvt_pk_bf16(o[6], o[7]);
                *(u32x4*)rowp = w; }
    }
    __device__ __forceinline__ void elem(int row, int j, float g, float uu) const { O[(size_t)row * ldc + j] = (bf16_t)f2bf(g / (1.0f + __expf(-g)) * uu); }
};

struct EpiAny {
    static constexpr bool PERM = true;
    bf16_t* O; int ldc; float scale; int mode;
    __device__ __forceinline__ void operator()(const f32x4 (&acc)[2][2][4][2], const Unit& u, int wr, int wc, int fr, int fq) const {
        if (mode == 0) { EpiBf16 E{O, ldc, scale}; E(acc, u, wr, wc, fr, fq); } else { EpiSwiglu E{O, ldc}; E(acc, u, wr, wc, fr, fq); }
    }
};
template <class Epi, bool ALIGN_EPI>
__device__ __forceinline__ void gemm_phase(LAS unsigned char* lds, const Gemm g, const StaticOrder& S, const Epi& E, const int tid) {
    const int wid = __builtin_amdgcn_readfirstlane(tid >> 6), lane = tid & 63, wr = wid >> 2, wc = wid & 3, fr = lane & 15, fq = lane >> 4;
    const int K = g.K, nt = K / BK;
    unsigned voffA[2], voffB[2];
#pragma unroll
    for (int i = 0; i < 2; ++i) { int R, C; stage_rc(tid * 16 + i * 8192, R, C); const int Rb = Epi::PERM ? ((R & ~31) + perm32(R & 31)) : R;
        voffA[i] = (unsigned)(R * g.lda + C) * 2u; voffB[i] = (unsigned)(Rb * g.ldb + C) * 2u; }
    const size_t kstep = (size_t)(BK * 2);
    const size_t hstepA = (size_t)HALF * g.lda * 2, hstepB = (size_t)HALF * g.ldb * 2;
    const unsigned ldsw = (unsigned)wid * 1024u;
    const int aoff = lds_byte(wr * 64 + fr, fq * 8), boff = lds_byte(wc * 32 + fr, fq * 8);
#define PG8_SA(b, h) (((b) * 2 + (h)) * HTB)
#define PG8_SB(b, h) ((4 + (b) * 2 + (h)) * HTB)
#define PG8_STAGE(bufoff, gbase, voff) do { _Pragma("unroll") for (int _i = 0; _i < 2; ++_i) \
        __builtin_amdgcn_global_load_lds((const unsigned*)((const char*)(gbase) + (voff)[_i]), (LAS unsigned*)(lds + (bufoff) + ldsw + _i * 8192), 16, 0, 0); } while (0)
#define PG8_LDA(dst, b, h) do { _Pragma("unroll") for (int m = 0; m < 4; ++m) _Pragma("unroll") for (int k = 0; k < 2; ++k) dst[m][k] = *(const LAS bf16x8*)(lds + PG8_SA(b, h) + aoff + m * 2048 + k * 1024); } while (0)
#define PG8_LDB(dst, b, h) do { _Pragma("unroll") for (int n = 0; n < 2; ++n) _Pragma("unroll") for (int k = 0; k < 2; ++k) dst[n][k] = *(const LAS bf16x8*)(lds + PG8_SB(b, h) + boff + n * 2048 + k * 1024); } while (0)
#define PG8_MMA(ai, bj, At, Bt) do { __builtin_amdgcn_s_setprio(1); _Pragma("unroll") for (int m = 0; m < 4; ++m) _Pragma("unroll") for (int n = 0; n < 2; ++n) _Pragma("unroll") for (int k = 0; k < 2; ++k) \
        acc[ai][bj][m][n] = __builtin_amdgcn_mfma_f32_16x16x32_bf16(Bt[n][k], At[m][k], acc[ai][bj][m][n], 0, 0, 0); __builtin_amdgcn_s_setprio(0); } while (0)
#define PG8_WAIT_V(n) asm volatile("s_waitcnt vmcnt(" #n ")" ::: "memory")
#define PG8_WAIT_L(n) asm volatile("s_waitcnt lgkmcnt(" #n ")" ::: "memory")
#define PG8_BAR __builtin_amdgcn_s_barrier()
#define PG8_SCHED __builtin_amdgcn_sched_barrier(0)
    Unit cur, nxt; int ui = 0;
    if (!S.next(0, cur)) return;
    f32x4 acc[2][2][4][2];
#pragma unroll
    for (int a = 0; a < 2; ++a)
#pragma unroll
        for (int b = 0; b < 2; ++b)
#pragma unroll
            for (int m = 0; m < 4; ++m)
#pragma unroll
                for (int n = 0; n < 2; ++n) acc[a][b][m][n] = (f32x4){0.f, 0.f, 0.f, 0.f};
    bf16x8 At[4][2], B0[2][2], B1[2][2];
    const char* cA = g.a_ptr(cur); const char* cB = g.b_ptr(cur);
    PG8_STAGE(PG8_SB(0, 0), cB, voffB); PG8_STAGE(PG8_SB(0, 1), cB + hstepB, voffB); PG8_STAGE(PG8_SA(0, 0), cA, voffA); PG8_STAGE(PG8_SA(0, 1), cA + hstepA, voffA);
    if (wr == 1) PG8_BAR;
    PG8_WAIT_V(2); PG8_BAR;
    PG8_STAGE(PG8_SB(1, 0), cB + kstep, voffB); PG8_STAGE(PG8_SA(1, 0), cA + kstep, voffA); PG8_STAGE(PG8_SB(1, 1), cB + hstepB + kstep, voffB);
    PG8_WAIT_V(6); PG8_BAR;
    for (;;) {
        const bool has_next = S.next(ui + 1, nxt);
        const char* nA = has_next ? g.a_ptr(nxt) : cA; const char* nB = has_next ? g.b_ptr(nxt) : cB;
        for (int t = 0; t < nt; t += 2) {
            const bool last = (t == nt - 2);
            const char* a1 = cA + (size_t)(t + 1) * kstep;
            const char* a2 = last ? nA : cA + (size_t)(t + 2) * kstep; const char* b2 = last ? nB : cB + (size_t)(t + 2) * kstep;
            const char* a3 = a2 + kstep; const char* b3 = b2 + kstep;
            PG8_LDB(B0, 0, 0); PG8_LDB(B1, 0, 1); PG8_SCHED; PG8_LDA(At, 0, 0); PG8_STAGE(PG8_SA(1, 1), a1 + hstepA, voffA);
            PG8_WAIT_V(8); PG8_WAIT_L(0); PG8_BAR; PG8_MMA(0, 0, At, B0); PG8_MMA(0, 1, At, B1); PG8_BAR; PG8_SCHED;
            PG8_LDA(At, 0, 1); PG8_STAGE(PG8_SB(0, 0), b2, voffB); PG8_STAGE(PG8_SB(0, 1), b2 + hstepB, voffB); PG8_STAGE(PG8_SA(0, 0), a2, voffA);
            PG8_WAIT_V(8); PG8_WAIT_L(0); PG8_BAR; PG8_MMA(1, 0, At, B0); PG8_MMA(1, 1, At, B1); PG8_BAR; PG8_SCHED;
            PG8_LDB(B0, 1, 0); PG8_LDB(B1, 1, 1); PG8_SCHED; PG8_LDA(At, 1, 0); PG8_STAGE(PG8_SA(0, 1), a2 + hstepA, voffA);
            PG8_WAIT_V(8); PG8_WAIT_L(0); PG8_BAR; PG8_MMA(0, 0, At, B0); PG8_MMA(0, 1, At, B1); PG8_BAR; PG8_SCHED;
            PG8_LDA(At, 1, 1); PG8_STAGE(PG8_SB(1, 0), b3, voffB); PG8_STAGE(PG8_SB(1, 1), b3 + hstepB, voffB); PG8_STAGE(PG8_SA(1, 0), a3, voffA);
            PG8_WAIT_V(8); PG8_WAIT_L(0); PG8_BAR; PG8_MMA(1, 0, At, B0); PG8_MMA(1, 1, At, B1); PG8_BAR; PG8_SCHED;
        }
        if constexpr (ALIGN_EPI) { if (wr == 0) PG8_BAR; }
        { Unit eu = cur; asm volatile("" : "+s"(eu.pm), "+s"(eu.pn));
          E(acc, eu, wr, wc, fr, fq); }
        if (!has_next) break;
#pragma unroll
        for (int a = 0; a < 2; ++a)
#pragma unroll
            for (int b = 0; b < 2; ++b)
#pragma unroll
                for (int m = 0; m < 4; ++m)
#pragma unroll
                    for (int n = 0; n < 2; ++n) acc[a][b][m][n] = (f32x4){0.f, 0.f, 0.f, 0.f};
        cur = nxt; cA = nA; cB = nB; ++ui;
        if constexpr (ALIGN_EPI) { if (wr == 1) PG8_BAR; }
    }
    PG8_WAIT_V(0);
    if constexpr (!ALIGN_EPI) { if (wr == 0) PG8_BAR; }
    PG8_BAR;
#undef PG8_SA
#undef PG8_SB
#undef PG8_STAGE
#undef PG8_LDA
#undef PG8_LDB
#undef PG8_MMA
#undef PG8_WAIT_V
#undef PG8_WAIT_L
#undef PG8_BAR
#undef PG8_SCHED
}

template <int NPAN, class Epi>
__device__ __forceinline__ void gemm_naive(LAS unsigned char* lds8, const Gemm g, const Epi& E, int nblk, int bid, const int tid) {
    LAS float* As = (LAS float*)lds8; LAS float* Bs = As + 64 * 33;
    const int ty = tid >> 4, tx = tid & 15;
    const int ntm = g.nM * 4, ntn = (NPAN == 2) ? g.nN * 2 : g.nN * 4;
    for (int tile = bid; tile < ntm * ntn; tile += nblk) {
        const int tm = tile / ntn, tn = tile % ntn;
        Unit u; u.pm = tm >> 2; u.pn = (NPAN == 2) ? (tn >> 1) : (tn >> 2);
        const bf16_t* Ab = (const bf16_t*)g.a_ptr(u) + (size_t)(tm & 3) * 64 * g.lda;
        const bf16_t* Bb = (const bf16_t*)g.b_ptr(u) + (size_t)((NPAN == 2) ? (tn & 1) * 64 : (tn & 3) * 64) * g.ldb;
        float acc[NPAN][2][4];
#pragma unroll
        for (int p = 0; p < NPAN; ++p)
#pragma unroll
            for (int r = 0; r < 2; ++r)
#pragma unroll
                for (int i = 0; i < 4; ++i) acc[p][r][i] = 0.f;
        const int lr = tid >> 3, lk = (tid & 7) * 4;
        for (int k0 = 0; k0 < g.K; k0 += 32) {
            { const u32x2 v = *(const u32x2*)(Ab + (size_t)lr * g.lda + k0 + lk);
              As[lr * 33 + lk] = __uint_as_float(v.x << 16); As[lr * 33 + lk + 1] = __uint_as_float(v.x & 0xffff0000u); As[lr * 33 + lk + 2] = __uint_as_float(v.y << 16); As[lr * 33 + lk + 3] = __uint_as_float(v.y & 0xffff0000u); }
#pragma unroll
            for (int p = 0; p < NPAN; ++p) { const u32x2 v = *(const u32x2*)(Bb + (size_t)(lr + p * 128) * g.ldb + k0 + lk); LAS float* B_ = Bs + p * 64 * 33;
              B_[lr * 33 + lk] = __uint_as_float(v.x << 16); B_[lr * 33 + lk + 1] = __uint_as_float(v.x & 0xffff0000u); B_[lr * 33 + lk + 2] = __uint_as_float(v.y << 16); B_[lr * 33 + lk + 3] = __uint_as_float(v.y & 0xffff0000u); }
            __syncthreads();
            for (int kk = 0; kk < 32; ++kk) { const float a0 = As[ty * 33 + kk], a1 = As[(ty + 32) * 33 + kk];
#pragma unroll
                for (int p = 0; p < NPAN; ++p)
#pragma unroll
                    for (int i = 0; i < 4; ++i) { const float b = Bs[p * 64 * 33 + (tx + 16 * i) * 33 + kk]; acc[p][0][i] += a0 * b; acc[p][1][i] += a1 * b; } }
            __syncthreads();
        }
#pragma unroll
        for (int r = 0; r < 2; ++r)
#pragma unroll
            for (int i = 0; i < 4; ++i) { const int row = tm * 64 + ty + 32 * r, col = tn * 64 + tx + 16 * i;
                E.elem(row, col, acc[0][r][i], NPAN == 2 ? acc[NPAN - 1][r][i] : 0.f); }
    }
}
}

#define XB_TMO      128
#define XB_XCNT(j)  (256  + 64 * (j))
#define XB_XSUB(j)  (1280 + 64 * (j))
#define XB_XGEN(j)  (2304 + 64 * (j))
#define XB_TOP      3328
#define XB_TOPGEN   3392
#define XCD_BAR_WORDS 3456
#define XB_SPIN_CAP (1u << 18)
__device__ __forceinline__ unsigned xb_ld(unsigned* p)              { return __hip_atomic_load(p, __ATOMIC_RELAXED, __HIP_MEMORY_SCOPE_AGENT); }
__device__ __forceinline__ unsigned xb_add(unsigned* p, unsigned v) { return __hip_atomic_fetch_add(p, v, __ATOMIC_RELAXED, __HIP_MEMORY_SCOPE_AGENT); }
__device__ __forceinline__ unsigned xb_xcc_id() { return (unsigned)__builtin_amdgcn_s_getreg((3 << 11) | 20) & 0xFu; }
#define XB_SPIN(cond, bar) do { unsigned _sp = 0; while (cond) { __builtin_amdgcn_s_sleep(1); \
    if ((++_sp & 255u) == 0u) { if (xb_ld(&(bar)[XB_TMO])) break; if (_sp > XB_SPIN_CAP) { atomicAdd(&(bar)[XB_TMO], 1u); break; } } } } while (0)
struct XcdBarrier { unsigned* bar; unsigned x; volatile LAS unsigned* st; };
__device__ __forceinline__ XcdBarrier xcd_barrier_post(unsigned* bar, volatile LAS unsigned* st) {
    XcdBarrier b; b.bar = bar; b.x = xb_xcc_id(); b.st = st;
    if (threadIdx.x == 0) (void)xb_add(&bar[XB_XCNT(b.x)], 1u);
    return b;
}
__device__ __forceinline__ void xcd_barrier_complete(unsigned* bar, unsigned x, unsigned& nloc, unsigned& nx) {
    const unsigned G = gridDim.x * gridDim.y * gridDim.z;
    unsigned sum, cnt, mine, sp = 0u;
    for (;;) {
        sum = 0u; cnt = 0u; mine = 0u;
#pragma unroll
        for (unsigned j = 0; j < 16; ++j) { const unsigned c = xb_ld(&bar[XB_XCNT(j)]); sum += c; cnt += (c > 0u) ? 1u : 0u; mine = (j == x) ? c : mine; }
        if (sum == G) break;
        __builtin_amdgcn_s_sleep(1);
        if ((++sp & 255u) == 0u) { if (xb_ld(&bar[XB_TMO])) break; if (sp > XB_SPIN_CAP) { atomicAdd(&bar[XB_TMO], 1u); break; } }
    }
    nloc = mine > 0u ? mine : 1u; nx = cnt > 0u ? cnt : 1u;
}
__device__ __forceinline__ void xcd_barrier(const XcdBarrier& b) {
    asm volatile("s_waitcnt vmcnt(0)" ::: "memory");
    __syncthreads();
    if (threadIdx.x == 0) {
        unsigned* bar = b.bar;
        __builtin_amdgcn_s_waitcnt(0);
        unsigned nloc = b.st[0], nx = b.st[1];
        if (nloc == 0u) { xcd_barrier_complete(bar, b.x, nloc, nx); b.st[0] = nloc; b.st[1] = nx; }
        const unsigned old = xb_add(&bar[XB_XSUB(b.x)], 1u);
        const unsigned gen = old / nloc;
        if (old + 1u == (gen + 1u) * nloc) {
            __builtin_amdgcn_fence(__ATOMIC_RELEASE, "agent");
            asm volatile("s_waitcnt vmcnt(0)" ::: "memory");
            const unsigned og = xb_add(&bar[XB_TOP], 1u);
            const unsigned tg = og / nx;
            if (og + 1u == (tg + 1u) * nx) xb_add(&bar[XB_TOPGEN], 1u);
            else XB_SPIN(xb_ld(&bar[XB_TOPGEN]) == tg, bar);
            __builtin_amdgcn_fence(__ATOMIC_ACQUIRE, "agent");
            xb_add(&bar[XB_XGEN(b.x)], 1u);
            asm volatile("s_waitcnt vmcnt(0)" ::: "memory");
        } else {
            XB_SPIN(xb_ld(&bar[XB_XGEN(b.x)]) == gen, bar);
            __builtin_amdgcn_fence(__ATOMIC_ACQUIRE, "agent");
            asm volatile("s_waitcnt vmcnt(0)" ::: "memory");
        }
    }
    __syncthreads();
}

namespace dsa {
using bf16=__hip_bfloat16;
using bf16x8=__attribute__((ext_vector_type(8)))short;
using s16x4=__attribute__((ext_vector_type(4)))short;
using f32x16=__attribute__((ext_vector_type(16)))float;
using u32x4=__attribute__((ext_vector_type(4)))unsigned;
using u32x2=__attribute__((ext_vector_type(2)))unsigned;
constexpr int BATCH=4,NHEAD=8,SEQ=4096,D=64,QP=2560,KP=1024,OP=1024;
constexpr int NW=8,QBLK=32,QB=QBLK*NW,KVBLK=64,NQB=SEQ/QB;
__device__ __forceinline__ int crow(int r,int hi){return (r&3)+8*(r>>2)+4*hi;}
#define SBAR() __builtin_amdgcn_sched_barrier(0)
__device__ __forceinline__ void bmask(f32x16&p0,f32x16&p1,unsigned w0,unsigned w1,int hi){
  const int s0=(int)(w0>>(4*hi)), s1=(int)(w1>>(4*hi));
  #pragma unroll
  for(int r=0;r<16;++r){const unsigned pos=(r&3)+8*(r>>2);
    const unsigned m0=(unsigned)__builtin_amdgcn_sbfe(s0,pos,1u), m1=(unsigned)__builtin_amdgcn_sbfe(s1,pos,1u);
    p0[r]=__uint_as_float((__float_as_uint(p0[r])&m0)|(~m0&0xff800000u)); p1[r]=__uint_as_float((__float_as_uint(p1[r])&m1)|(~m1&0xff800000u));}
}

constexpr int NSLOT=3, SLOTB=8192;
constexpr int LDS_K=0, LDS_V=NSLOT*SLOTB, LDS_WS=2*NSLOT*SLOTB, LDS_OST=LDS_WS+NW*64*4, LDS_BYTES=LDS_OST+NW*4096;
constexpr float C2=0.125f*1.4426950408889634f;
__device__ __forceinline__ void glds16(const void*gsrc,unsigned lds_dst){unsigned keep;
  asm volatile("s_mov_b32 %0, m0\n\ts_mov_b32 m0, %2\n\ts_nop 0\n\tglobal_load_lds_dwordx4 %1, off\n\ts_mov_b32 m0, %0":"=&s"(keep):"v"(gsrc),"s"(lds_dst):"memory");}
__device__ __forceinline__ float max3f(float a,float b,float c){float r;asm("v_max3_f32 %0, %1, %2, %3":"=v"(r):"v"(a),"v"(b),"v"(c));return r;}
__device__ __forceinline__ float max2f(float a,float b){float r;asm("v_max_f32_e32 %0, %1, %2":"=v"(r):"v"(a),"v"(b));return r;}
__device__ __forceinline__ float fadd_s(float a,float b){float r;asm("v_add_f32_e32 %0, %1, %2":"=v"(r):"v"(a),"v"(b));return r;}
__device__ __forceinline__ float fsub_s(float a,float b){float r;asm("v_sub_f32_e32 %0, %1, %2":"=v"(r):"v"(a),"v"(b));return r;}
typedef float f32x2_t __attribute__((ext_vector_type(2))); typedef __bf16 bf16x2_t __attribute__((ext_vector_type(2)));
__device__ __forceinline__ unsigned cvtpk_s(float lo,float hi){f32x2_t v={lo,hi};bf16x2_t b=__builtin_convertvector(v,bf16x2_t);return __builtin_bit_cast(unsigned,b);}
#define WAIT_BAR(N) asm volatile("s_waitcnt vmcnt(" #N ") lgkmcnt(0)\n\ts_barrier":::"memory")
#define WAIT_BAR_M(N,M) asm volatile("s_waitcnt vmcnt(" #N ") lgkmcnt(0)\n\ts_barrier":"+v"(M)::"memory")

__device__ __forceinline__ void qkt(f32x16&p0,f32x16&p1,const char*Kslot,const bf16x8*qr,int r32,int hi){
  const char*kb=Kslot+hi*1024+r32*16;
  #pragma unroll
  for(int d0=0;d0<4;++d0){
    const bf16x8 b0=*reinterpret_cast<const bf16x8*>(kb+d0*2048);
    const bf16x8 b1=*reinterpret_cast<const bf16x8*>(kb+d0*2048+512);
    if(d0==0){p0=__builtin_amdgcn_mfma_f32_32x32x16_bf16(b0,qr[0],f32x16{},0,0,0);p1=__builtin_amdgcn_mfma_f32_32x32x16_bf16(b1,qr[0],f32x16{},0,0,0);}
    else{p0=__builtin_amdgcn_mfma_f32_32x32x16_bf16(b0,qr[d0],p0,0,0,0);p1=__builtin_amdgcn_mfma_f32_32x32x16_bf16(b1,qr[d0],p1,0,0,0);}}
}
typedef __attribute__((address_space(3))) const char* lds_cptr;
typedef short v4i16_t __attribute__((ext_vector_type(4)));
__device__ __forceinline__ void kload8(bf16x8*kf,lds_cptr kp){
  kf[0]=*(const __attribute__((address_space(3))) bf16x8*)(kp);      kf[1]=*(const __attribute__((address_space(3))) bf16x8*)(kp+512);
  kf[2]=*(const __attribute__((address_space(3))) bf16x8*)(kp+2048); kf[3]=*(const __attribute__((address_space(3))) bf16x8*)(kp+2560);
  kf[4]=*(const __attribute__((address_space(3))) bf16x8*)(kp+4096); kf[5]=*(const __attribute__((address_space(3))) bf16x8*)(kp+4608);
  kf[6]=*(const __attribute__((address_space(3))) bf16x8*)(kp+6144); kf[7]=*(const __attribute__((address_space(3))) bf16x8*)(kp+6656);
}
__device__ __forceinline__ void kload2(bf16x8*kf,lds_cptr kp,int j){ kf[2*j]=*(const __attribute__((address_space(3))) bf16x8*)(kp+j*2048); kf[2*j+1]=*(const __attribute__((address_space(3))) bf16x8*)(kp+j*2048+512); }
__device__ __forceinline__ s16x4 vtr(lds_cptr p){ return __builtin_bit_cast(s16x4,__builtin_amdgcn_ds_read_tr16_b64_v4i16((__attribute__((address_space(3))) v4i16_t*)p)); }
__device__ __forceinline__ float rowmax(const f32x16&p0,const f32x16&p1){
  float a=max3f(p0[0],p0[1],p1[0]),b=max3f(p0[2],p0[3],p1[1]);a=max3f(a,p1[2],p1[3]);
  #pragma unroll
  for(int r=4;r<16;r+=4){a=max3f(a,p0[r],p0[r+1]);b=max3f(b,p0[r+2],p0[r+3]);a=max3f(a,p1[r],p1[r+1]);b=max3f(b,p1[r+2],p1[r+3]);}
  const float m=max2f(a,b);
  auto rr=__builtin_amdgcn_permlane32_swap(__float_as_uint(m),__float_as_uint(m),false,false);
  return max2f(__uint_as_float(rr[0]),__uint_as_float(rr[1]));
}
__device__ __forceinline__ void pv(f32x16*o,int vb,bf16x8 pa0,bf16x8 pa1,bf16x8 pa2,bf16x8 pa3){
  #pragma unroll
  for(int d0=0;d0<2;++d0){s16x4 lo[4],hi[4];
    #pragma unroll
    for(int ks=0;ks<4;++ks){
      asm volatile("ds_read_b64_tr_b16 %0,%1 offset:%c2":"=&v"(lo[ks]):"v"(vb),"i"(d0*4096+ks*1024):"memory");
      asm volatile("ds_read_b64_tr_b16 %0,%1 offset:%c2":"=&v"(hi[ks]):"v"(vb),"i"(d0*4096+ks*1024+512):"memory");}
    asm volatile("s_waitcnt lgkmcnt(0)":::"memory");SBAR();
    #define PK(k) (bf16x8){lo[k][0],lo[k][1],lo[k][2],lo[k][3],hi[k][0],hi[k][1],hi[k][2],hi[k][3]}
    o[d0]=__builtin_amdgcn_mfma_f32_32x32x16_bf16(pa0,PK(0),o[d0],0,0,0);
    o[d0]=__builtin_amdgcn_mfma_f32_32x32x16_bf16(pa1,PK(1),o[d0],0,0,0);
    o[d0]=__builtin_amdgcn_mfma_f32_32x32x16_bf16(pa2,PK(2),o[d0],0,0,0);
    o[d0]=__builtin_amdgcn_mfma_f32_32x32x16_bf16(pa3,PK(3),o[d0],0,0,0);
    #undef PK
  }
}

#ifndef ATTN_STORE16
#define ATTN_STORE16(p,v) (*(u32x4*)(p)=(v))
#endif
template<int THRL> __device__ __forceinline__ void attn_unit(const int tid,int b,int h,int qb,const bf16*Q,const bf16*__restrict__ K,const bf16*__restrict__ V,bf16*O,const u32x2*__restrict__ MT,char*shm){
  const int lane=tid&63,r32=lane&31,hi=lane>>5; const int wid=__builtin_amdgcn_readfirstlane(tid>>6);
  const long rowbase=(long)b*SEQ; const int q0=qb*QB;
  const bf16*Qw=Q+(rowbase+q0+wid*QBLK)*QP+h*D;
  const bf16*Kh=K+rowbase*KP+h*D,*Vh=V+rowbase*KP+h*D;
  const unsigned lds0=(unsigned)(uintptr_t)shm;
  float*wsf=(float*)(shm+LDS_WS)+wid*64;
  const bf16*ksrc=Kh+(long)lane*KP+wid*8;
  const bf16*vsrc=Vh+(long)(16*(wid&3)+(lane>>2))*KP+(wid>>2)*32+(lane&3)*8;
  const unsigned kdst=lds0+LDS_K+wid*1024, vdst=lds0+LDS_V+wid*1024;
  #define DMA_K(t,slot) glds16(ksrc+(long)(t)*KVBLK*KP,(unsigned)__builtin_amdgcn_readfirstlane(kdst+(slot)))
  #define DMA_V(t,slot) glds16(vsrc+(long)(t)*KVBLK*KP,(unsigned)__builtin_amdgcn_readfirstlane(vdst+(slot)))
  const int vb0=(int)(lds0+LDS_V)+((lane>>4)&1)*32+(lane&3)*8+(4*hi+((lane&15)>>2))*64;
  const char*Kbase=shm+LDS_K; bf16x8 kf[8];
  const lds_cptr shm3=(lds_cptr)shm; const lds_cptr kp0=shm3+LDS_K+hi*1024+r32*16; const lds_cptr vp0=shm3+LDS_V+((lane>>4)&1)*32+(lane&3)*8+(4*hi+((lane&15)>>2))*64;
  const int NT=(q0+QB)/KVBLK;
  const u32x2*mq=MT+(long)b*64*SEQ+q0+wid*QBLK+r32;
  u32x2 mA=mq[0],mB=mq[SEQ]; asm volatile("s_waitcnt vmcnt(0)":"+v"(mA),"+v"(mB)::"memory");
  #define MLD(M,t) asm volatile("global_load_dwordx2 %0, %1, off":"=v"(M):"v"(mq+(long)(t)*SEQ):"memory")
  DMA_K(0,0);DMA_V(0,0);DMA_K(1,SLOTB);
  bf16x8 qr[4];
  #pragma unroll
  for(int d0=0;d0<4;++d0)qr[d0]=*reinterpret_cast<const bf16x8*>(&Qw[(long)r32*QP+d0*16+hi*8]);
  float mhat=0.f,l_reg=0.f;f32x16 o[2];o[0]=f32x16{};o[1]=f32x16{};
  const int qrel=wid*QBLK+r32;
  #define CMASK(P0,P1,M) bmask(P0,P1,M.x,M.y,hi)
  bool resc=false;
  #define START(P0,P1) do{ const float rm=rowmax(P0,P1); resc=false; \
    { const float dl=__builtin_fmaxf(rm,-64.f); mhat=fadd_s(mhat,dl); \
      _Pragma("unroll") for(int r=0;r<16;++r){P0[r]=fsub_s(P0[r],dl);P1[r]=fsub_s(P1[r],dl);} } \
    _Pragma("unroll") for(int r=0;r<16;++r)P0[r]=__builtin_amdgcn_exp2f(P0[r]); }while(0)
  #define RESC() do{ if(resc){ asm volatile("s_waitcnt lgkmcnt(0)":::"memory"); \
      _Pragma("unroll") for(int d_=0;d_<2;++d_) _Pragma("unroll") for(int r=0;r<16;++r)o[d_][r]*=wsf[crow(r,hi)]; } }while(0)
  f32x16 pA0,pA1,pB0,pB1;
  int sl_prev=0,sl_cur=0,sl_next=SLOTB;
  #define ROT() do{sl_prev=sl_cur;sl_cur=sl_next;sl_next=(sl_next==(NSLOT-1)*SLOTB)?0:sl_next+SLOTB;}while(0)
  DMA_K(2,2*SLOTB);
  WAIT_BAR(3);
  qkt(pA0,pA1,Kbase,qr,r32,hi);asm volatile("s_nop 15\n\ts_nop 7":"+v"(pA0),"+v"(pA1));CMASK(pA0,pA1,mA);
  START(pA0,pA1);
  _Pragma("unroll") for(int r=0;r<16;++r)pA1[r]=__builtin_amdgcn_exp2f(pA1[r]);
  WAIT_BAR(0);
  DMA_K(3,0);DMA_V(1,SLOTB);
  ROT();
  kload8(kf,kp0+sl_cur);
  WAIT_BAR(2);
  s16x4 vl0,vh0,vl1,vh1,vl2,vh2; u32x4 pw0,pw1,pw2,pw3;
  #define PKW(P,B) cvtpk_s(P[B],P[B+1])
  #define PAF(k) __builtin_bit_cast(bf16x8,pw##k)
  #define VFRB(b) (bf16x8){vl##b[0],vl##b[1],vl##b[2],vl##b[3],vh##b[0],vh##b[1],vh##b[2],vh##b[3]}
  #define PIN(x) asm volatile("":"+v"(x))
  #define MX3(a,b,c) __builtin_fmaxf(__builtin_fmaxf((a),(b)),(c))
  #define GAPA(MF,A0,A1,A2,A3,W0,W1,PW) do{ MF; sacc+=A0; sacc+=A1; sacc+=A2; sacc+=A3; PIN(sacc); W0; W1; PIN(PW); SBAR(); }while(0)
  #define EX(v) __builtin_amdgcn_exp2f(v)
  #define GAPB(MF,X,B) do{ MF; X[B]=EX(X[B]); X[B+1]=EX(X[B+1]); X[B+2]=EX(X[B+2]); X[B+3]=EX(X[B+3]); PIN(X); SBAR(); }while(0)
  #define VRDB(b,i) do{ vl##b=vtr(vp_+(((i)>>2)*4096+((i)&3)*1024)); vh##b=vtr(vp_+(((i)>>2)*4096+((i)&3)*1024+512)); SBAR(); }while(0)
  #define KRD(G,j) do{ if(G){ kload2(kf,kp0+sl_next,j); SBAR(); } }while(0)
  #define STEP(C0,C1,P0,P1,t,GK,GV,GL,MC,MN) do{ SBAR(); if(GV){MLD(MN,(t)+1);} SBAR(); \
    const lds_cptr vp_=vp0+sl_prev; \
    float sacc=(P0[0]+P0[1]); \
    GAPA(C0=__builtin_amdgcn_mfma_f32_32x32x16_bf16(kf[0],qr[0],f32x16{},0,0,0), P0[2],P0[3],P0[4],P0[5],     pw0[0]=PKW(P0,0), pw0[1]=PKW(P0,2), pw0); \
    GAPA(C1=__builtin_amdgcn_mfma_f32_32x32x16_bf16(kf[1],qr[0],f32x16{},0,0,0), P0[6],P0[7],P0[8],P0[9],     pw0[2]=PKW(P0,4), pw0[3]=PKW(P0,6), pw0); \
    GAPA(C0=__builtin_amdgcn_mfma_f32_32x32x16_bf16(kf[2],qr[1],C0,0,0,0),   P0[10],P0[11],P0[12],P0[13], pw1[0]=PKW(P0,8), pw1[1]=PKW(P0,10), pw1); \
    GAPA(C1=__builtin_amdgcn_mfma_f32_32x32x16_bf16(kf[3],qr[1],C1,0,0,0),   P0[14],P0[15],P1[0],P1[1],   pw1[2]=PKW(P0,12),pw1[3]=PKW(P0,14), pw1); \
    KRD(GL,0); \
    GAPA(C0=__builtin_amdgcn_mfma_f32_32x32x16_bf16(kf[4],qr[2],C0,0,0,0),   P1[2],P1[3],P1[4],P1[5],     pw2[0]=PKW(P1,0), pw2[1]=PKW(P1,2), pw2); \
    GAPA(C1=__builtin_amdgcn_mfma_f32_32x32x16_bf16(kf[5],qr[2],C1,0,0,0),   P1[6],P1[7],P1[8],P1[9],     pw2[2]=PKW(P1,4), pw2[3]=PKW(P1,6), pw2); \
    KRD(GL,1); \
    GAPA(C0=__builtin_amdgcn_mfma_f32_32x32x16_bf16(kf[6],qr[3],C0,0,0,0),   P1[10],P1[11],P1[12],P1[13], pw3[0]=PKW(P1,8), pw3[1]=PKW(P1,10), pw3); \
    GAPA(C1=__builtin_amdgcn_mfma_f32_32x32x16_bf16(kf[7],qr[3],C1,0,0,0),   P1[14],P1[15],0.f,0.f,       pw3[2]=PKW(P1,12),pw3[3]=PKW(P1,14), pw3); \
    KRD(GL,2); KRD(GL,3); \
    l_reg+=sacc; \
    if(GK){DMA_K((t)+3,sl_cur);} if(GV){DMA_V((t)+1,sl_next);} \
    VRDB(0,0); VRDB(1,4); \
    CMASK(C0,C1,MC); \
    { float a=MX3(C0[0],C0[1],C1[0]),b=MX3(C0[2],C0[3],C1[1]); a=MX3(a,C1[2],C1[3]); \
      _Pragma("unroll") for(int r=4;r<16;r+=4){a=MX3(a,C0[r],C0[r+1]);b=MX3(b,C0[r+2],C0[r+3]);a=MX3(a,C1[r],C1[r+1]);b=MX3(b,C1[r+2],C1[r+3]);} \
      float rm=__builtin_fmaxf(a,b); { auto rr=__builtin_amdgcn_permlane32_swap(__float_as_uint(rm),__float_as_uint(rm),false,false); rm=__builtin_fmaxf(__uint_as_float(rr[0]),__uint_as_float(rr[1])); } \
      rm-=mhat; resc=false;     \
      if(__builtin_expect(__any(rm>(float)THRL),0)){ const float dl=__builtin_fmaxf(rm,0.f); mhat+=dl; \
        const float f=__builtin_amdgcn_exp2f(-dl); l_reg*=f; if(hi==0)wsf[r32]=f; resc=true; } \
      _Pragma("unroll") for(int r=0;r<16;++r){C0[r]-=mhat;C1[r]-=mhat;} } \
    SBAR(); \
    VRDB(2,1); GAPB(o[0]=__builtin_amdgcn_mfma_f32_32x32x16_bf16(PAF(0),VFRB(0),o[0],0,0,0), C0,0); \
    VRDB(0,5); GAPB(o[1]=__builtin_amdgcn_mfma_f32_32x32x16_bf16(PAF(0),VFRB(1),o[1],0,0,0), C0,4); \
    VRDB(1,2); GAPB(o[0]=__builtin_amdgcn_mfma_f32_32x32x16_bf16(PAF(1),VFRB(2),o[0],0,0,0), C0,8); \
    VRDB(2,6); GAPB(o[1]=__builtin_amdgcn_mfma_f32_32x32x16_bf16(PAF(1),VFRB(0),o[1],0,0,0), C0,12); \
    VRDB(0,3); GAPB(o[0]=__builtin_amdgcn_mfma_f32_32x32x16_bf16(PAF(2),VFRB(1),o[0],0,0,0), C1,0); \
    VRDB(1,7); GAPB(o[1]=__builtin_amdgcn_mfma_f32_32x32x16_bf16(PAF(2),VFRB(2),o[1],0,0,0), C1,4); \
    GAPB(o[0]=__builtin_amdgcn_mfma_f32_32x32x16_bf16(PAF(3),VFRB(0),o[0],0,0,0), C1,8); \
    GAPB(o[1]=__builtin_amdgcn_mfma_f32_32x32x16_bf16(PAF(3),VFRB(1),o[1],0,0,0), C1,12); \
    }while(0)
  int t=1;
  for(;t+5<NT;t+=2){
    STEP(pB0,pB1,pA0,pA1,t,true,true,true,mB,mA);     WAIT_BAR_M(2,mA); RESC(); ROT();
    STEP(pA0,pA1,pB0,pB1,t+1,true,true,true,mA,mB);   WAIT_BAR_M(2,mB); RESC(); ROT();
  }
  #define ENDW(tt,M) do{ if((tt)+3<NT){WAIT_BAR_M(2,M);} else if((tt)+2<NT){WAIT_BAR_M(1,M);} else {WAIT_BAR_M(0,M);} }while(0)
  for(;t+1<NT;t+=2){
    STEP(pB0,pB1,pA0,pA1,t,(t+3<NT),(t+1<NT),(t+1<NT),mB,mA);       ENDW(t,mA);   RESC(); ROT();
    STEP(pA0,pA1,pB0,pB1,t+1,(t+4<NT),(t+2<NT),(t+2<NT),mA,mB);     ENDW(t+1,mB); RESC(); ROT();
  }
  STEP(pB0,pB1,pA0,pA1,NT-1,false,false,false,mB,mA); RESC();
  { float sacc=pB0[0]+pB0[1]; _Pragma("unroll") for(int r=2;r<16;++r)sacc+=pB0[r]; _Pragma("unroll") for(int r=0;r<16;++r)sacc+=pB1[r]; l_reg+=sacc;
    pw0=(u32x4){PKW(pB0,0),PKW(pB0,2),PKW(pB0,4),PKW(pB0,6)};pw1=(u32x4){PKW(pB0,8),PKW(pB0,10),PKW(pB0,12),PKW(pB0,14)};pw2=(u32x4){PKW(pB1,0),PKW(pB1,2),PKW(pB1,4),PKW(pB1,6)};pw3=(u32x4){PKW(pB1,8),PKW(pB1,10),PKW(pB1,12),PKW(pB1,14)};
    SBAR(); pv(o,vb0+sl_cur,PAF(0),PAF(1),PAF(2),PAF(3)); }
  #undef PKW
  #undef PAF
  #undef VFRB
  #undef PIN
  #undef MX3
  #undef GAPA
  #undef GAPB
  #undef EX
  #undef VRDB
  #undef KRD
  #undef STEP
  #undef ENDW
  {auto rr=__builtin_amdgcn_permlane32_swap(__float_as_uint(l_reg),__float_as_uint(l_reg),false,false);l_reg=__uint_as_float(rr[0])+__uint_as_float(rr[1]);}
  if(hi==0)wsf[32+r32]=l_reg;asm volatile("s_waitcnt lgkmcnt(0)":::"memory");
  float rli[16];
  #pragma unroll
  for(int r=0;r<16;++r)rli[r]=__builtin_amdgcn_rcpf(wsf[32+crow(r,hi)]);
  bf16*Ow=O+(rowbase+q0+wid*QBLK)*OP+h*D;
  { bf16*stg=(bf16*)(shm+LDS_OST)+wid*2048;
    #pragma unroll
    for(int r=0;r<16;++r){const int orow=crow(r,hi);
      #pragma unroll
      for(int d0=0;d0<2;++d0)stg[orow*64+d0*32+r32]=__float2bfloat16(o[d0][r]*rli[r]);}
    asm volatile("s_waitcnt lgkmcnt(0)":::"memory");
    #pragma unroll
    for(int i=0;i<4;++i){const int row=i*8+(lane>>3),ch=lane&7; const u32x4 v=*(const u32x4*)(stg+row*64+ch*8); ATTN_STORE16(Ow+(long)row*OP+ch*8,v);} }
  asm volatile("s_waitcnt lgkmcnt(0)\n\ts_barrier":::"memory");
  #undef DMA_K
  #undef DMA_V
  #undef CMASK
  #undef MLD
  #undef START
  #undef RESC
  #undef ROT
}
constexpr int ATTN_LDS_BYTES=LDS_BYTES;
template<int THRL=8> __device__ __forceinline__ void attn_phase(const int tid,int grid,int block,const bf16*Q,const bf16*K,const bf16*V,bf16*O,const u32x2*MT,char*lds){
  for(int i=0;;++i){ const int u=i*grid+block; if(u>=BATCH*NHEAD*NQB)break; int bh,qb;
    if(grid==256){ const int vcu=(block%8)*(grid/8)+block/8, s=vcu&7; bh=vcu>>3; qb=i?15-s:s; } else { bh=u/NQB; qb=NQB-1-(u%NQB); }
    bh=__builtin_amdgcn_readfirstlane(bh); qb=__builtin_amdgcn_readfirstlane(qb);
    attn_unit<THRL>(tid,bh/NHEAD,bh%NHEAD,qb,Q,K,V,O,MT,lds); }
}
#undef SBAR
#undef WAIT_BAR
#undef WAIT_BAR_M
}
constexpr int NWAVES = 8, NTHREADS = 512;
constexpr int RING_BYTES = 131072, HIST_OFF = RING_BYTES, DESC_OFF = RING_BYTES + 8704, MISC_OFF = DESC_OFF + 6144, LDS_BYTES = 147456;
constexpr int DESC_WORDS = 32;
struct Args { const float* in[25]; float* out; unsigned char* ws; int ph_lo, ph_hi; };
struct Ctx {
    LAS unsigned char* lds; char* ldsg; int tid, lane, wave, nblk, bid;
    float* out; unsigned char* ws; const __attribute__((address_space(4))) void* kp;
};
#define inp(i) (((const float* const __attribute__((address_space(4)))*)F.kp)[i])
enum { I_X = 0, I_MEM, I_NORMS, I_WGU, I_WDN, I_XQ, I_XKV, I_XO, I_EIN, I_EKVN, I_EUK, I_EUV, I_ECW, I_ECB, I_ERA, I_EBRA, I_ERI, I_EBRI, I_ELAM, I_EOUT, I_OIN, I_OG2, I_OBG, I_OHN, I_OOUT };
enum { N_FFN1_PRE = 0, N_FFN1_POST, N_MIX_PRE, N_MIX_POST, N_XA_PRE, N_XA_POST, N_MEM_NORM, N_FFN2_PRE, N_FFN2_POST };

struct TJob { const float* W; int K, Nsrc; bf16_t* WT; int c0, nc, r0, mode; float scale; };
__device__ __forceinline__ void transpose_item(const TJob& J, int item, LAS float* scr, int lane) {
    const int nblk = (J.nc + 31) / 32, kb = item / nblk, nb = item % nblk, k0 = 64 * kb, n0 = 32 * nb;
    const int cl = n0 + (lane & 7) * 4; const bool okc = cl < J.nc;
#pragma unroll
    for (int i = 0; i < 8; ++i) { const int kk = 8 * i + (lane >> 3); f32x4 v = {0.f, 0.f, 0.f, 0.f}; if (okc) v = *(const f32x4*)(J.W + (size_t)(k0 + kk) * J.Nsrc + J.c0 + cl);
        LAS float* sp = scr + kk * 33 + (lane & 7) * 4; sp[0] = v.x * J.scale; sp[1] = v.y * J.scale; sp[2] = v.z * J.scale; sp[3] = v.w * J.scale; }
    asm volatile("s_waitcnt lgkmcnt(0)" ::: "memory");
    const int c = lane & 7;
#pragma unroll
    for (int j = 0; j < 4; ++j) { const int n = (lane >> 3) + 8 * j; const LAS float* s = scr + (8 * c) * 33 + n;
        u32x4 o; o.x = pk2(s[0 * 33], s[1 * 33]); o.y = pk2(s[2 * 33], s[3 * 33]); o.z = pk2(s[4 * 33], s[5 * 33]); o.w = pk2(s[6 * 33], s[7 * 33]);
        const int cc = n0 + n;
        if (cc < J.nc) { int row; if (J.mode == 0) row = J.r0 + cc; else { const int cg = J.c0 + cc, bj = cg / FF, jj = cg % FF; row = 256 * (jj / 128) + 128 * bj + (jj % 128); }
            *(u32x4*)(J.WT + (size_t)row * J.K + k0 + 8 * c) = o; } }
    asm volatile("s_waitcnt lgkmcnt(0)" ::: "memory");
}
constexpr int NJOBS = 4 + 4 + 6 + 7 + 2 + 1 + 5 + 1;
__device__ __forceinline__ TJob get_job(const Ctx& F, int j) {
    TJob J; J.mode = 0; J.scale = 1.f; J.c0 = 0; J.r0 = 0;
    bf16_t* Wb = (bf16_t*)(F.ws + WS_W);
    if (j < 4) { J.W = inp(I_WGU) + (size_t)j * D * 2 * FF; J.K = D; J.Nsrc = 2 * FF; J.nc = 2 * FF; J.WT = (bf16_t*)((unsigned char*)Wb + W_GU) + (size_t)j * 2 * FF * D; J.mode = 1; return J; }
    j -= 4;
    if (j < 4) { J.W = inp(I_WDN) + (size_t)j * FF * D; J.K = FF; J.Nsrc = D; J.nc = D; J.WT = (bf16_t*)((unsigned char*)Wb + W_DN) + (size_t)j * D * FF; return J; }
    j -= 4;
    if (j < 6) { const int l = j & 1, w = j >> 1;
        if (w == 0) { J.W = inp(I_XQ) + (size_t)l * D * D; J.K = D; J.Nsrc = D; J.nc = D; J.WT = (bf16_t*)((unsigned char*)Wb + W_Q) + (size_t)l * D * D; }
        else if (w == 1) { J.W = inp(I_XKV) + (size_t)l * D * 2 * D; J.K = D; J.Nsrc = 2 * D; J.nc = 2 * D; J.WT = (bf16_t*)((unsigned char*)Wb + W_KV) + (size_t)l * 2 * D * D; }
        else { J.W = inp(I_XO) + (size_t)l * D * D; J.K = D; J.Nsrc = D; J.nc = D; J.WT = (bf16_t*)((unsigned char*)Wb + W_O) + (size_t)l * D * D; }
        return J; }
    j -= 6;
    if (j < 7) { J.W = inp(I_EIN); J.K = D; J.Nsrc = 2376; J.WT = (bf16_t*)((unsigned char*)Wb + W_EIN);
        switch (j) { case 0: J.c0 = 0; J.nc = 512; J.r0 = YQ; J.scale = C2; break; case 1: J.c0 = 512; J.nc = 256; J.r0 = YCKV; break; case 2: J.c0 = 768; J.nc = 512; J.r0 = YQI; break;
                     case 3: J.c0 = 1280; J.nc = 64; J.r0 = YKI; break; case 4: J.c0 = 1344; J.nc = 8; J.r0 = YWI; break; case 5: J.c0 = 1352; J.nc = 512; J.r0 = YGATE; break; default: J.c0 = 1864; J.nc = 512; J.r0 = YXB; break; }
        return J; }
    j -= 7;
    if (j < 2) { J.W = (j == 0) ? inp(I_EUK) : inp(I_EUV); J.K = 256; J.Nsrc = 512; J.nc = 512; J.WT = (bf16_t*)((unsigned char*)Wb + W_UKV); J.r0 = 512 * j; return J; }
    j -= 2;
    if (j < 1) { J.W = inp(I_EOUT); J.K = D; J.Nsrc = D; J.nc = D; J.WT = (bf16_t*)((unsigned char*)Wb + W_EOUT); return J; }
    j -= 1;
    if (j < 5) { J.W = inp(I_OIN); J.K = D; J.Nsrc = 3088; J.WT = (bf16_t*)((unsigned char*)Wb + W_OIN);
        switch (j) { case 0: J.c0 = 0; J.nc = 512; J.r0 = ZQ; break; case 1: J.c0 = 512; J.nc = 512; J.r0 = ZK; break; case 2: J.c0 = 1024; J.nc = 1024; J.r0 = ZV; break;
                     case 3: J.c0 = 2048; J.nc = 16; J.r0 = ZG; break; default: J.c0 = 2064; J.nc = 1024; J.r0 = ZR; break; }
        return J; }
    J.W = inp(I_OOUT); J.K = D; J.Nsrc = D; J.nc = D; J.WT = (bf16_t*)((unsigned char*)Wb + W_OOUT); return J;
}
__device__ __forceinline__ void rms_row_to_bf16(const float* xrow, const float* gain, bf16_t* orow, int lane) {
    const f32x4* xr = (const f32x4*)xrow + lane; f32x4 v[4]; float s = 0.f;
#pragma unroll
    for (int j = 0; j < 4; ++j) { v[j] = xr[64 * j]; s += (v[j].x * v[j].x + v[j].y * v[j].y) + (v[j].z * v[j].z + v[j].w * v[j].w); }
    const float rstd = 1.0f / sqrtf(wave_sum(s) * (1.f / D) + EPS);
    u32x2* o8 = (u32x2*)orow + lane;
#pragma unroll
    for (int j = 0; j < 4; ++j) { const f32x4 gg = ((const f32x4*)gain)[lane + 64 * j]; u32x2 w; w.x = pk2(v[j].x * rstd * gg.x, v[j].y * rstd * gg.y); w.y = pk2(v[j].z * rstd * gg.z, v[j].w * rstd * gg.w); o8[64 * j] = w; }
}
__device__ __forceinline__ void phase_prep(const Ctx& F) {
    LAS float* scr = (LAS float*)(F.lds + F.wave * 16384);
    const int gw = F.bid * NWAVES + F.wave, NGW = F.nblk * NWAVES;
    int total = 0;
    for (int j = 0; j < NJOBS; ++j) { const TJob J = get_job(F, j); total += (J.K / 64) * ((J.nc + 31) / 32); }
    for (int it = gw; it < total; it += NGW) {
        int r = it, j = 0; TJob J = get_job(F, 0);
        for (;;) { const int n = (J.K / 64) * ((J.nc + 31) / 32); if (r < n) break; r -= n; ++j; J = get_job(F, j); }
        transpose_item(J, r, scr, F.lane);
    }
    { bf16_t* We = (bf16_t*)(F.ws + WS_W + W_EIN) + (size_t)1352 * D; bf16_t* Wo = (bf16_t*)(F.ws + WS_W + W_OIN) + (size_t)2064 * D;
      const int ne = 184 * D / 8, no = 240 * D / 8; const int gt = F.bid * NTHREADS + F.tid, NGT = F.nblk * NTHREADS;
      for (int i = gt; i < ne + no; i += NGT) { unsigned zz = 0u; asm volatile("" : "+v"(zz)); u32x4 z = {zz, zz, zz, zz}; if (i < ne) ((u32x4*)We)[i] = z; else ((u32x4*)Wo)[i - ne] = z; } }
    for (int m = gw; m < 2 * 1024 + T; m += NGW) {
        if (m < 2048) { const int l = m >> 10, r = m & 1023; rms_row_to_bf16(inp(I_MEM) + (size_t)r * D, inp(I_NORMS) + (size_t)(l * 9 + N_MEM_NORM) * D, (bf16_t*)(F.ws + (l ? WS_MEMN1 : WS_MEMN0)) + (size_t)r * D, F.lane); }
        else { const int r = m - 2048; rms_row_to_bf16(inp(I_X) + (size_t)r * D, inp(I_NORMS) + (size_t)N_FFN1_PRE * D, (bf16_t*)(F.ws + WS_A) + (size_t)r * D, F.lane); }
    }
}

__device__ __forceinline__ void phase_norm(const Ctx& F, const bf16_t* Fb, const float* hin, float* hout, float coef, const float* gpost, const float* gpre, bf16_t* Aout) {
    const int gw = F.bid * NWAVES + F.wave, NGW = F.nblk * NWAVES, lane = F.lane;
    for (int m = gw; m < T; m += NGW) {
        const u32x2* fr = (const u32x2*)(Fb + (size_t)m * D) + lane; f32x4 f[4]; float s = 0.f;
#pragma unroll
        for (int j = 0; j < 4; ++j) { const u32x2 w = fr[64 * j]; f[j].x = __uint_as_float(w.x << 16); f[j].y = __uint_as_float(w.x & 0xffff0000u); f[j].z = __uint_as_float(w.y << 16); f[j].w = __uint_as_float(w.y & 0xffff0000u);
            s += (f[j].x * f[j].x + f[j].y * f[j].y) + (f[j].z * f[j].z + f[j].w * f[j].w); }
        const float rstd = coef / sqrtf(wave_sum(s) * (1.f / D) + EPS);
        f32x4 h[4]; float s2 = 0.f;
#pragma unroll
        for (int j = 0; j < 4; ++j) { const f32x4 hv = ((const f32x4*)(hin + (size_t)m * D))[lane + 64 * j]; const f32x4 gg = ((const f32x4*)gpost)[lane + 64 * j];
            h[j] = hv + f[j] * rstd * gg; ((f32x4*)(hout + (size_t)m * D))[lane + 64 * j] = h[j];
            s2 += (h[j].x * h[j].x + h[j].y * h[j].y) + (h[j].z * h[j].z + h[j].w * h[j].w); }
        if (gpre) { const float r2 = 1.0f / sqrtf(wave_sum(s2) * (1.f / D) + EPS); u32x2* o8 = (u32x2*)(Aout + (size_t)m * D) + lane;
#pragma unroll
            for (int j = 0; j < 4; ++j) { const f32x4 gg = ((const f32x4*)gpre)[lane + 64 * j]; u32x2 w; w.x = pk2(h[j].x * r2 * gg.x, h[j].y * r2 * gg.y); w.y = pk2(h[j].z * r2 * gg.z, h[j].w * r2 * gg.w); o8[64 * j] = w; } }
    }
}

__device__ __forceinline__ void phase_ckvn(const Ctx& F) {
    const bf16_t* Y = (const bf16_t*)(F.ws + WS_BIG + BG_Y); bf16_t* O = (bf16_t*)(F.ws + WS_BIG + BG_CKVN); const float* gn = inp(I_EKVN);
    const int gw = F.bid * NWAVES + F.wave, NGW = F.nblk * NWAVES, lane = F.lane;
    for (int m = gw; m < T; m += NGW) {
        const u32x2 w = ((const u32x2*)(Y + (size_t)m * NE + YCKV))[lane];
        const float a = __uint_as_float(w.x << 16), b = __uint_as_float(w.x & 0xffff0000u), c = __uint_as_float(w.y << 16), d = __uint_as_float(w.y & 0xffff0000u);
        const float rstd = 1.0f / sqrtf(wave_sum(a * a + b * b + c * c + d * d) * (1.f / 256.f) + EPS);
        const f32x4 gg = ((const f32x4*)gn)[lane]; u32x2 o; o.x = pk2(a * rstd * gg.x, b * rstd * gg.y); o.y = pk2(c * rstd * gg.z, d * rstd * gg.w);
        ((u32x2*)(O + (size_t)m * 256))[lane] = o;
    }
}

__device__ __forceinline__ unsigned f2ord(float f) { const unsigned u = __float_as_uint(f + 0.0f); return (u & 0x80000000u) ? ~u : (u | 0x80000000u); }
typedef float f32x16 __attribute__((ext_vector_type(16)));
__device__ __forceinline__ void phase_idx(const Ctx& F) {
    const bf16_t* Y = (const bf16_t*)(F.ws + WS_BIG + BG_Y);
    u32x2* MT = (u32x2*)(F.ws + WS_BIG + BG_MASK);
    LAS float* sc = (LAS float*)F.lds;
    LAS unsigned* hist = (LAS unsigned*)(F.lds + HIST_OFF) + F.wave * 264;
    const int lane = F.lane, wave = F.wave, c = lane & 31, h2 = lane >> 5;
    for (int unit = F.bid; unit < T / 8; unit += F.nblk) {
        const int b = unit / 512, qg = 511 - (unit % 512); const int t0 = qg * 8, nkeys = t0 + 8;
        const size_t rowb = (size_t)b * SEQ;
        const int t = t0 + wave, n = t + 1;
        u32x2* mrow = MT + (size_t)b * 64 * SEQ + t;
        if (nkeys <= 256) {
            const int lo = lane * 64; unsigned long long bits = 0ull; if (lo + 63 <= t) bits = ~0ull; else if (lo <= t) bits = (2ull << (t - lo)) - 1ull;
            u32x2 w; w.x = (unsigned)bits; w.y = (unsigned)(bits >> 32); mrow[(size_t)lane * SEQ] = w;
            continue;
        }
        {
            bf16x8 afr[2][4]; float wq[2][16];
            const int head = (c & 3) + 4 * ((c >> 3) & 1), ql = ((c >> 2) & 1) + 2 * (c >> 4);
#pragma unroll
            for (int rt = 0; rt < 2; ++rt) { const bf16_t* qrow = Y + (rowb + t0 + rt * 4 + ql) * NE + YQI + head * 64 + 8 * h2;
#pragma unroll
                for (int ks = 0; ks < 4; ++ks) afr[rt][ks] = *(const bf16x8*)(qrow + 16 * ks);
#pragma unroll
                for (int r = 0; r < 16; ++r) wq[rt][r] = bf2f(Y[(rowb + t0 + rt * 4 + h2 + 2 * (r >> 3)) * NE + YWI + (r & 7)]); }
            const int nkt = (nkeys + 31) >> 5;
            for (int kt = wave; kt < nkt; kt += 8) {
                const bf16_t* krow = Y + (rowb + kt * 32 + c) * NE + YKI + 8 * h2;
                bf16x8 bfr[4];
#pragma unroll
                for (int ks = 0; ks < 4; ++ks) bfr[ks] = *(const bf16x8*)(krow + 16 * ks);
#pragma unroll
                for (int rt = 0; rt < 2; ++rt) { f32x16 acc = {};
#pragma unroll
                    for (int ks = 0; ks < 4; ++ks) acc = __builtin_amdgcn_mfma_f32_32x32x16_bf16(afr[rt][ks], bfr[ks], acc, 0, 0, 0);
                    float s0 = 0.f, s1 = 0.f;
#pragma unroll
                    for (int r = 0; r < 8; ++r) { s0 += fmaxf(acc[r], 0.f) * wq[rt][r]; s1 += fmaxf(acc[8 + r], 0.f) * wq[rt][8 + r]; }
                    sc[(rt * 4 + h2) * 4096 + kt * 32 + c] = s0; sc[(rt * 4 + h2 + 2) * 4096 + kt * 32 + c] = s1; }
            }
        }
        __syncthreads();
        {
            LAS float* row = sc + wave * 4096;
            unsigned u[64]; int nv = n - lane; asm volatile("" : "+v"(nv));
#pragma unroll
            for (int j = 0; j < 64; ++j) { u[j] = (64 * j < nv) ? f2ord(row[lane + 64 * j]) : 0u; }
            unsigned prefix = 0u; int kk = 256;
#pragma unroll
            for (int pass = 0; pass < 4; ++pass) {
                const int shift = 24 - 8 * pass;
                for (int i = lane; i < 264; i += 64) hist[i] = 0u;
                asm volatile("s_waitcnt lgkmcnt(0)" ::: "memory");
#pragma unroll
                for (int j = 0; j < 64; ++j) { const bool match = (pass == 0) ? (u[j] != 0u) : ((u[j] >> (shift + 8)) == (prefix >> (shift + 8)) && u[j] != 0u);
                    if (match) atomicAdd((unsigned*)&hist[(u[j] >> shift) & 255u], 1u); }
                asm volatile("s_waitcnt lgkmcnt(0)" ::: "memory");
                const unsigned c0 = hist[4 * lane], c1 = hist[4 * lane + 1], c2 = hist[4 * lane + 2], c3 = hist[4 * lane + 3];
                const unsigned tot = c0 + c1 + c2 + c3; unsigned suf = tot;
#pragma unroll
                for (int o = 1; o < 64; o <<= 1) { const unsigned v = __shfl_down(suf, o); if (lane + o < 64) suf += v; }
                unsigned above = suf - tot;
                const unsigned cs[4] = {c0, c1, c2, c3};
#pragma unroll
                for (int bb = 3; bb >= 0; --bb) { if ((int)above < kk && (int)(above + cs[bb]) >= kk) { hist[256] = (unsigned)(4 * lane + bb); hist[257] = (unsigned)(kk - (int)above); } above += cs[bb]; }
                asm volatile("s_waitcnt lgkmcnt(0)" ::: "memory");
                const unsigned dsel = hist[256]; kk = (int)hist[257];
                prefix |= dsel << shift;
                asm volatile("s_waitcnt lgkmcnt(0)" ::: "memory");
            }
            int eqseen = 0; u32x2 myw = {0u, 0u}; const unsigned long long lt = (1ull << lane) - 1ull;
#pragma unroll
            for (int j = 0; j < 64; ++j) {
                const bool gt = u[j] > prefix, eq = (u[j] == prefix);
                const unsigned long long beq = __ballot(eq);
                const int rk = eqseen + __popcll(beq & lt);
                const unsigned long long bs = __ballot(gt || (eq && rk < kk));
                if (lane == j) { myw.x = (unsigned)bs; myw.y = (unsigned)(bs >> 32); }
                eqseen += __popcll(beq);
                if ((j & 3) == 3) __builtin_amdgcn_sched_barrier(0);
            }
            mrow[(size_t)lane * SEQ] = myw;
        }
        __syncthreads();
    }
}

template <int MODE> __device__ __forceinline__ void phase_lru(const Ctx& F) {
    const bf16_t* Y = (const bf16_t*)(F.ws + WS_BIG + BG_Y); bf16_t* C = (bf16_t*)(F.ws + WS_MIX + 32 * MiB);
    float* CA = (float*)(F.ws + WS_LRUA); float* CH = (float*)(F.ws + WS_LRUH);
    const int gw = F.bid * NWAVES + F.wave, NGW = F.nblk * NWAVES, lane = F.lane;
    for (int unit = gw; unit < NB * 8 * 64; unit += NGW) {
        const int g = unit & 7, ck = (unit >> 3) & 63, b = unit >> 9; const int ch = g * 64 + lane; const size_t rowb = (size_t)b * SEQ;
        float wra[64], wri[64];
#pragma unroll
        for (int i = 0; i < 64; ++i) { wra[i] = inp(I_ERA)[(size_t)(g * 64 + i) * 64 + lane]; wri[i] = inp(I_ERI)[(size_t)(g * 64 + i) * 64 + lane]; }
        const float bra = inp(I_EBRA)[ch], bri = inp(I_EBRI)[ch], lam = inp(I_ELAM)[ch], cb = inp(I_ECB)[ch];
        const float cw0 = inp(I_ECW)[ch], cw1 = inp(I_ECW)[512 + ch], cw2 = inp(I_ECW)[1024 + ch], cw3 = inp(I_ECW)[1536 + ch];
        const float spl = log1pf(__expf(-lam));
        const int t0 = ck * 64;
        float x3 = (t0 >= 3) ? bf2f(Y[(rowb + t0 - 3) * NE + YXB + ch]) : 0.f, x2 = (t0 >= 2) ? bf2f(Y[(rowb + t0 - 2) * NE + YXB + ch]) : 0.f, x1 = (t0 >= 1) ? bf2f(Y[(rowb + t0 - 1) * NE + YXB + ch]) : 0.f;
        float hst = 0.f, aprod = 1.f;
        if (MODE == 1) { for (int c = 0; c < ck; ++c) { const float a = CA[((size_t)b * 64 + c) * 512 + ch], hh = CH[((size_t)b * 64 + c) * 512 + ch]; hst = a * hst + hh; } }
        for (int tt = 0; tt < 64; ++tt) {
            const size_t m = rowb + t0 + tt;
            const float x0 = bf2f(Y[m * NE + YXB + ch]);
            const float xc = cw0 * x3 + cw1 * x2 + cw2 * x1 + cw3 * x0 + cb;
            x3 = x2; x2 = x1; x1 = x0;
            float ra = bra, ri = bri;
#pragma unroll
            for (int i = 0; i < 64; ++i) { const float xi = __uint_as_float(__builtin_amdgcn_readlane(__float_as_uint(xc), i)); ra += xi * wra[i]; ri += xi * wri[i]; }
            const float r = sigmoidf_(ra), ig = sigmoidf_(ri);
            const float log_a = -8.0f * r * spl; const float a = __expf(log_a); const float bb = sqrtf(-expm1f(2.0f * log_a)) * (ig * xc);
            hst = a * hst + bb; aprod *= a;
            if (MODE == 1) { const float gt = bf2f(Y[m * NE + YGATE + ch]); const float u = 0.7978845608028654f * (gt + 0.044715f * gt * gt * gt); const float ge = 0.5f * gt * (1.0f + tanhf(u));
                C[m * 1024 + 512 + ch] = (bf16_t)f2bf(hst * ge); }
        }
        if (MODE == 0) { CA[((size_t)b * 64 + ck) * 512 + ch] = aprod; CH[((size_t)b * 64 + ck) * 512 + ch] = hst; }
    }
}

__device__ __forceinline__ void phase_gla_a(const Ctx& F) {
    const bf16_t* Z = (const bf16_t*)(F.ws + WS_BIG + BG_Y);
    bf16_t* QD = (bf16_t*)(F.ws + WS_A + AF_QD); bf16_t* KRT = (bf16_t*)(F.ws + WS_A + AF_KRT); bf16_t* ATT = (bf16_t*)(F.ws + WS_A + AF_ATT); bf16_t* VT = (bf16_t*)(F.ws + WS_MIX + 32 * MiB);
    float* DEC = (float*)(F.ws + WS_DEC);
    LAS float* G = (LAS float*)F.lds;
    LAS float* qd = G + 64 * 128;
    LAS float* ki = qd + 64 * 129;
    LAS float* gl = ki + 64 * 129;
    LAS bf16_t* krt = (LAS bf16_t*)(gl + 64 * 16);
    LAS bf16_t* vtl = (LAS bf16_t*)G;
    const int tid = F.tid;
    for (int unit = F.bid; unit < NB * 64 * 4; unit += F.nblk) {
        const int h = unit & 3, n = (unit >> 2) & 63, b = unit >> 8; const size_t row0 = (size_t)b * SEQ + n * 64;
        for (int i = tid; i < 64 * 16; i += NTHREADS) gl[i] = bf2f(Z[(row0 + (i >> 4)) * NO + ZG + (i & 15)]);
        __syncthreads();
        for (int i = tid; i < 64 * 128; i += NTHREADS) { const int j = i >> 7, d = i & 127; float z = inp(I_OBG)[h * 128 + d];
#pragma unroll
            for (int r = 0; r < 16; ++r) z += gl[j * 16 + r] * inp(I_OG2)[r * 512 + h * 128 + d];
            const float ls = fminf(z, 0.f) - log1pf(__expf(-fabsf(z)));
            G[i] = ls * (1.0f / 16.0f); }
        __syncthreads();
        if (tid < 128) { float run = 0.f; for (int j = 0; j < 64; ++j) { run += G[j * 128 + tid]; G[j * 128 + tid] = run; } DEC[((size_t)b * 64 + n) * 512 + h * 128 + tid] = __expf(run); }
        __syncthreads();
        for (int i = tid; i < 64 * 128; i += NTHREADS) { const int j = i >> 7, d = i & 127; const size_t m = row0 + j;
            const float q = bf2f(Z[m * NO + ZQ + h * 128 + d]) * 0.08838834764831845f, k = bf2f(Z[m * NO + ZK + h * 128 + d]);
            const float gg = G[i], glast = G[63 * 128 + d];
            const float qdv = q * __expf(gg), kiv = k * __expf(-gg), krv = k * __expf(glast - gg);
            const bf16_t qb = (bf16_t)f2bf(qdv), kb = (bf16_t)f2bf(kiv);
            QD[(size_t)unit * 8192 + i] = qb; krt[d * 64 + j] = (bf16_t)f2bf(krv);
            qd[j * 129 + d] = bf2f(qb); ki[j * 129 + d] = bf2f(kb); }
        __syncthreads();
        for (int i = tid; i < 64 * 64; i += NTHREADS) { const int ii = i >> 6, jj = i & 63; float a = 0.f;
            if (jj <= ii) { for (int d = 0; d < 128; ++d) a += qd[ii * 129 + d] * ki[jj * 129 + d]; }
            ATT[(size_t)unit * 4096 + i] = (bf16_t)f2bf(a); }
        for (int i = tid; i < 128 * 64 / 8; i += NTHREADS) ((u32x4*)(KRT + (size_t)unit * 8192))[i] = ((const LAS u32x4*)krt)[i];
        for (int i = tid; i < 64 * 256; i += NTHREADS) { const int j = i >> 8, v = i & 255; vtl[v * 64 + j] = Z[(row0 + j) * NO + ZV + h * 256 + v]; }
        __syncthreads();
        for (int i = tid; i < 256 * 64 / 8; i += NTHREADS) ((u32x4*)(VT + (size_t)unit * 16384))[i] = ((const LAS u32x4*)vtl)[i];
        __syncthreads();
    }
}
__device__ __forceinline__ void phase_gla_b(const Ctx& F) {
    const bf16_t* QD = (const bf16_t*)(F.ws + WS_A + AF_QD); const bf16_t* KRT = (const bf16_t*)(F.ws + WS_A + AF_KRT); const bf16_t* ATT = (const bf16_t*)(F.ws + WS_A + AF_ATT); const bf16_t* VT = (const bf16_t*)(F.ws + WS_MIX + 32 * MiB);
    const float* DEC = (const float*)(F.ws + WS_DEC); bf16_t* ORAW = (bf16_t*)(F.ws + WS_MIX);
    constexpr int QP_ = 272, KP_ = 144, BUF = 64 * QP_ + 128 * KP_ + 64 * KP_;
    static_assert(2 * BUF <= RING_BYTES, "GLA_B LDS");
    const int tid = F.tid, lane = F.lane, wave = F.wave, i16 = lane & 15, g = lane >> 4;
    for (int unit = F.bid; unit < NB * 4 * 4; unit += F.nblk) {
        const int vq = unit & 3, h = (unit >> 2) & 3, b = unit >> 4; const int v0 = (vq * 4 + (wave & 3)) * 16; const bool comp = wave < 4;
        f32x4 sacc[8];
#pragma unroll
        for (int m = 0; m < 8; ++m) sacc[m] = (f32x4){0.f, 0.f, 0.f, 0.f};
        u32x4 stg[5];
        auto issue = [&](int n) { const size_t u = (size_t)(((b * 64 + n) << 2) + h);
#pragma unroll
            for (int k = 0; k < 5; ++k) { const int p = tid + 512 * k; const bf16_t* src = (k < 2) ? QD + u * 8192 + (size_t)p * 8 : (k < 4) ? KRT + u * 8192 + (size_t)(p - 1024) * 8 : ATT + u * 4096 + (size_t)(p - 2048) * 8;
                stg[k] = *(const u32x4*)src; } };
        auto commit = [&](int buf) { LAS unsigned char* base = F.lds + buf * BUF;
#pragma unroll
            for (int k = 0; k < 5; ++k) { const int p = tid + 512 * k; LAS unsigned char* dst;
                if (k < 2) dst = base + (p >> 4) * QP_ + (p & 15) * 16; else if (k < 4) { const int q = p - 1024; dst = base + 64 * QP_ + (q >> 3) * KP_ + (q & 7) * 16; } else { const int q = p - 2048; dst = base + 64 * QP_ + 128 * KP_ + (q >> 3) * KP_ + (q & 7) * 16; }
                *(LAS u32x4*)dst = stg[k]; } };
        issue(0); commit(0);
        __syncthreads();
        for (int n = 0; n < 64; ++n) {
            const size_t row0 = (size_t)b * SEQ + n * 64; const size_t u = (size_t)(((b * 64 + n) << 2) + h);
            LAS unsigned char* base = F.lds + (n & 1) * BUF; LAS unsigned char* qdl = base; LAS unsigned char* krl = base + 64 * QP_; LAS unsigned char* atl = krl + 128 * KP_;
            if (n + 1 < 64) issue(n + 1);
            if (comp) {
            bf16x8 vtf[2];
#pragma unroll
            for (int s2 = 0; s2 < 2; ++s2) vtf[s2] = *(const bf16x8*)(VT + u * 16384 + (size_t)(v0 + i16) * 64 + 32 * s2 + 8 * g);
            f32x4 dec4[8];
#pragma unroll
            for (int m = 0; m < 8; ++m) dec4[m] = *(const f32x4*)(DEC + ((size_t)b * 64 + n) * 512 + h * 128 + 16 * m + 4 * g);
            f32x4 oacc[4];
#pragma unroll
            for (int m = 0; m < 4; ++m) oacc[m] = (f32x4){0.f, 0.f, 0.f, 0.f};
#pragma unroll
            for (int m = 0; m < 4; ++m)
#pragma unroll
                for (int s2 = 0; s2 < 2; ++s2) { const bf16x8 a = *(const LAS bf16x8*)(atl + (16 * m + i16) * KP_ + (32 * s2 + 8 * g) * 2); oacc[m] = __builtin_amdgcn_mfma_f32_16x16x32_bf16(a, vtf[s2], oacc[m], 0, 0, 0); }
#pragma unroll
            for (int s4 = 0; s4 < 4; ++s4) {
                u32x4 bw; bw.x = pg8::cvt_pk_bf16(sacc[2 * s4][0], sacc[2 * s4][1]); bw.y = pg8::cvt_pk_bf16(sacc[2 * s4][2], sacc[2 * s4][3]); bw.z = pg8::cvt_pk_bf16(sacc[2 * s4 + 1][0], sacc[2 * s4 + 1][1]); bw.w = pg8::cvt_pk_bf16(sacc[2 * s4 + 1][2], sacc[2 * s4 + 1][3]);
                const bf16x8 bS = __builtin_bit_cast(bf16x8, bw);
#pragma unroll
                for (int m = 0; m < 4; ++m) { const LAS unsigned char* ap = qdl + (16 * m + i16) * QP_ + (32 * s4 + 4 * g) * 2; const u32x2 lo = *(const LAS u32x2*)ap, hi = *(const LAS u32x2*)(ap + 32);
                    u32x4 aw; aw.x = lo.x; aw.y = lo.y; aw.z = hi.x; aw.w = hi.y; oacc[m] = __builtin_amdgcn_mfma_f32_16x16x32_bf16(__builtin_bit_cast(bf16x8, aw), bS, oacc[m], 0, 0, 0); }
            }
#pragma unroll
            for (int m = 0; m < 4; ++m)
#pragma unroll
                for (int r = 0; r < 4; ++r) ORAW[(row0 + 16 * m + 4 * g + r) * 1024 + h * 256 + v0 + i16] = (bf16_t)f2bf(oacc[m][r]);
#pragma unroll
            for (int m = 0; m < 8; ++m) { sacc[m] = sacc[m] * dec4[m];
#pragma unroll
                for (int s2 = 0; s2 < 2; ++s2) { const bf16x8 a = *(const LAS bf16x8*)(krl + (16 * m + i16) * KP_ + (32 * s2 + 8 * g) * 2); sacc[m] = __builtin_amdgcn_mfma_f32_16x16x32_bf16(a, vtf[s2], sacc[m], 0, 0, 0); } }
            }
            if (n + 1 < 64) commit((n + 1) & 1);
            __syncthreads();
        }
    }
}
__device__ __forceinline__ void phase_gla_c(const Ctx& F) {
    const bf16_t* Z = (const bf16_t*)(F.ws + WS_BIG + BG_Y); const bf16_t* ORAW = (const bf16_t*)(F.ws + WS_MIX); bf16_t* C = (bf16_t*)(F.ws + WS_MIX + 32 * MiB);
    const float* hn = inp(I_OHN);
    const int gw = F.bid * NWAVES + F.wave, NGW = F.nblk * NWAVES, lane = F.lane;
    for (int m = gw; m < T; m += NGW) {
#pragma unroll
        for (int j = 0; j < 4; ++j) { const u32x2 w = ((const u32x2*)(ORAW + (size_t)m * 1024))[lane + 64 * j]; const u32x2 rw = ((const u32x2*)(Z + (size_t)m * NO + ZR))[lane + 64 * j];
            const float a = __uint_as_float(w.x << 16), bq = __uint_as_float(w.x & 0xffff0000u), c = __uint_as_float(w.y << 16), d = __uint_as_float(w.y & 0xffff0000u);
            const float rstd = 1.0f / sqrtf(wave_sum(a * a + bq * bq + c * c + d * d) * (1.f / 256.f) + EPS);
            const f32x4 gg = ((const f32x4*)hn)[lane];
            const float r0 = __uint_as_float(rw.x << 16), r1 = __uint_as_float(rw.x & 0xffff0000u), r2 = __uint_as_float(rw.y << 16), r3 = __uint_as_float(rw.y & 0xffff0000u);
            u32x2 o; o.x = pk2(a * rstd * gg.x * r0 * sigmoidf_(r0), bq * rstd * gg.y * r1 * sigmoidf_(r1)); o.y = pk2(c * rstd * gg.z * r2 * sigmoidf_(r2), d * rstd * gg.w * r3 * sigmoidf_(r3));
            ((u32x2*)(C + (size_t)m * 1024))[lane + 64 * j] = o; }
    }
}

__device__ __forceinline__ void phase_xsoftmax(const Ctx& F) {
    const bf16_t* S = (const bf16_t*)(F.ws + WS_BIG + BG_S); bf16_t* P = (bf16_t*)(F.ws + WS_MIX);
    const int gw = F.bid * NWAVES + F.wave, NGW = F.nblk * NWAVES, lane = F.lane;
    for (int m = gw; m < T; m += NGW) {
#pragma unroll
        for (int j = 0; j < 4; ++j) { const u32x2 w = ((const u32x2*)(S + (size_t)m * 1024))[lane + 64 * j];
            const float a = __uint_as_float(w.x << 16), b = __uint_as_float(w.x & 0xffff0000u), c = __uint_as_float(w.y << 16), d = __uint_as_float(w.y & 0xffff0000u);
            const float mx = wave_max(fmaxf(fmaxf(a, b), fmaxf(c, d)));
            const float ea = __expf(a - mx), eb = __expf(b - mx), ec = __expf(c - mx), ed = __expf(d - mx);
            const float inv = 1.0f / wave_sum((ea + eb) + (ec + ed));
            u32x2 o; o.x = pk2(ea * inv, eb * inv); o.y = pk2(ec * inv, ed * inv);
            ((u32x2*)(P + (size_t)m * 1024))[lane + 64 * j] = o; }
    }
}

enum Kind { K_PREP = 0, K_SWIGLU, K_GEMM, K_NORM, K_CKVN, K_IDX, K_ATT, K_LRU_A, K_LRU_B, K_GLA_A, K_GLA_B, K_GLA_C, K_VT, K_XSOFTMAX };
enum Op { OP_UP1 = 0, OP_DN1, OP_N1, OP_IN, OP_M0, OP_M1, OP_M2, OP_M3, OP_M4, OP_M5, OP_OUT, OP_N2, OP_XQ, OP_XS, OP_XSM, OP_XO, OP_XOUT, OP_N3, OP_UP2, OP_DN2, OP_N4, OP_COUNT };
constexpr int NPRE = 5;
constexpr int NPHASES = NPRE + 2 * OP_COUNT;

struct Desc { int kind; int nobar; pg8::Gemm g; bf16_t* O; int ldc; float scale; const bf16_t* Fb; const float* hin; float coef; const float* gpost; const float* gpre; };
__device__ __forceinline__ void st_ptr(LAS unsigned* p, const void* q) { const unsigned long long v = (unsigned long long)(uintptr_t)q; p[0] = (unsigned)v; p[1] = (unsigned)(v >> 32); }
__device__ __forceinline__ unsigned ld_u(const LAS unsigned* p) { return (unsigned)__builtin_amdgcn_readfirstlane((int)p[0]); }
__device__ __forceinline__ const void* ld_ptr(const LAS unsigned* p) { const unsigned long long v = (unsigned long long)ld_u(p) | ((unsigned long long)ld_u(p + 1) << 32); return (const void*)(uintptr_t)v; }
__device__ __forceinline__ void desc_store(LAS unsigned* t, const Desc& d) {
    t[27] = (unsigned)d.nobar; t[0] = (unsigned)d.kind; st_ptr(t + 1, d.g.A); st_ptr(t + 3, d.g.Bt); t[5] = d.g.lda; t[6] = d.g.ldb; t[7] = d.g.K; t[8] = d.g.nM; t[9] = d.g.nN; t[10] = d.g.a_pn_off; t[11] = d.g.b_pn_off; t[12] = d.g.b_batch_off; t[13] = d.g.bshift;
    st_ptr(t + 14, d.O); t[16] = d.ldc; t[17] = __float_as_uint(d.scale); st_ptr(t + 18, d.Fb); st_ptr(t + 20, d.hin); t[22] = __float_as_uint(d.coef); st_ptr(t + 23, d.gpost); st_ptr(t + 25, d.gpre);
}
__device__ __forceinline__ Desc desc_load(const LAS unsigned* t) {
    Desc d; d.nobar = (int)ld_u(t + 27); d.kind = (int)ld_u(t); d.g.A = (const bf16_t*)ld_ptr(t + 1); d.g.Bt = (const bf16_t*)ld_ptr(t + 3); d.g.lda = ld_u(t + 5); d.g.ldb = ld_u(t + 6); d.g.K = ld_u(t + 7); d.g.nM = ld_u(t + 8); d.g.nN = ld_u(t + 9);
    d.g.a_pn_off = ld_u(t + 10); d.g.b_pn_off = ld_u(t + 11); d.g.b_batch_off = ld_u(t + 12); d.g.bshift = ld_u(t + 13);
    d.O = (bf16_t*)ld_ptr(t + 14); d.ldc = ld_u(t + 16); d.scale = __uint_as_float(ld_u(t + 17)); d.Fb = (const bf16_t*)ld_ptr(t + 18); d.hin = (const float*)ld_ptr(t + 20); d.coef = __uint_as_float(ld_u(t + 22));
    d.gpost = (const float*)ld_ptr(t + 23); d.gpre = (const float*)ld_ptr(t + 25); return d;
}

__device__ __forceinline__ Desc make_desc(const Ctx& F, int ph) {
    Desc d; d.kind = -1; d.nobar = 0; d.O = nullptr; d.ldc = 0; d.scale = 1.f; d.Fb = nullptr; d.hin = nullptr; d.coef = 0.f; d.gpost = nullptr; d.gpre = nullptr;
    d.g = pg8::plain_gemm(nullptr, 0, nullptr, 0, 256, 256, 256);
    if (ph == 0) { d.kind = K_PREP; return d; }
    if (ph < NPRE) {
        const int l = (ph - 1) >> 1, v = (ph - 1) & 1; const bf16_t* mn = (const bf16_t*)(F.ws + (l ? WS_MEMN1 : WS_MEMN0)); const bf16_t* wkv = (const bf16_t*)(F.ws + WS_W + W_KV) + (size_t)l * 2 * D * D;
        d.kind = K_GEMM; d.nobar = 1; d.ldc = D;
        if (v == 0) { d.g = pg8::plain_gemm(mn, D, wkv, D, 1024, D, D); d.O = (bf16_t*)(F.ws + (l ? WS_KX1 : WS_KX0)); }
        else { d.g = pg8::plain_gemm(wkv + (size_t)D * D, D, mn, D, 1024, D, D); d.O = (bf16_t*)(F.ws + (l ? WS_VT1 : WS_VT0)); }
        return d; }
    const int l = (ph - NPRE) / OP_COUNT, op = (ph - NPRE) % OP_COUNT;
    unsigned char* ws = F.ws; const float* nrm = inp(I_NORMS) + (size_t)l * 9 * D;
    bf16_t* A = (bf16_t*)(ws + WS_A); bf16_t* Fb = (bf16_t*)(ws + WS_F); bf16_t* BIG = (bf16_t*)(ws + WS_BIG); bf16_t* MIX = (bf16_t*)(ws + WS_MIX); bf16_t* Cc = (bf16_t*)(ws + WS_MIX + 32 * MiB);
    const unsigned char* W = ws + WS_W;
    switch (op) {
    case OP_UP1: case OP_UP2: { const int i = (op == OP_UP2); d.kind = K_SWIGLU; d.g = pg8::plain_gemm(A, D, (const bf16_t*)(W + W_GU) + (size_t)(l * 2 + i) * 2 * FF * D, D, T, 2 * FF, D); d.O = BIG; d.ldc = FF; break; }
    case OP_DN1: case OP_DN2: { const int i = (op == OP_DN2); d.kind = K_GEMM; d.g = pg8::plain_gemm(BIG, FF, (const bf16_t*)(W + W_DN) + (size_t)(l * 2 + i) * D * FF, FF, T, D, FF); d.O = Fb; d.ldc = D; break; }
    case OP_N1: d.kind = K_NORM; d.Fb = Fb; d.hin = (l == 0) ? inp(I_X) : F.out; d.coef = 0.5f; d.gpost = nrm + N_FFN1_POST * D; d.gpre = nrm + N_MIX_PRE * D; break;
    case OP_IN: d.kind = K_GEMM; if (l == 0) d.g = pg8::plain_gemm(A, D, (const bf16_t*)(W + W_EIN), D, T, NE, D); else d.g = pg8::plain_gemm(A, D, (const bf16_t*)(W + W_OIN), D, T, NO, D);
                d.O = BIG; d.ldc = (l == 0) ? NE : NO; break;
    case OP_M0: d.kind = (l == 0) ? K_CKVN : K_GLA_A; d.nobar = (l == 0); break;
    case OP_M1: d.kind = (l == 0) ? K_LRU_A : K_GLA_B; d.nobar = (l == 0); break;
    case OP_M2: d.kind = (l == 0) ? K_IDX : K_GLA_C; break;
    case OP_M3: if (l == 0) { d.kind = K_GEMM; d.nobar = 1; d.g = pg8::plain_gemm((const bf16_t*)(ws + WS_BIG + BG_CKVN), 256, (const bf16_t*)(W + W_UKV), 256, T, 1024, 256); d.O = MIX; d.ldc = 1024; } break;
    case OP_M4: d.kind = (l == 0) ? K_LRU_B : -1; break;
    case OP_M5: d.kind = (l == 0) ? K_ATT : -1; break;
    case OP_OUT: d.kind = K_GEMM; d.g = pg8::plain_gemm(Cc, D, (const bf16_t*)(W + (l == 0 ? W_EOUT : W_OOUT)), D, T, D, D); d.O = Fb; d.ldc = D; break;
    case OP_N2: d.kind = K_NORM; d.Fb = Fb; d.hin = F.out; d.coef = 1.0f; d.gpost = nrm + N_MIX_POST * D; d.gpre = nrm + N_XA_PRE * D; break;
    case OP_XQ: d.kind = K_GEMM; d.g = pg8::plain_gemm(A, D, (const bf16_t*)(W + W_Q) + (size_t)l * D * D, D, T, D, D); d.O = BIG; d.ldc = D; break;
    case OP_XS: { d.kind = K_GEMM; pg8::Gemm g; g.A = BIG; g.Bt = (const bf16_t*)(ws + (l ? WS_KX1 : WS_KX0)); g.lda = D; g.ldb = D; g.K = 256; g.nM = T / 256; g.nN = 4; g.a_pn_off = 256; g.b_pn_off = 256; g.b_batch_off = 256 * D; g.bshift = 4;
                  d.g = g; d.O = (bf16_t*)(ws + WS_BIG + BG_S); d.ldc = D; d.scale = 0.0625f; break; }
    case OP_XSM: d.kind = K_XSOFTMAX; break;
    case OP_XO: { d.kind = K_GEMM; pg8::Gemm g; g.A = MIX; g.Bt = (const bf16_t*)(ws + (l ? WS_VT1 : WS_VT0)); g.lda = D; g.ldb = D; g.K = 256; g.nM = T / 256; g.nN = 4; g.a_pn_off = 256; g.b_pn_off = 256 * D; g.b_batch_off = 256; g.bshift = 4;
                  d.g = g; d.O = BIG; d.ldc = D; break; }
    case OP_XOUT: d.kind = K_GEMM; d.g = pg8::plain_gemm(BIG, D, (const bf16_t*)(W + W_O) + (size_t)l * D * D, D, T, D, D); d.O = Fb; d.ldc = D; break;
    case OP_N3: d.kind = K_NORM; d.Fb = Fb; d.hin = F.out; d.coef = 1.0f; d.gpost = nrm + N_XA_POST * D; d.gpre = nrm + N_FFN2_PRE * D; break;
    case OP_N4: d.kind = K_NORM; d.Fb = Fb; d.hin = F.out; d.coef = 0.5f; d.gpost = nrm + N_FFN2_POST * D; d.gpre = (l == 0) ? (inp(I_NORMS) + (size_t)(9 + N_FFN1_PRE) * D) : nullptr; break;
    default: break;
    }
    return d;
}

__global__ void __launch_bounds__(NTHREADS, 2) mk_fwd(Args args) {
    extern __shared__ __attribute__((aligned(16))) unsigned char lds_raw[];
    Ctx F; F.lds = (LAS unsigned char*)lds_raw; F.ldsg = (char*)lds_raw; F.tid = threadIdx.x; F.lane = F.tid & 63; F.wave = __builtin_amdgcn_readfirstlane(F.tid >> 6);
    F.nblk = gridDim.x; F.bid = blockIdx.x; F.out = args.out; F.ws = args.ws;
    volatile LAS unsigned* MISC = (volatile LAS unsigned*)(F.lds + MISC_OFF);
    for (int u = F.tid; u < (LDS_BYTES - MISC_OFF) / 4; u += NTHREADS) MISC[u] = 0u;
    __syncthreads();
    XcdBarrier bar; bar.bar = (unsigned*)(args.ws + WS_CTL) + CW_BAR; bar.x = 0; bar.st = nullptr;
#if !MK_PER_PHASE
    bar = xcd_barrier_post((unsigned*)(args.ws + WS_CTL) + CW_BAR, MISC + 8);
#endif
    F.kp = (const __attribute__((address_space(4))) void*)__builtin_amdgcn_kernarg_segment_ptr();
    if (F.tid < NPHASES) { const Desc dd = make_desc(F, F.tid); desc_store((LAS unsigned*)(F.lds + DESC_OFF) + F.tid * DESC_WORDS, dd); }
    __syncthreads();
    const Ctx F0 = F;
    for (int ph = args.ph_lo; ph < args.ph_hi; ++ph) {
        Ctx F = F0;
        asm volatile("" ::: "v16","v17","v18","v19","v20","v21","v22","v23","v24","v25","v26","v27","v28","v29","v30","v31","v32","v33","v34","v35","v36","v37","v38","v39","v40","v41","v42","v43","v44","v45","v46","v47","v48","v49","v50","v51","v52","v53","v54","v55","v56","v57","v58","v59","v60","v61","v62","v63","v64","v65","v66","v67","v68","v69","v70","v71","v72","v73","v74","v75","v76","v77","v78","v79","v80","v81","v82","v83","v84","v85","v86","v87","v88","v89","v90","v91","v92","v93","v94","v95","v96","v97","v98","v99","v100","v101","v102","v103","v104","v105","v106","v107","v108","v109","v110","v111","v112","v113","v114","v115","v116","v117","v118","v119","v120","v121","v122","v123","v124","v125","v126","v127","v128","v129","v130","v131","v132","v133","v134","v135","v136","v137","v138","v139","v140","v141","v142","v143","v144","v145","v146","v147","v148","v149","v150","v151","v152","v153","v154","v155","v156","v157","v158","v159","v160","v161","v162","v163","v164","v165","v166","v167","v168","v169","v170","v171","v172","v173","v174","v175","v176","v177","v178","v179","v180","v181","v182","v183","v184","v185","v186","v187","v188","v189","v190","v191","v192","v193","v194","v195","v196","v197","v198","v199","v200","v201","v202","v203","v204","v205","v206","v207","v208","v209","v210","v211","v212","v213","v214","v215","v216","v217","v218","v219","v220","v221","v222","v223","v224","v225","v226","v227","v228","v229","v230","v231","v232","v233","v234","v235");
        F.tid = F0.tid;
        const Desc d = desc_load((const LAS unsigned*)(F.lds + DESC_OFF) + ph * DESC_WORDS);
        if (d.kind < 0) continue;
#ifndef PH_ENABLE
#define PH_ENABLE 0xffffffffu
#endif
#define EN(k) (((PH_ENABLE) >> (k)) & 1u)
#ifndef REPEAT_MASK
#define REPEAT_MASK 0u
#endif
        for (int rep = 0; rep < 1 + (int)((REPEAT_MASK >> d.kind) & 1u); ++rep) {
        if (rep) __syncthreads();
        F = F0;
        { unsigned long long p0 = (unsigned long long)(uintptr_t)F.ws, p1 = (unsigned long long)(uintptr_t)F.out, p2 = (unsigned long long)(uintptr_t)F.kp;
          unsigned a0 = (unsigned)p0, a1 = (unsigned)(p0 >> 32), b0 = (unsigned)p1, b1 = (unsigned)(p1 >> 32), c0 = (unsigned)p2, c1 = (unsigned)(p2 >> 32); int w_ = F.wave, n_ = F.nblk, i_ = F.bid;
          int ln_; asm volatile("v_mbcnt_lo_u32_b32 %0, -1, 0\n\tv_mbcnt_hi_u32_b32 %0, -1, %0" : "=v"(ln_));
          asm volatile("" : "+v"(a0), "+v"(a1), "+v"(b0), "+v"(b1), "+v"(c0), "+v"(c1), "+v"(w_), "+v"(n_), "+v"(i_));
#define RFL(x) ((unsigned)__builtin_amdgcn_readfirstlane((int)(x)))
          F.ws = (unsigned char*)(uintptr_t)((unsigned long long)RFL(a0) | ((unsigned long long)RFL(a1) << 32)); F.out = (float*)(uintptr_t)((unsigned long long)RFL(b0) | ((unsigned long long)RFL(b1) << 32));
          F.kp = (const __attribute__((address_space(4))) void*)(uintptr_t)((unsigned long long)RFL(c0) | ((unsigned long long)RFL(c1) << 32)); F.wave = (int)RFL(w_); F.nblk = (int)RFL(n_); F.bid = (int)RFL(i_); F.lane = ln_; F.tid = F.wave * 64 + ln_; }
        switch (d.kind) {
        case K_PREP: if constexpr (EN(K_PREP)) { phase_prep(F); } break;
#if NAIVE_GEMM
        case K_SWIGLU: { pg8::EpiSwiglu E{d.O, d.ldc}; pg8::gemm_naive<2>(F.lds, d.g, E, F.nblk, F.bid, F.tid); break; }
        case K_GEMM: { pg8::EpiBf16 E{d.O, d.ldc, d.scale}; pg8::gemm_naive<1>(F.lds, d.g, E, F.nblk, F.bid, F.tid); break; }
#else
        case K_SWIGLU: case K_GEMM: if constexpr (EN(K_GEMM)) {
            pg8::StaticOrder S; S.init(d.g.nM, d.g.nN, F.nblk, F.bid); pg8::EpiAny E{d.O, d.ldc, d.scale, d.kind == K_SWIGLU ? 1 : 0}; pg8::gemm_phase<pg8::EpiAny, true>(F.lds, d.g, S, E, F.tid);
            break; }
#endif
        case K_NORM: if constexpr (EN(K_NORM)) { phase_norm(F, d.Fb, d.hin, F.out, d.coef, d.gpost, d.gpre, (bf16_t*)(F.ws + WS_A)); } break;
        case K_CKVN: if constexpr (EN(K_CKVN)) { phase_ckvn(F); } break;
        case K_IDX: if constexpr (EN(K_IDX)) { phase_idx(F); } break;
                case K_ATT: if constexpr (EN(K_ATT)) { dsa::attn_phase<8>(F.tid, F.nblk, F.bid, (const dsa::bf16*)(F.ws + WS_BIG + BG_Y) + YQ, (const dsa::bf16*)(F.ws + WS_MIX), (const dsa::bf16*)(F.ws + WS_MIX) + 512,
                                                                  (dsa::bf16*)(F.ws + WS_MIX + 32 * MiB), (const dsa::u32x2*)(F.ws + WS_BIG + BG_MASK), F.ldsg); } break;
        case K_LRU_A: if constexpr (EN(K_LRU_A)) { phase_lru<0>(F); } break;
        case K_LRU_B: if constexpr (EN(K_LRU_B)) { phase_lru<1>(F); } break;
        case K_GLA_A: if constexpr (EN(K_GLA_A)) { phase_gla_a(F); } break;
        case K_GLA_B: if constexpr (EN(K_GLA_B)) { phase_gla_b(F); } break;
        case K_GLA_C: if constexpr (EN(K_GLA_C)) { phase_gla_c(F); } break;
        case K_XSOFTMAX: if constexpr (EN(K_XSOFTMAX)) { phase_xsoftmax(F); } break;
        default: break;
        }
        }
        if (d.nobar) __syncthreads();
#if !MK_PER_PHASE
        if (ph + 1 < args.ph_hi && !d.nobar) {
            if (ph == 0) { cg::this_grid().sync(); }
            XcdBarrier bb = bar; { unsigned long long p = (unsigned long long)(uintptr_t)bb.bar; unsigned lo = (unsigned)p, hi = (unsigned)(p >> 32), xx = bb.x; asm volatile("" : "+v"(lo), "+v"(hi), "+v"(xx));
                bb.bar = (unsigned*)(uintptr_t)((unsigned long long)RFL(lo) | ((unsigned long long)RFL(hi) << 32)); bb.x = RFL(xx); }
            xcd_barrier(bb);
        }
#endif
    }
}

extern "C" void kernel_launch(void* const* d_in, const int* in_sizes, int n_in, void* d_out, int out_size, void* d_ws, size_t ws_size, hipStream_t stream) {
    static int grid = 0;
    if (grid == 0) {
        if (n_in != 25 || in_sizes[0] != T * D || out_size != T * D || ws_size < WS_END) { fprintf(stderr, "kernel_launch: unexpected shapes (n_in %d, in0 %d, out %d, ws %zu); nothing launched\n", n_in, n_in > 0 ? in_sizes[0] : -1, out_size, ws_size); grid = -1; return; }
        int dev = 0, cus = 0, per_cu = 0;
        if (hipGetDevice(&dev) != hipSuccess || hipDeviceGetAttribute(&cus, hipDeviceAttributeMultiprocessorCount, dev) != hipSuccess) { grid = -1; return; }
        if (hipFuncSetAttribute((const void*)mk_fwd, hipFuncAttributeMaxDynamicSharedMemorySize, LDS_BYTES) != hipSuccess) { fprintf(stderr, "kernel_launch: hipFuncSetAttribute failed\n"); grid = -1; return; }
        if (hipOccupancyMaxActiveBlocksPerMultiprocessor(&per_cu, (const void*)mk_fwd, NTHREADS, LDS_BYTES) != hipSuccess || per_cu < 1) { fprintf(stderr, "kernel_launch: occupancy query says %d\n", per_cu); (void)hipGetLastError(); grid = -1; return; }
        grid = cus;
    }
    if (grid < 0) return;
    (void)hipMemsetAsync((char*)d_ws + WS_CTL, 0, CTL_BYTES, stream);
    Args a{};
    for (int i = 0; i < 25; ++i) a.in[i] = (const float*)d_in[i];
    a.out = (float*)d_out; a.ws = (unsigned char*)d_ws;
#if MK_PER_PHASE
    for (int ph = 0; ph < NPHASES; ++ph) { a.ph_lo = ph; a.ph_hi = ph + 1; hipLaunchKernelGGL(mk_fwd, dim3(grid), dim3(NTHREADS), LDS_BYTES, stream, a); }
#else
    a.ph_lo = 0; a.ph_hi = NPHASES;
    void* kargs[] = {&a};
    hipError_t e = hipLaunchCooperativeKernel((const void*)mk_fwd, dim3(grid), dim3(NTHREADS), kargs, LDS_BYTES, stream);
    if (e != hipSuccess) fprintf(stderr, "cooperative launch failed: %s (grid %d)\n", hipGetErrorString(e), grid);
#endif
}
```
